# Optimizing an MI355X kernel written in HIP

```python
import math
import jax, jax.numpy as jnp
from jax import lax
import numpy as np

D_MODEL = 1024
BATCH = 2
SEQ = 16384
DEPTH = 2

HEAD_DIM = 64
SB_HEADS = 4
DIL_HEADS = 4
HGRN_HEADS = 4
HGRN_DK = 128
HGRN_DV = 128
SB_WIDTH = SB_HEADS * HEAD_DIM
DIL_WIDTH = DIL_HEADS * HEAD_DIM
HGRN_WIDTH = HGRN_HEADS * HGRN_DV
HGRN_KDIM = HGRN_HEADS * HGRN_DK
MIX_WIDTH = SB_WIDTH + DIL_WIDTH + HGRN_WIDTH
IN_SPLITS = (SB_WIDTH, SB_WIDTH, SB_WIDTH, DIL_WIDTH, DIL_WIDTH, DIL_WIDTH, HGRN_KDIM, HGRN_KDIM, HGRN_WIDTH, HGRN_WIDTH)
IN_WIDTH = 3 * SB_WIDTH + 3 * DIL_WIDTH + 2 * HGRN_KDIM + 2 * HGRN_WIDTH
D_FF = 2816
QBLK = 128
HGRN_CHUNK = 64
DIL_PATTERNS = ((128, 1), (512, 4), (2048, 16))
ROPE_THETA = 10000.0
EPS = 1e-6
LB_FLOOR = 1e-30
NEG_BIG = -1e30
N_MOD = 9
HALF_STEP = 0.5

kernel_name = "hymba_style_sb_dilated_hgrn2_macaron_block"


def _rmsnorm(x):
    xf = x.astype(jnp.float32)
    return (xf * lax.rsqrt(jnp.mean(xf * xf, axis=-1, keepdims=True) + EPS)).astype(x.dtype)


def _split_heads(x, n_heads):
    b, s, w = x.shape
    return x.reshape(b, s, n_heads, w // n_heads).transpose(0, 2, 1, 3)


def _merge_heads(x):
    b, h, s, d = x.shape
    return x.transpose(0, 2, 1, 3).reshape(b, s, h * d)


def _rope(x):
    s, d = x.shape[2], x.shape[3]
    half = d // 2
    inv_freq = ROPE_THETA ** (-jnp.arange(half, dtype=jnp.float32) * 2.0 / d)
    ang = jnp.arange(s, dtype=jnp.float32)[:, None] * inv_freq[None, :]
    cos, sin = jnp.cos(ang), jnp.sin(ang)
    xf = x.astype(jnp.float32)
    x1, x2 = xf[..., :half], xf[..., half:]
    return jnp.concatenate([x1 * cos - x2 * sin, x2 * cos + x1 * sin], axis=-1).astype(x.dtype)


def _swiglu(h, w_gate, w_up, w_down):
    return (jax.nn.silu(h @ w_gate) * (h @ w_up)) @ w_down


def _stick_breaking(q, k, v):
    b, h, s, d = q.shape
    nb = s // QBLK
    qf = q.astype(jnp.float32) * (d ** -0.5)
    kf = k.astype(jnp.float32)
    vf = v.astype(jnp.float32)
    q_blocks = qf.reshape(b, h, nb, QBLK, d).transpose(2, 0, 1, 3, 4)
    starts = jnp.arange(nb, dtype=jnp.int32) * QBLK
    kpos = jnp.arange(s, dtype=jnp.int32)

    def block(args):
        qb, start = args
        z = jnp.einsum('bhqd,bhkd->bhqk', qb, kf)
        qpos = start + jnp.arange(QBLK, dtype=jnp.int32)
        causal = kpos[None, :] < qpos[:, None]
        log_not_beta = jnp.where(causal, jax.nn.log_sigmoid(-z), 0.0)
        tail = lax.cumsum(log_not_beta, axis=3, reverse=True) - log_not_beta
        log_w = jnp.where(causal, jax.nn.log_sigmoid(z) + tail, NEG_BIG)
        w = jnp.exp(log_w)
        return jnp.einsum('bhqk,bhkd->bhqd', w, vf)

    out = lax.map(block, (q_blocks, starts))
    return out.transpose(1, 2, 0, 3, 4).reshape(b, h, s, d)


def _dilated_partial(q, k, v, window, dilation):
    b, h, s, d = q.shape
    steps = window // dilation
    sub_len = -(-s // (QBLK * dilation)) * QBLK
    pad = sub_len * dilation - s
    nb = sub_len // QBLK

    def to_residue(x):
        x = jnp.pad(x.astype(jnp.float32), ((0, 0), (0, 0), (0, pad), (0, 0)))
        x = x.reshape(b, h, sub_len, dilation, d).transpose(0, 1, 3, 2, 4)
        return x.reshape(b, h, dilation, nb, QBLK, d)

    qr, kr, vr = to_residue(q), to_residue(k), to_residue(v)

    def with_prev_block(x):
        prev = jnp.pad(x, ((0, 0), (0, 0), (0, 0), (1, 0), (0, 0), (0, 0)))[:, :, :, :-1]
        return jnp.concatenate([prev, x], axis=4)

    kw, vw = with_prev_block(kr), with_prev_block(vr)
    scores = jnp.einsum('bhrnqd,bhrnkd->bhrnqk', qr, kw)
    a_idx = jnp.arange(QBLK)[:, None]
    k_idx = jnp.arange(2 * QBLK)[None, :]
    dist = a_idx + QBLK - k_idx
    band = (dist >= 0) & (dist <= steps)
    valid = band[None] & ((jnp.arange(nb)[:, None, None] > 0) | (k_idx[None] >= QBLK))
    scores = jnp.where(valid, scores, NEG_BIG)
    mx = jnp.max(scores, axis=-1)
    p = jnp.where(valid, jnp.exp(scores - mx[..., None]), 0.0)
    den = jnp.sum(p, axis=-1)
    num = jnp.einsum('bhrnqk,bhrnkd->bhrnqd', p, vw)

    def back(x):
        x = x.reshape((b, h, dilation, sub_len) + x.shape[5:])
        perm = (0, 1, 3, 2) + tuple(range(4, x.ndim))
        x = x.transpose(perm).reshape((b, h, sub_len * dilation) + x.shape[4:])
        return x[:, :, :s]

    return back(num), back(den), back(mx)


def _dilated_mixture(q, k, v):
    parts = [_dilated_partial(q, k, v, w, r) for (w, r) in DIL_PATTERNS]
    m_all = parts[0][2]
    for _, _, m in parts[1:]:
        m_all = jnp.maximum(m_all, m)
    num = 0.0
    den = 0.0
    for n_i, d_i, m_i in parts:
        scale = jnp.exp(m_i - m_all)
        num = num + n_i * scale[..., None]
        den = den + d_i * scale
    return num / den[..., None]


def _hgrn2_chunkwise(q, k, v, log_f):
    b, h, s, dk = q.shape
    dv = v.shape[-1]
    n = s // HGRN_CHUNK

    def chunks(x):
        return x.astype(jnp.float32).reshape(b, h, n, HGRN_CHUNK, x.shape[-1]).transpose(2, 0, 1, 3, 4)

    qc, kc, vc = chunks(q), chunks(k), chunks(v)
    g_cum = jnp.cumsum(chunks(log_f), axis=3)
    causal = jnp.tril(jnp.ones((HGRN_CHUNK, HGRN_CHUNK), dtype=bool))[:, :, None]

    def step(state, xs):
        qb, kb, vb, gb = xs
        diff = gb[:, :, :, None, :] - gb[:, :, None, :, :]
        decay = jnp.where(causal, jnp.exp(jnp.where(causal, diff, 0.0)), 0.0)
        scores = jnp.einsum('bhtd,bhsd,bhtsd->bhts', qb, kb, decay)
        o = jnp.einsum('bhts,bhsv->bhtv', scores, vb) + jnp.einsum('bhtd,bhdv->bhtv', qb * jnp.exp(gb), state)
        g_last = gb[:, :, -1, :]
        new_state = jnp.exp(g_last)[..., None] * state + jnp.einsum('bhsd,bhsv->bhdv', kb * jnp.exp(g_last[:, :, None, :] - gb), vb)
        return new_state, o

    state0 = jnp.zeros((b, h, dk, dv), jnp.float32)
    _, o = lax.scan(step, state0, (qc, kc, vc, g_cum))
    return o.transpose(1, 2, 0, 3, 4).reshape(b, h, s, dv)


def _hybrid_mixer(h, w_in, w_out, q_norm_g, k_norm_g, hgrn_norm_g, lower_bound):
    dt = h.dtype
    proj = h @ w_in
    offsets = []
    acc = 0
    for wdt in IN_SPLITS[:-1]:
        acc += wdt
        offsets.append(acc)
    qa, ka, va, qd, kd, vd, qh, fh, ih, gh = jnp.split(proj, offsets, axis=-1)

    o_a = _stick_breaking(_split_heads(qa, SB_HEADS), _split_heads(ka, SB_HEADS), _split_heads(va, SB_HEADS))

    qd = _rope(_rmsnorm(_split_heads(qd, DIL_HEADS)) * q_norm_g) * (HEAD_DIM ** -0.5)
    kd = _rope(_rmsnorm(_split_heads(kd, DIL_HEADS)) * k_norm_g)
    o_d = _dilated_mixture(qd, kd, _split_heads(vd, DIL_HEADS))

    lb = lower_bound.reshape(HGRN_HEADS, 1, HGRN_DK).astype(jnp.float32)
    z = _split_heads(fh, HGRN_HEADS).astype(jnp.float32)
    log_f = jnp.logaddexp(jnp.log(jnp.maximum(lb, LB_FLOOR)), jnp.log1p(-lb) + jax.nn.log_sigmoid(z))
    k_h = -jnp.expm1(log_f)
    q_h = jax.nn.silu(_split_heads(qh, HGRN_HEADS))
    o_h = _hgrn2_chunkwise(q_h, k_h, _split_heads(ih, HGRN_HEADS), log_f)
    o_h = _rmsnorm(o_h) * hgrn_norm_g * jax.nn.silu(_split_heads(gh, HGRN_HEADS).astype(jnp.float32))

    y = jnp.concatenate([_merge_heads(o_a).astype(dt), _merge_heads(o_d).astype(dt), _merge_heads(o_h).astype(dt)], axis=-1)
    return y @ w_out


def setup_inputs(seed: int = 0) -> dict:
    key = jax.random.key(seed)
    ks = jax.random.split(key, 16)

    def nrm(k, shape, scale):
        return jax.random.normal(k, shape, jnp.float32) * scale

    return {
        "x": nrm(ks[0], (BATCH, SEQ, D_MODEL), 1.0),
        "c": nrm(ks[1], (BATCH, D_MODEL), 1.0),
        "w_mod": nrm(ks[2], (DEPTH, D_MODEL, N_MOD * D_MODEL), D_MODEL ** -0.5),
        "b_mod": nrm(ks[3], (DEPTH, N_MOD * D_MODEL), 0.02),
        "ffn1_w_gate": nrm(ks[4], (DEPTH, D_MODEL, D_FF), D_MODEL ** -0.5),
        "ffn1_w_up": nrm(ks[5], (DEPTH, D_MODEL, D_FF), D_MODEL ** -0.5),
        "ffn1_w_down": nrm(ks[6], (DEPTH, D_FF, D_MODEL), D_FF ** -0.5),
        "w_in": nrm(ks[7], (DEPTH, D_MODEL, IN_WIDTH), D_MODEL ** -0.5),
        "w_out": nrm(ks[8], (DEPTH, MIX_WIDTH, D_MODEL), MIX_WIDTH ** -0.5),
        "q_norm_g": 1.0 + nrm(ks[9], (DEPTH, HEAD_DIM), 0.02),
        "k_norm_g": 1.0 + nrm(ks[10], (DEPTH, HEAD_DIM), 0.02),
        "hgrn_norm_g": 1.0 + nrm(ks[11], (DEPTH, HGRN_DV), 0.02),
        "hgrn_lb_logits": nrm(ks[12], (DEPTH, HGRN_KDIM), 0.5),
        "ffn2_w_gate": nrm(ks[13], (DEPTH, D_MODEL, D_FF), D_MODEL ** -0.5),
        "ffn2_w_up": nrm(ks[14], (DEPTH, D_MODEL, D_FF), D_MODEL ** -0.5),
        "ffn2_w_down": nrm(ks[15], (DEPTH, D_FF, D_MODEL), D_FF ** -0.5),
    }


def reference(x, c, w_mod, b_mod, ffn1_w_gate, ffn1_w_up, ffn1_w_down, w_in, w_out, q_norm_g, k_norm_g, hgrn_norm_g, hgrn_lb_logits, ffn2_w_gate, ffn2_w_up, ffn2_w_down):
    lb_sm = jax.nn.softmax(hgrn_lb_logits.astype(jnp.float32), axis=0)
    lower_bounds = jnp.clip(jnp.cumsum(lb_sm, axis=0) - lb_sm[0:1], 0.0, 1.0 - EPS)
    for l in range(DEPTH):
        mod = jax.nn.silu(c) @ w_mod[l] + b_mod[l]
        sh1, sc1, g1, sh2, sc2, g2, sh3, sc3, g3 = jnp.split(mod[:, None, :], N_MOD, axis=-1)
        h = _rmsnorm(x) * (1.0 + sc1) + sh1
        x = x + HALF_STEP * g1 * _swiglu(h, ffn1_w_gate[l], ffn1_w_up[l], ffn1_w_down[l])
        h = _rmsnorm(x) * (1.0 + sc2) + sh2
        x = x + g2 * _hybrid_mixer(h, w_in[l], w_out[l], q_norm_g[l], k_norm_g[l], hgrn_norm_g[l], lower_bounds[l])
        h = _rmsnorm(x) * (1.0 + sc3) + sh3
        x = x + HALF_STEP * g3 * _swiglu(h, ffn2_w_gate[l], ffn2_w_up[l], ffn2_w_down[l])
    return x
```

```cpp
#include <hip/hip_runtime.h>
#include <hip/hip_cooperative_groups.h>
#include <cstdio>
#include <cstdint>
namespace cg = cooperative_groups;

typedef unsigned short bf16_t;
typedef short bf16x8 __attribute__((ext_vector_type(8)));
typedef _Float16 f16x8 __attribute__((ext_vector_type(8)));
typedef float f32x2 __attribute__((ext_vector_type(2)));
typedef float f32x4 __attribute__((ext_vector_type(4)));
typedef float f32x16 __attribute__((ext_vector_type(16)));
typedef unsigned u32x2 __attribute__((ext_vector_type(2)));
typedef unsigned u32x4 __attribute__((ext_vector_type(4)));
typedef __bf16 bf16x2_t __attribute__((ext_vector_type(2)));

#define DI __device__ __forceinline__
#define LAS __attribute__((address_space(3)))

constexpr int D_MODEL = 1024, BATCH = 2, SEQ = 16384, DEPTH = 2, D_FF = 2816;
constexpr int M_TOK = BATCH * SEQ;
constexpr int PW = 3584;
constexpr int C_QA = 0, C_KA = 256, C_VA = 512, C_QD = 768, C_KD = 1024, C_VD = 1280, C_QH = 1536, C_FH = 2048, C_IH = 2560, C_GH = 3072;
constexpr int NMOD = 9 * D_MODEL;
constexpr float EPS = 1e-6f;
constexpr float LOG2E = 1.4426950408889634f;
constexpr int NCHUNK = SEQ / 64;

constexpr size_t MiB = 1u << 20;
constexpr size_t W_GU = (size_t)2 * D_FF * D_MODEL * 2;
constexpr size_t W_DN = (size_t)D_MODEL * D_FF * 2;
constexpr size_t W_IN = (size_t)PW * D_MODEL * 2;
constexpr size_t W_OUT = (size_t)D_MODEL * D_MODEL * 2;
constexpr size_t WL_GU1 = 0, WL_DN1 = WL_GU1 + W_GU, WL_IN = WL_DN1 + W_DN, WL_OUT = WL_IN + W_IN, WL_GU2 = WL_OUT + W_OUT, WL_DN2 = WL_GU2 + W_GU, WL_SIZE = WL_DN2 + W_DN;
static_assert(WL_SIZE == 44040192, "weights per layer");
constexpr size_t WS_WEIGHTS = 0;
constexpr size_t WS_SMALL = 84 * MiB;
constexpr size_t WS_MOD = WS_SMALL, WS_LB = WS_SMALL + 256 * 1024;
constexpr size_t WS_DEC = 85 * MiB;
constexpr size_t WS_HB = 86 * MiB;
constexpr size_t WS_PNUM = WS_HB;
constexpr size_t WS_PDEN = WS_HB + 48 * MiB;
constexpr size_t WS_ACT = 150 * MiB;
constexpr size_t WS_Y = 374 * MiB;
constexpr size_t WS_ST = 438 * MiB;
constexpr size_t WS_END = 502 * MiB;

DI unsigned pk2(float lo, float hi) { f32x2 v = {lo, hi}; bf16x2_t b = __builtin_convertvector(v, bf16x2_t); return __builtin_bit_cast(unsigned, b); }
DI float bf2f(bf16_t b) { return __uint_as_float((unsigned)b << 16); }
DI float bflo(unsigned u) { return __uint_as_float(u << 16); }
DI float bfhi(unsigned u) { return __uint_as_float(u & 0xffff0000u); }
DI int crow(int reg, int h) { return (reg & 3) + 8 * (reg >> 2) + 4 * h; }
DI int krow(int s, int h, int j) { return 16 * s + 8 * (j >> 2) + 4 * h + (j & 3); }
DI float fexp2(float x) { return __builtin_amdgcn_exp2f(x); }
DI float flog2(float x) { return __builtin_amdgcn_logf(x); }
DI float frcp(float x) { return __builtin_amdgcn_rcpf(x); }
DI float silu_f(float g) { return g * frcp(1.0f + fexp2(-g * LOG2E)); }
#define MFMA_BF16(a, b, c) __builtin_amdgcn_mfma_f32_32x32x16_bf16((a), (b), (c), 0, 0, 0)
#define MFMA_F16(a, b, c) __builtin_amdgcn_mfma_f32_32x32x16_f16((a), (b), (c), 0, 0, 0)
#define LDS_WAIT() asm volatile("s_waitcnt lgkmcnt(0)" ::: "memory")

#ifdef SKIP_GEMM
#define GEMMCALL pg8::gemm_dummy
#else
#define GEMMCALL pg8::gemm_phase
#endif
namespace pg8 {
#define PG8_LAS __attribute__((address_space(3)))
constexpr int BM = 256, BK = 64, HALF = 128, HTB = HALF * BK * 2  , STAGE_BYTES = 8 * HTB, NXCD = 8, WGM = 8;

__host__ __device__ __forceinline__ int lds_byte(int r, int c) { const int st = (r >> 4) * 2 + (c >> 5), rr = r & 15, cc = c & 31, ob = rr * 64 + cc * 2; return st * 1024 + (ob ^ (((ob >> 9) & 1) << 5)); }
__host__ __device__ __forceinline__ void stage_rc(int b, int& R, int& C) { const int st = b / 1024, sb = b % 1024, swz = sb ^ (((sb >> 9) & 1) << 5); R = (st >> 1) * 16 + swz / 64; C = (st & 1) * 32 + (swz % 64) / 2; }
__host__ __device__ __forceinline__ int perm32(int rho) { const int n = rho >> 4, i = rho & 15; return 8 * (i >> 2) + 4 * n + (i & 3); }

struct Unit { int pm, pn; };
struct Gemm { const bf16_t* A; const bf16_t* Bt; int M, N, K; };

struct StaticOrder {
    int nM, nN, nwg, G, c;
    __host__ __device__ void init(int M, int N, int G_, int c_) { nM = M / BM; nN = N / BM; nwg = nM * nN; G = G_; c = c_; }
    __host__ __device__ bool next(int i, Unit& u) const {
        const long L = (long)i * G + c; if (L >= nwg) return false;
        int wgid = (int)L; { const int q = nwg / NXCD, r = nwg % NXCD, xcd = wgid % NXCD, off = wgid / NXCD; wgid = (xcd < r ? xcd * (q + 1) : r * (q + 1) + (xcd - r) * q) + off; }
        const int nig = WGM * nN, gid = wgid / nig, fm = gid * WGM, gsz = (nM - fm) < WGM ? (nM - fm) : WGM;
        u.pm = fm + ((wgid % nig) % gsz); u.pn = (wgid % nig) / gsz; return true;
    }
    __device__ __forceinline__ void a_ready(const Unit&) const {}
    __device__ __forceinline__ void done(const Unit&) const {}
};

struct EpiBf16 {
    static constexpr bool PERM = true, AFTER_DRAIN = false;
    bf16_t* O; int ldc;
    __device__ __forceinline__ void operator()(const f32x4 (&acc)[2][2][4][2], const Unit& u, int wr, int wc, int fr, int fq) const {
        const int row0 = u.pm * BM + wr * 64 + fr; const int col0 = u.pn * BM + wc * 32 + 8 * fq;
#pragma unroll
        for (int ai = 0; ai < 2; ++ai)
#pragma unroll
            for (int m = 0; m < 4; ++m) { bf16_t* rowp = O + (size_t)(row0 + ai * HALF + m * 16) * ldc + col0;
#pragma unroll
                for (int bj = 0; bj < 2; ++bj) { const f32x4 v0 = acc[ai][bj][m][0], v1 = acc[ai][bj][m][1];
                    u32x4 w; w.x = pk2(v0[0], v0[1]); w.y = pk2(v0[2], v0[3]); w.z = pk2(v1[0], v1[1]); w.w = pk2(v1[2], v1[3]);
                    *(u32x4*)(rowp + bj * HALF) = w; } }
    }
};
struct EpiSwiGLU {
    static constexpr bool PERM = true, AFTER_DRAIN = false;
    bf16_t* O; int ldc;
    __device__ __forceinline__ void operator()(const f32x4 (&acc)[2][2][4][2], const Unit& u, int wr, int wc, int fr, int fq) const {
        const int row0 = u.pm * BM + wr * 64 + fr; const int col0 = u.pn * HALF + wc * 32 + 8 * fq;
#pragma unroll
        for (int ai = 0; ai < 2; ++ai)
#pragma unroll
            for (int m = 0; m < 4; ++m) { bf16_t* rowp = O + (size_t)(row0 + ai * HALF + m * 16) * ldc + col0;
                const f32x4 g0 = acc[ai][0][m][0], g1 = acc[ai][0][m][1], u0 = acc[ai][1][m][0], u1 = acc[ai][1][m][1];
                float r[8];
#pragma unroll
                for (int e = 0; e < 4; ++e) { r[e] = silu_f(g0[e]) * u0[e]; r[4 + e] = silu_f(g1[e]) * u1[e]; }
                u32x4 w; w.x = pk2(r[0], r[1]); w.y = pk2(r[2], r[3]); w.z = pk2(r[4], r[5]); w.w = pk2(r[6], r[7]);
                *(u32x4*)rowp = w; }
    }
};
struct EpiRes {
    static constexpr bool PERM = true, AFTER_DRAIN = false;
    const float* X; float* Out; const float* gate; int gstride; float coef;
    __device__ __forceinline__ void operator()(const f32x4 (&acc)[2][2][4][2], const Unit& u, int wr, int wc, int fr, int fq) const {
        const int row0 = u.pm * BM + wr * 64 + fr; const int col0 = u.pn * BM + wc * 32 + 8 * fq;
        const float* gp = gate + (size_t)((u.pm * BM) / SEQ) * gstride + col0;
        f32x4 gv[2][2];
#pragma unroll
        for (int bj = 0; bj < 2; ++bj)
#pragma unroll
            for (int n = 0; n < 2; ++n) gv[bj][n] = *(const f32x4*)(gp + bj * HALF + 4 * n) * coef;
#pragma unroll
        for (int ai = 0; ai < 2; ++ai)
#pragma unroll
            for (int m = 0; m < 4; ++m) { const size_t ro = (size_t)(row0 + ai * HALF + m * 16) * D_MODEL + col0;
#pragma unroll
                for (int bj = 0; bj < 2; ++bj)
#pragma unroll
                    for (int n = 0; n < 2; ++n) { const f32x4 xv = *(const f32x4*)(X + ro + bj * HALF + 4 * n);
                        *(f32x4*)(Out + ro + bj * HALF + 4 * n) = xv + gv[bj][n] * acc[ai][bj][m][n]; } }
    }
};

template <class Epi, class Sched, bool ALIGN_EPI = false, bool SP2 = false>
__device__ __forceinline__ void gemm_phase(PG8_LAS unsigned char* lds, const Gemm g, const Sched& S, const Epi& E) {
    int tid_ = threadIdx.x; asm volatile("" : "+v"(tid_));
    const int tid = tid_, wid = __builtin_amdgcn_readfirstlane(tid >> 6), lane = tid & 63, wr = wid >> 2, wc = wid & 3, fr = lane & 15, fq = lane >> 4;
    const int K = g.K, nt = K / BK;
    unsigned voffA[2], voffB[2];
#pragma unroll
    for (int i = 0; i < 2; ++i) { int R, C; stage_rc(tid * 16 + i * 8192, R, C); const int Rb = Epi::PERM ? ((R & ~31) + perm32(R & 31)) : R;
        voffA[i] = (unsigned)(R * K + C) * 2u; voffB[i] = (unsigned)(Rb * K + C) * 2u; }
    const size_t kstep = (size_t)(BK * 2);
    const size_t hstep = (size_t)HALF * K * 2;
    const size_t tstep = 2 * hstep;
    const unsigned ldsw = (unsigned)wid * 1024u;
    const int aoff = lds_byte(wr * 64 + fr, fq * 8), boff = lds_byte(wc * 32 + fr, fq * 8);
#define PG8_SA(b, h) (((b) * 2 + (h)) * HTB)
#define PG8_SB(b, h) ((4 + (b) * 2 + (h)) * HTB)
#define PG8_STAGE(bufoff, gbase, voff) do { _Pragma("unroll") for (int _i = 0; _i < 2; ++_i) \
        __builtin_amdgcn_global_load_lds((const unsigned*)((const char*)(gbase) + (voff)[_i]), (PG8_LAS unsigned*)(lds + (bufoff) + ldsw + _i * 8192), 16, 0, 0); } while (0)
#define PG8_LDA(dst, b, h) do { _Pragma("unroll") for (int m = 0; m < 4; ++m) _Pragma("unroll") for (int k = 0; k < 2; ++k) dst[m][k] = *(const PG8_LAS bf16x8*)(lds + PG8_SA(b, h) + aoff + m * 2048 + k * 1024); } while (0)
#define PG8_LDB(dst, b, h) do { _Pragma("unroll") for (int n = 0; n < 2; ++n) _Pragma("unroll") for (int k = 0; k < 2; ++k) dst[n][k] = *(const PG8_LAS bf16x8*)(lds + PG8_SB(b, h) + boff + n * 2048 + k * 1024); } while (0)
#define PG8_MMA(ai, bj, At, Bt) do { __builtin_amdgcn_s_setprio(1); _Pragma("unroll") for (int m = 0; m < 4; ++m) _Pragma("unroll") for (int n = 0; n < 2; ++n) _Pragma("unroll") for (int k = 0; k < 2; ++k) \
        acc[ai][bj][m][n] = __builtin_amdgcn_mfma_f32_16x16x32_bf16(Bt[n][k], At[m][k], acc[ai][bj][m][n], 0, 0, 0); __builtin_amdgcn_s_setprio(0); } while (0)
#define PG8_WAIT_V(n) asm volatile("s_waitcnt vmcnt(" #n ")" ::: "memory")
#define PG8_WAIT_L(n) asm volatile("s_waitcnt lgkmcnt(" #n ")" ::: "memory")
#define PG8_BAR __builtin_amdgcn_s_barrier()
#define PG8_SCHED __builtin_amdgcn_sched_barrier(0)
    Unit cur, nxt; int ui = 0;
    if (!S.next(0, cur)) return;
    f32x4 acc[2][2][4][2];
#pragma unroll
    for (int a = 0; a < 2; ++a)
#pragma unroll
        for (int b = 0; b < 2; ++b)
#pragma unroll
            for (int m = 0; m < 4; ++m)
#pragma unroll
                for (int n = 0; n < 2; ++n) acc[a][b][m][n] = (f32x4){0.f, 0.f, 0.f, 0.f};
    bf16x8 At[4][2], B0[2][2], B1[2][2];
    const char* cA = (const char*)g.A + (size_t)cur.pm * tstep; const char* cB = (const char*)g.Bt + (size_t)cur.pn * tstep;
    S.a_ready(cur);
    if constexpr (SP2) {
        PG8_STAGE(PG8_SB(0, 0), cB, voffB); PG8_STAGE(PG8_SB(0, 1), cB + hstep, voffB); PG8_STAGE(PG8_SA(0, 0), cA, voffA); PG8_STAGE(PG8_SA(0, 1), cA + hstep, voffA);
        if (wr == 1) PG8_BAR;
        PG8_WAIT_V(2); PG8_BAR;
        PG8_STAGE(PG8_SB(1, 0), cB + kstep, voffB); PG8_STAGE(PG8_SA(1, 0), cA + kstep, voffA); PG8_STAGE(PG8_SB(1, 1), cB + hstep + kstep, voffB);
        PG8_WAIT_V(6); PG8_BAR;
    } else {
        PG8_STAGE(PG8_SB(0, 0), cB, voffB); PG8_STAGE(PG8_SA(0, 0), cA, voffA); PG8_STAGE(PG8_SB(0, 1), cB + hstep, voffB); PG8_STAGE(PG8_SA(0, 1), cA + hstep, voffA);
        if (wr == 1) PG8_BAR;
        PG8_WAIT_V(4); PG8_BAR;
        PG8_STAGE(PG8_SB(1, 0), cB + kstep, voffB); PG8_STAGE(PG8_SA(1, 0), cA + kstep, voffA); PG8_STAGE(PG8_SB(1, 1), cB + hstep + kstep, voffB);
        PG8_WAIT_V(6); PG8_BAR;
    }
    for (;;) {
        const bool has_next = S.next(ui + 1, nxt);
        const char* nA = has_next ? (const char*)g.A + (size_t)nxt.pm * tstep : cA; const char* nB = has_next ? (const char*)g.Bt + (size_t)nxt.pn * tstep : cB;
        for (int t = 0; t < nt; t += 2) {
            const bool last = (t == nt - 2);
            const char* a1 = cA + (size_t)(t + 1) * kstep;
            const char* a2 = last ? nA : cA + (size_t)(t + 2) * kstep; const char* b2 = last ? nB : cB + (size_t)(t + 2) * kstep;
            const char* a3 = a2 + kstep; const char* b3 = b2 + kstep;
            if (last && has_next) S.a_ready(nxt);
            if constexpr (SP2) {
            PG8_LDB(B0, 0, 0); PG8_LDB(B1, 0, 1); PG8_SCHED; PG8_LDA(At, 0, 0); PG8_STAGE(PG8_SA(1, 1), a1 + hstep, voffA);
            PG8_WAIT_V(8); PG8_WAIT_L(0); PG8_BAR; PG8_MMA(0, 0, At, B0); PG8_MMA(0, 1, At, B1); PG8_BAR; PG8_SCHED;
            PG8_LDA(At, 0, 1); PG8_STAGE(PG8_SB(0, 0), b2, voffB); PG8_STAGE(PG8_SB(0, 1), b2 + hstep, voffB); PG8_STAGE(PG8_SA(0, 0), a2, voffA);
            PG8_WAIT_V(8); PG8_WAIT_L(0); PG8_BAR; PG8_MMA(1, 0, At, B0); PG8_MMA(1, 1, At, B1); PG8_BAR; PG8_SCHED;
            PG8_LDB(B0, 1, 0); PG8_LDB(B1, 1, 1); PG8_SCHED; PG8_LDA(At, 1, 0); PG8_STAGE(PG8_SA(0, 1), a2 + hstep, voffA);
            PG8_WAIT_V(8); PG8_WAIT_L(0); PG8_BAR; PG8_MMA(0, 0, At, B0); PG8_MMA(0, 1, At, B1); PG8_BAR; PG8_SCHED;
            PG8_LDA(At, 1, 1); PG8_STAGE(PG8_SB(1, 0), b3, voffB); PG8_STAGE(PG8_SB(1, 1), b3 + hstep, voffB); PG8_STAGE(PG8_SA(1, 0), a3, voffA);
            PG8_WAIT_V(8); PG8_WAIT_L(0); PG8_BAR; PG8_MMA(1, 0, At, B0); PG8_MMA(1, 1, At, B1); PG8_BAR; PG8_SCHED;
            } else {
            PG8_LDB(B0, 0, 0); PG8_SCHED; PG8_LDA(At, 0, 0); PG8_STAGE(PG8_SA(1, 1), a1 + hstep, voffA);
            PG8_WAIT_L(8); PG8_BAR; PG8_WAIT_L(0); PG8_MMA(0, 0, At, B0); PG8_BAR; PG8_SCHED;
            PG8_LDB(B1, 0, 1); PG8_STAGE(PG8_SB(0, 0), b2, voffB);
            PG8_BAR; PG8_WAIT_L(0); PG8_MMA(0, 1, At, B1); PG8_BAR;
            PG8_LDA(At, 0, 1); PG8_STAGE(PG8_SA(0, 0), a2, voffA);
            PG8_BAR; PG8_WAIT_L(0); PG8_MMA(1, 0, At, B0); PG8_BAR; PG8_SCHED;
            PG8_STAGE(PG8_SB(0, 1), b2 + hstep, voffB);
            PG8_WAIT_V(6); PG8_BAR; PG8_MMA(1, 1, At, B1); PG8_BAR;
            PG8_LDB(B0, 1, 0); PG8_SCHED; PG8_LDA(At, 1, 0); PG8_STAGE(PG8_SA(0, 1), a2 + hstep, voffA);
            PG8_WAIT_L(8); PG8_BAR; PG8_WAIT_L(0); PG8_MMA(0, 0, At, B0); PG8_BAR; PG8_SCHED;
            PG8_LDB(B1, 1, 1); PG8_STAGE(PG8_SB(1, 0), b3, voffB);
            PG8_BAR; PG8_WAIT_L(0); PG8_MMA(0, 1, At, B1); PG8_BAR;
            PG8_LDA(At, 1, 1); PG8_STAGE(PG8_SA(1, 0), a3, voffA);
            PG8_BAR; PG8_WAIT_L(0); PG8_MMA(1, 0, At, B0); PG8_BAR; PG8_SCHED;
            PG8_STAGE(PG8_SB(1, 1), b3 + hstep, voffB);
            PG8_WAIT_V(6); PG8_BAR; PG8_MMA(1, 1, At, B1); PG8_BAR;
            }
        }
        if constexpr (ALIGN_EPI) { if (wr == 0) PG8_BAR; }
        if constexpr (!Epi::AFTER_DRAIN) { E(acc, cur, wr, wc, fr, fq); S.done(cur); }
        if (!has_next) break;
#pragma unroll
        for (int a = 0; a < 2; ++a)
#pragma unroll
            for (int b = 0; b < 2; ++b)
#pragma unroll
                for (int m = 0; m < 4; ++m)
#pragma unroll
                    for (int n = 0; n < 2; ++n) acc[a][b][m][n] = (f32x4){0.f, 0.f, 0.f, 0.f};
        cur = nxt; cA = nA; cB = nB; ++ui;
        if constexpr (ALIGN_EPI) { if (wr == 1) PG8_BAR; }
    }
    PG8_WAIT_V(0);
    if constexpr (!ALIGN_EPI) { if (wr == 0) PG8_BAR; }
    PG8_BAR;
#undef PG8_SA
#undef PG8_SB
#undef PG8_STAGE
#undef PG8_LDA
#undef PG8_LDB
#undef PG8_MMA
#undef PG8_WAIT_V
#undef PG8_WAIT_L
#undef PG8_BAR
#undef PG8_SCHED
}
template <class Epi, class Sched, bool A=false, bool B=false> __device__ __forceinline__ void gemm_dummy(PG8_LAS unsigned char* lds, const Gemm g, const Sched& S, const Epi& E) {}
}

constexpr bool G_ALIGN = true, G_SP2 = true;
constexpr int LDS_BYTES = 147456;

struct Params {
    const float* x; const float* c; const float* w_mod; const float* b_mod;
    const float* f1g; const float* f1u; const float* f1d; const float* w_in; const float* w_out;
    const float* qng; const float* kng; const float* hng; const float* lbl;
    const float* f2g; const float* f2u; const float* f2d;
    float* out; unsigned char* ws;
};

template <class T> DI T* lau(T* p) { asm volatile("" : "+s"(p)); return p; }
DI float shx(float v, int o, int lane) { return __int_as_float(__builtin_amdgcn_ds_bpermute((lane ^ o) << 2, __float_as_int(v))); }
DI float wave_sum(float v, int lane) {
#pragma unroll
    for (int o = 1; o < 64; o <<= 1) v += shx(v, o, lane);
    return v;
}

DI void transpose_item(const float* W, int K, int N, bf16_t* WT, int mode, float* scr, int item, int lane) {
    const int nblk = N / 32, kb = item / nblk, nb = item % nblk, k0 = 64 * kb, n0 = 32 * nb;
    const int drow0 = (mode == 0) ? n0 : ((n0 >> 7) * 256 + (n0 & 127) + (mode == 2 ? 128 : 0));
#pragma unroll 8
    for (int i = 0; i < 32; ++i) { const int kk = 2 * i + (lane >> 5); scr[kk * 33 + (lane & 31)] = W[(size_t)(k0 + kk) * N + n0 + (lane & 31)]; }
    LDS_WAIT(); asm volatile("" ::: "memory");
    const int cch = lane & 7;
#pragma unroll
    for (int j = 0; j < 4; ++j) { const int n = (lane >> 3) + 8 * j; const float* s = scr + (8 * cch) * 33 + n;
        u32x4 o; o.x = pk2(s[0 * 33], s[1 * 33]); o.y = pk2(s[2 * 33], s[3 * 33]); o.z = pk2(s[4 * 33], s[5 * 33]); o.w = pk2(s[6 * 33], s[7 * 33]);
        *(u32x4*)(WT + (size_t)(drow0 + n) * K + k0 + 8 * cch) = o; }
    LDS_WAIT(); asm volatile("" ::: "memory");
}

DI void phase_prep(const Params& p, unsigned char* lds, int gw, int NGW, int wave, int lane) {
    float* scr = (float*)(lds + wave * 16384);
    constexpr int I_G = (D_MODEL / 64) * (D_FF / 32);
    constexpr int I_D = (D_FF / 64) * (D_MODEL / 32);
    constexpr int I_IN = (D_MODEL / 64) * (PW / 32);
    constexpr int I_OUT = (D_MODEL / 64) * (D_MODEL / 32);
    constexpr int I_LAYER = 4 * I_G + 2 * I_D + I_IN + I_OUT;
    constexpr int I_MOD = DEPTH * (NMOD / 64);
    constexpr int NITEMS = I_MOD + 1 + DEPTH * I_LAYER;
    for (int it = gw; it < NITEMS; it += NGW) {
        if (it < I_MOD) {
            const int l = it / (NMOD / 64), n = (it % (NMOD / 64)) * 64 + lane;
            for (int k = lane; k < 2 * D_MODEL; k += 64) scr[k] = silu_f(p.c[k]);
            LDS_WAIT(); asm volatile("" ::: "memory");
            const float* W = p.w_mod + (size_t)l * D_MODEL * NMOD + n;
            float a0 = 0.f, a1 = 0.f;
#pragma unroll 8
            for (int k = 0; k < D_MODEL; ++k) { const float w = W[(size_t)k * NMOD]; a0 += scr[k] * w; a1 += scr[D_MODEL + k] * w; }
            const float bm = p.b_mod[l * NMOD + n];
            float* mod = (float*)(p.ws + WS_MOD);
            mod[(l * 2 + 0) * NMOD + n] = a0 + bm; mod[(l * 2 + 1) * NMOD + n] = a1 + bm;
            LDS_WAIT(); asm volatile("" ::: "memory");
            continue;
        }
        if (it == I_MOD) {
            float* lb = (float*)(p.ws + WS_LB);
            for (int i = lane; i < 512; i += 64) { const float l0 = p.lbl[i], l1 = p.lbl[512 + i]; const float mx = fmaxf(l0, l1);
                const float e0 = __expf(l0 - mx), e1 = __expf(l1 - mx); const float s0 = e0 / (e0 + e1), s1 = e1 / (e0 + e1);
                lb[i] = fminf(fmaxf(s0 - s0, 0.f), 1.0f - EPS); lb[512 + i] = fminf(fmaxf((s0 + s1) - s0, 0.f), 1.0f - EPS); }
            continue;
        }
        int r = it - I_MOD - 1; const int l = r / I_LAYER; r -= l * I_LAYER;
        bf16_t* wl = (bf16_t*)(p.ws + WS_WEIGHTS + (size_t)l * WL_SIZE);
        const size_t o_gu = (size_t)l * D_MODEL * D_FF, o_in = (size_t)l * D_MODEL * PW, o_out = (size_t)l * D_MODEL * D_MODEL;
        if (r < I_G) { transpose_item(p.f1g + o_gu, D_MODEL, D_FF, wl + WL_GU1 / 2, 1, scr, r, lane); continue; } r -= I_G;
        if (r < I_G) { transpose_item(p.f1u + o_gu, D_MODEL, D_FF, wl + WL_GU1 / 2, 2, scr, r, lane); continue; } r -= I_G;
        if (r < I_D) { transpose_item(p.f1d + o_gu, D_FF, D_MODEL, wl + WL_DN1 / 2, 0, scr, r, lane); continue; } r -= I_D;
        if (r < I_IN) { transpose_item(p.w_in + o_in, D_MODEL, PW, wl + WL_IN / 2, 0, scr, r, lane); continue; } r -= I_IN;
        if (r < I_OUT) { transpose_item(p.w_out + o_out, D_MODEL, D_MODEL, wl + WL_OUT / 2, 0, scr, r, lane); continue; } r -= I_OUT;
        if (r < I_G) { transpose_item(p.f2g + o_gu, D_MODEL, D_FF, wl + WL_GU2 / 2, 1, scr, r, lane); continue; } r -= I_G;
        if (r < I_G) { transpose_item(p.f2u + o_gu, D_MODEL, D_FF, wl + WL_GU2 / 2, 2, scr, r, lane); continue; } r -= I_G;
        transpose_item(p.f2d + o_gu, D_FF, D_MODEL, wl + WL_DN2 / 2, 0, scr, r, lane);
    }
}

DI void phase_norm(const float* X, const float* sh, const float* sc, bf16_t* HB, int gw, int NGW, int lane) {
    for (int m = gw; m < M_TOK; m += NGW) {
        const int b = m / SEQ;
        const f32x4* xr = (const f32x4*)(X + (size_t)m * D_MODEL) + lane;
        f32x4 v[4]; float s = 0.f;
#pragma unroll
        for (int j = 0; j < 4; ++j) { v[j] = xr[64 * j]; s += (v[j].x * v[j].x + v[j].y * v[j].y) + (v[j].z * v[j].z + v[j].w * v[j].w); }
        const float r = 1.0f / sqrtf(wave_sum(s, lane) * (1.0f / D_MODEL) + EPS);
        u32x2* o8 = (u32x2*)(HB + (size_t)m * D_MODEL) + lane;
#pragma unroll
        for (int j = 0; j < 4; ++j) {
            const f32x4 scv = *((const f32x4*)(sc + (size_t)b * NMOD) + lane + 64 * j), shv = *((const f32x4*)(sh + (size_t)b * NMOD) + lane + 64 * j);
            const f32x4 h = v[j] * r * (scv + 1.0f) + shv;
            u32x2 w; w.x = pk2(h.x, h.y); w.y = pk2(h.z, h.w); o8[64 * j] = w; }
    }
}

DI void sb_unit(const bf16_t* proj, bf16_t* Y, int b, int hd, int qt, int lane) {
    const int q = lane & 31, hh = lane >> 5;
    const size_t rowbase = (size_t)b * SEQ;
    const bf16_t* qp = proj + (rowbase + qt * 32 + q) * PW + C_QA + hd * 64 + 8 * hh;
    bf16x8 qf[4];
#pragma unroll
    for (int ks = 0; ks < 4; ++ks) qf[ks] = *(const bf16x8*)(qp + 16 * ks);
    f16x8 tf[2];
#pragma unroll
    for (int ks = 0; ks < 2; ++ks)
#pragma unroll
        for (int j = 0; j < 8; ++j) tf[ks][j] = (krow(ks, hh, j) > q) ? (_Float16)1.0f : (_Float16)0.0f;
    f32x16 o0, o1;
#pragma unroll
    for (int i = 0; i < 16; ++i) { o0[i] = 0.f; o1[i] = 0.f; }
    float carry = 0.f;
    const float SC = 0.125f * LOG2E;
    for (int kt = qt; kt >= 0; --kt) {
        const bf16_t* kp = proj + (rowbase + kt * 32 + q) * PW + C_KA + hd * 64 + 8 * hh;
        f32x16 S;
#pragma unroll
        for (int i = 0; i < 16; ++i) S[i] = 0.f;
#pragma unroll
        for (int ks = 0; ks < 4; ++ks) S = MFMA_BF16(*(const bf16x8*)(kp + 16 * ks), qf[ks], S);
        const bf16_t* vp = proj + (rowbase + kt * 32) * PW + C_VA + hd * 64 + q;
        bf16x8 vf[2][2];
#pragma unroll
        for (int ks = 0; ks < 2; ++ks)
#pragma unroll
            for (int j = 0; j < 8; ++j) { const bf16_t* r = vp + (size_t)krow(ks, hh, j) * PW; vf[0][ks][j] = (short)r[0]; vf[1][ks][j] = (short)r[32]; }
        const bool diag = (kt == qt);
        float lnb[16], lw[16]; float tot = 0.f;
#pragma unroll
        for (int i = 0; i < 16; ++i) {
            const float z2 = fminf(S[i] * SC, 100.f);
            const float sp = flog2(1.0f + fexp2(z2));
            const bool valid = !diag || (crow(i, hh) < q);
            lnb[i] = valid ? -sp : 0.f; lw[i] = z2 - sp; tot += lnb[i];
        }
        tot += shx(tot, 32, lane);
        f16x8 lf[2];
#pragma unroll
        for (int ks = 0; ks < 2; ++ks)
#pragma unroll
            for (int j = 0; j < 8; ++j) lf[ks][j] = (_Float16)lnb[8 * ks + j];
        f32x16 T;
#pragma unroll
        for (int i = 0; i < 16; ++i) T[i] = 0.f;
#pragma unroll
        for (int ks = 0; ks < 2; ++ks) T = MFMA_F16(tf[ks], lf[ks], T);
        unsigned pw[8];
#pragma unroll
        for (int i = 0; i < 16; i += 2) {
            const bool v0 = !diag || (crow(i, hh) < q), v1 = !diag || (crow(i + 1, hh) < q);
            const float w0 = v0 ? fexp2(lw[i] + T[i] + carry) : 0.f, w1 = v1 ? fexp2(lw[i + 1] + T[i + 1] + carry) : 0.f;
            pw[i >> 1] = pk2(w0, w1);
        }
        bf16x8 pf[2];
        pf[0] = __builtin_bit_cast(bf16x8, (u32x4){pw[0], pw[1], pw[2], pw[3]});
        pf[1] = __builtin_bit_cast(bf16x8, (u32x4){pw[4], pw[5], pw[6], pw[7]});
#pragma unroll
        for (int ks = 0; ks < 2; ++ks) { o0 = MFMA_BF16(vf[0][ks], pf[ks], o0); o1 = MFMA_BF16(vf[1][ks], pf[ks], o1); }
        carry += tot;
        if (__all(carry < -160.f)) break;
    }
    bf16_t* yp = Y + (rowbase + qt * 32 + q) * D_MODEL + hd * 64 + 4 * hh;
#pragma unroll
    for (int g = 0; g < 4; ++g) {
        u32x2 w0; w0.x = pk2(o0[4 * g], o0[4 * g + 1]); w0.y = pk2(o0[4 * g + 2], o0[4 * g + 3]);
        u32x2 w1; w1.x = pk2(o1[4 * g], o1[4 * g + 1]); w1.y = pk2(o1[4 * g + 2], o1[4 * g + 3]);
        *(u32x2*)(yp + 8 * g) = w0; *(u32x2*)(yp + 32 + 8 * g) = w1;
    }
}

DI void qkprep_token(bf16_t* proj, const float* qg, const float* kg, int m, int lane) {
    const int j = lane & 31, which = lane >> 5;
    const int pos = m % SEQ;
    const float inv_freq = exp2f(-(float)j * (13.287712379549449f / 32.0f));
    const float ang = (float)pos * inv_freq;
    double t = (double)ang * 0.15915494309189535; t -= rint(t);
    const float sn = __builtin_amdgcn_sinf((float)t), cs = __builtin_amdgcn_cosf((float)t);
    const float* g = which ? kg : qg;
    const float g1 = g[j], g2 = g[j + 32];
    const float osc = which ? 1.0f : 0.125f * LOG2E;
    bf16_t* row = proj + (size_t)m * PW + (which ? C_KD : C_QD);
#pragma unroll
    for (int hd = 0; hd < 4; ++hd) {
        const float x1 = bf2f(row[hd * 64 + j]), x2 = bf2f(row[hd * 64 + 32 + j]);
        float ss = x1 * x1 + x2 * x2;
#pragma unroll
        for (int o = 1; o < 32; o <<= 1) ss += shx(ss, o, lane);
        const float r = 1.0f / sqrtf(ss * (1.0f / 64.0f) + EPS);
        const float y1 = x1 * r * g1, y2 = x2 * r * g2;
        const float o1 = (y1 * cs - y2 * sn) * osc, o2 = (y2 * cs + y1 * sn) * osc;
        row[hd * 64 + j] = (bf16_t)(pk2(o1, 0.f) & 0xffffu); row[hd * 64 + 32 + j] = (bf16_t)(pk2(o2, 0.f) & 0xffffu);
    }
}

DI void dil_unit(const bf16_t* proj, bf16_t* pnum, float* pden, int b, int hd, int pat, int rho, int jt, float m2, int lane) {
    const int r = 1 << (2 * pat);
    const int q = lane & 31, hh = lane >> 5;
    const size_t rowbase = (size_t)b * SEQ;
    const size_t rowq = rowbase + (size_t)(32 * jt + q) * r + rho;
    const bf16_t* qp = proj + rowq * PW + C_QD + hd * 64 + 8 * hh;
    bf16x8 qf[4];
#pragma unroll
    for (int ks = 0; ks < 4; ++ks) qf[ks] = *(const bf16x8*)(qp + 16 * ks);
    f32x16 o0, o1;
#pragma unroll
    for (int i = 0; i < 16; ++i) { o0[i] = 0.f; o1[i] = 0.f; }
    float den = 0.f;
    const int kt0 = (jt - 4) > 0 ? (jt - 4) : 0;
    for (int kt = kt0; kt <= jt; ++kt) {
        const bf16_t* kp = proj + (rowbase + (size_t)(32 * kt + q) * r + rho) * PW + C_KD + hd * 64 + 8 * hh;
        f32x16 S;
#pragma unroll
        for (int i = 0; i < 16; ++i) S[i] = 0.f;
#pragma unroll
        for (int ks = 0; ks < 4; ++ks) S = MFMA_BF16(*(const bf16x8*)(kp + 16 * ks), qf[ks], S);
        const bf16_t* vp = proj + (rowbase + (size_t)(32 * kt) * r + rho) * PW + C_VD + hd * 64 + q;
        bf16x8 vf[2][2];
#pragma unroll
        for (int ks = 0; ks < 2; ++ks)
#pragma unroll
            for (int j = 0; j < 8; ++j) { const bf16_t* rr = vp + (size_t)(krow(ks, hh, j) * r) * PW; vf[0][ks][j] = (short)rr[0]; vf[1][ks][j] = (short)rr[32]; }
        const int dbase = 32 * (jt - kt) + q;
        unsigned pw[8];
#pragma unroll
        for (int i = 0; i < 16; i += 2) {
            const int d0 = dbase - crow(i, hh), d1 = dbase - crow(i + 1, hh);
            const float p0 = (d0 >= 0 && d0 <= 128) ? fexp2(S[i] - m2) : 0.f, p1 = (d1 >= 0 && d1 <= 128) ? fexp2(S[i + 1] - m2) : 0.f;
            den += p0 + p1; pw[i >> 1] = pk2(p0, p1);
        }
        bf16x8 pf[2];
        pf[0] = __builtin_bit_cast(bf16x8, (u32x4){pw[0], pw[1], pw[2], pw[3]});
        pf[1] = __builtin_bit_cast(bf16x8, (u32x4){pw[4], pw[5], pw[6], pw[7]});
#pragma unroll
        for (int ks = 0; ks < 2; ++ks) { o0 = MFMA_BF16(vf[0][ks], pf[ks], o0); o1 = MFMA_BF16(vf[1][ks], pf[ks], o1); }
    }
    den += shx(den, 32, lane);
    bf16_t* np = pnum + ((size_t)pat * M_TOK + rowq) * 256 + hd * 64 + 4 * hh;
#pragma unroll
    for (int g = 0; g < 4; ++g) {
        u32x2 w0; w0.x = pk2(o0[4 * g], o0[4 * g + 1]); w0.y = pk2(o0[4 * g + 2], o0[4 * g + 3]);
        u32x2 w1; w1.x = pk2(o1[4 * g], o1[4 * g + 1]); w1.y = pk2(o1[4 * g + 2], o1[4 * g + 3]);
        *(u32x2*)(np + 8 * g) = w0; *(u32x2*)(np + 32 + 8 * g) = w1;
    }
    if (hh == 0) pden[((size_t)pat * M_TOK + rowq) * 4 + hd] = den;
}

DI void dil_merge_row(const bf16_t* pnum, const float* pden, bf16_t* Y, int m, int lane) {
    float n0 = 0.f, n1 = 0.f, n2 = 0.f, n3 = 0.f, d = 0.f;
#pragma unroll
    for (int p = 0; p < 3; ++p) {
        const u32x2 v = *(const u32x2*)(pnum + ((size_t)p * M_TOK + m) * 256 + 4 * lane);
        n0 += bflo(v.x); n1 += bfhi(v.x); n2 += bflo(v.y); n3 += bfhi(v.y);
        d += pden[((size_t)p * M_TOK + m) * 4 + (lane >> 4)];
    }
    const float rd = 1.0f / d;
    u32x2 w; w.x = pk2(n0 * rd, n1 * rd); w.y = pk2(n2 * rd, n3 * rd);
    *(u32x2*)(Y + (size_t)m * D_MODEL + 256 + 4 * lane) = w;
}

constexpr int H_LG = 0;
constexpr int H_QA = 32768;
constexpr int H_KT = H_QA + 17408;
constexpr int H_QB = H_KT + 17408;
constexpr int H_VT = H_QB + 17408;
constexpr int H_KH = H_VT + 18432;
constexpr int H_RED = H_KH + 18432;
static_assert(H_RED + 1024 <= 131072, "HGRN LDS map");

DI void hgrn_front(unsigned char* lds, const bf16_t* proj, const float* lbv  , size_t R0, int hd, int tid) {
    float* LG = (float*)(lds + H_LG);
#pragma unroll
    for (int it = 0; it < 2; ++it) {
        const int c = tid + it * 512, row = c >> 4, ch = c & 15;
        const u32x4 zz = *(const u32x4*)(proj + (R0 + row) * PW + C_FH + hd * 128 + ch * 8);
        const unsigned zw[4] = {zz.x, zz.y, zz.z, zz.w};
#pragma unroll
        for (int e = 0; e < 8; ++e) {
            const float z = (e & 1) ? bfhi(zw[e >> 1]) : bflo(zw[e >> 1]);
            const float lb = lbv[ch * 8 + e];
            const float sig = frcp(1.0f + __expf(-z));
            const float f = fmaxf(lb + (1.0f - lb) * sig, 1e-30f);
            LG[row * 128 + ch * 8 + e] = __logf(f);
        }
    }
    __syncthreads();
    const int d = tid & 127, seg = tid >> 7;
    float run = 0.f;
#pragma unroll
    for (int i = 0; i < 16; ++i) { run += LG[(16 * seg + i) * 128 + d]; LG[(16 * seg + i) * 128 + d] = run; }
    __syncthreads();
    float off = 0.f;
    for (int s2 = 0; s2 < seg; ++s2) off += LG[(16 * s2 + 15) * 128 + d];
    __syncthreads();
    if (seg > 0) {
#pragma unroll
        for (int i = 0; i < 16; ++i) LG[(16 * seg + i) * 128 + d] += off;
    }
    __syncthreads();
}

DI void hgrn_load_vt(unsigned char* lds, const bf16_t* proj, size_t R0, int col0, int tid) {
    const int v = tid & 127, seg = tid >> 7;
    const bf16_t* src = proj + (R0 + 16 * seg) * PW + col0 + v;
    unsigned w[8];
#pragma unroll
    for (int i = 0; i < 8; ++i) w[i] = (unsigned)src[(size_t)(2 * i) * PW] | ((unsigned)src[(size_t)(2 * i + 1) * PW] << 16);
    u32x4* dst = (u32x4*)(lds + H_VT + (v * 72 + 16 * seg) * 2);
    dst[0] = (u32x4){w[0], w[1], w[2], w[3]}; dst[1] = (u32x4){w[4], w[5], w[6], w[7]};
}

DI void hgrn_h1_unit(unsigned char* lds, const bf16_t* proj, const float* lball, bf16_t* ST, float* DEC, int unit, int tid, int wave, int lane) {
    const int bh = unit / NCHUNK, n = unit % NCHUNK, b = bh >> 2, hd = bh & 3;
    const size_t R0 = (size_t)b * SEQ + (size_t)n * 64;
    hgrn_front(lds, proj, lball + hd * 128, R0, hd, tid);
    const float* LG = (const float*)(lds + H_LG);
    {
        const int d = tid & 127, seg = tid >> 7;
        const float glast = LG[63 * 128 + d];
        float gprev = (seg == 0) ? 0.f : LG[(16 * seg - 1) * 128 + d];
        unsigned w[8]; float kh[16];
#pragma unroll
        for (int i = 0; i < 16; ++i) { const float g = LG[(16 * seg + i) * 128 + d]; const float k = 1.0f - __expf(g - gprev); gprev = g; kh[i] = k * __expf(glast - g); }
#pragma unroll
        for (int i = 0; i < 8; ++i) w[i] = pk2(kh[2 * i], kh[2 * i + 1]);
        u32x4* dst = (u32x4*)(lds + H_KH + (d * 72 + 16 * seg) * 2);
        dst[0] = (u32x4){w[0], w[1], w[2], w[3]}; dst[1] = (u32x4){w[4], w[5], w[6], w[7]};
        if (seg == 0) DEC[((size_t)bh * NCHUNK + n) * 128 + d] = __expf(glast);
    }
    hgrn_load_vt(lds, proj, R0, C_IH + hd * 128, tid);
    __syncthreads();
    {
        const int vt = wave >> 1, dt0 = 2 * (wave & 1), l31 = lane & 31, hh = lane >> 5;
        f32x16 a0, a1;
#pragma unroll
        for (int i = 0; i < 16; ++i) { a0[i] = 0.f; a1[i] = 0.f; }
#pragma unroll
        for (int ks = 0; ks < 4; ++ks) {
            const bf16x8 af = *(const bf16x8*)(lds + H_VT + ((32 * vt + l31) * 72 + 16 * ks + 8 * hh) * 2);
            const bf16x8 b0 = *(const bf16x8*)(lds + H_KH + ((32 * dt0 + l31) * 72 + 16 * ks + 8 * hh) * 2);
            const bf16x8 b1 = *(const bf16x8*)(lds + H_KH + ((32 * (dt0 + 1) + l31) * 72 + 16 * ks + 8 * hh) * 2);
            a0 = MFMA_BF16(af, b0, a0); a1 = MFMA_BF16(af, b1, a1);
        }
        bf16_t* st = ST + ((size_t)bh * NCHUNK + n) * 16384;
#pragma unroll
        for (int i = 0; i < 16; ++i) { const int v = 32 * vt + crow(i, hh);
            st[v * 128 + 32 * dt0 + l31] = (bf16_t)(pk2(a0[i], 0.f) & 0xffffu); st[v * 128 + 32 * (dt0 + 1) + l31] = (bf16_t)(pk2(a1[i], 0.f) & 0xffffu); }
    }
    __syncthreads();
}

DI void hgrn_scan(bf16_t* ST, const float* DEC, int gtid  ) {
    const int bh = gtid >> 14, e = gtid & 16383, d = e & 127;
    bf16_t* st = ST + (size_t)bh * NCHUNK * 16384 + e;
    const float* dc = DEC + (size_t)bh * NCHUNK * 128 + d;
    float s = 0.f;
    for (int n0 = 0; n0 < NCHUNK; n0 += 8) {
        float u[8], dd[8];
#pragma unroll
        for (int i = 0; i < 8; ++i) { u[i] = bf2f(st[(size_t)(n0 + i) * 16384]); dd[i] = dc[(n0 + i) * 128]; }
#pragma unroll
        for (int i = 0; i < 8; ++i) { st[(size_t)(n0 + i) * 16384] = (bf16_t)(pk2(s, 0.f) & 0xffffu); s = dd[i] * s + u[i]; }
    }
}

DI void hgrn_h3_unit(unsigned char* lds, const bf16_t* proj, const float* lball, const bf16_t* ST, const float* hng, bf16_t* Y, int unit, int tid, int wave, int lane) {
    const int bh = unit / NCHUNK, n = unit % NCHUNK, b = bh >> 2, hd = bh & 3;
    const size_t R0 = (size_t)b * SEQ + (size_t)n * 64;
    hgrn_front(lds, proj, lball + hd * 128, R0, hd, tid);
    const float* LG = (const float*)(lds + H_LG);
    {
        const int d = tid & 127, seg = tid >> 7;
        const float gm = LG[31 * 128 + d];
        float gprev = (seg == 0) ? 0.f : LG[(16 * seg - 1) * 128 + d];
        bf16_t* QA = (bf16_t*)(lds + H_QA); bf16_t* KT = (bf16_t*)(lds + H_KT); bf16_t* QB = (bf16_t*)(lds + H_QB);
        const bf16_t* qsrc = proj + (R0 + 16 * seg) * PW + C_QH + hd * 128 + d;
#pragma unroll
        for (int i = 0; i < 16; ++i) {
            const int t = 16 * seg + i;
            const float g = LG[t * 128 + d]; const float k = 1.0f - __expf(g - gprev); gprev = g;
            const float qv = silu_f(bf2f(qsrc[(size_t)i * PW]));
            const float e1 = __expf(fminf(g - gm, 80.f)), e2 = __expf(fminf(gm - g, 80.f)), e3 = __expf(g);
            QA[t * 136 + d] = (bf16_t)(pk2(qv * e1, 0.f) & 0xffffu);
            KT[t * 136 + d] = (bf16_t)(pk2(k * e2, 0.f) & 0xffffu);
            QB[t * 136 + d] = (bf16_t)(pk2(qv * e3, 0.f) & 0xffffu);
        }
    }
    hgrn_load_vt(lds, proj, R0, C_IH + hd * 128, tid);
    __syncthreads();
    const int vt = wave >> 1, ti = wave & 1, l31 = lane & 31, hh = lane >> 5;
    f32x16 acc;
#pragma unroll
    for (int i = 0; i < 16; ++i) acc[i] = 0.f;
    {
        const bf16_t* sp = ST + ((size_t)bh * NCHUNK + n) * 16384 + (32 * vt + l31) * 128 + 8 * hh;
#pragma unroll
        for (int ks = 0; ks < 8; ++ks) {
            const bf16x8 af = *(const bf16x8*)(sp + 16 * ks);
            const bf16x8 bfr = *(const bf16x8*)(lds + H_QB + ((32 * ti + l31) * 136 + 16 * ks + 8 * hh) * 2);
            acc = MFMA_BF16(af, bfr, acc);
        }
    }
    for (int si = 0; si <= ti; ++si) {
        f32x16 Sc;
#pragma unroll
        for (int i = 0; i < 16; ++i) Sc[i] = 0.f;
#pragma unroll
        for (int ks = 0; ks < 8; ++ks) {
            const bf16x8 af = *(const bf16x8*)(lds + H_KT + ((32 * si + l31) * 136 + 16 * ks + 8 * hh) * 2);
            const bf16x8 bfr = *(const bf16x8*)(lds + H_QA + ((32 * ti + l31) * 136 + 16 * ks + 8 * hh) * 2);
            Sc = MFMA_BF16(af, bfr, Sc);
        }
        unsigned pw[8];
#pragma unroll
        for (int i = 0; i < 16; i += 2) {
            const bool v0 = (si < ti) || (crow(i, hh) <= l31), v1 = (si < ti) || (crow(i + 1, hh) <= l31);
            pw[i >> 1] = pk2(v0 ? Sc[i] : 0.f, v1 ? Sc[i + 1] : 0.f);
        }
        bf16x8 pf[2];
        pf[0] = __builtin_bit_cast(bf16x8, (u32x4){pw[0], pw[1], pw[2], pw[3]});
        pf[1] = __builtin_bit_cast(bf16x8, (u32x4){pw[4], pw[5], pw[6], pw[7]});
#pragma unroll
        for (int ks = 0; ks < 2; ++ks) {
            const unsigned char* vb = lds + H_VT + ((32 * vt + l31) * 72 + 32 * si + 16 * ks + 4 * hh) * 2;
            const u32x2 lo = *(const u32x2*)vb, hi = *(const u32x2*)(vb + 16);
            const bf16x8 af = __builtin_bit_cast(bf16x8, (u32x4){lo.x, lo.y, hi.x, hi.y});
            acc = MFMA_BF16(af, pf[ks], acc);
        }
    }
    float ss = 0.f;
#pragma unroll
    for (int i = 0; i < 16; ++i) ss += acc[i] * acc[i];
    ss += shx(ss, 32, lane);
    float* RED = (float*)(lds + H_RED);
    if (hh == 0) RED[vt * 64 + 32 * ti + l31] = ss;
    __syncthreads();
    const int t = 32 * ti + l31;
    const float tot = RED[t] + RED[64 + t] + RED[128 + t] + RED[192 + t];
    const float rs = 1.0f / sqrtf(tot * (1.0f / 128.0f) + EPS);
    const bf16_t* gp = proj + (R0 + t) * PW + C_GH + hd * 128 + 32 * vt + 4 * hh;
    bf16_t* yp = Y + (R0 + t) * D_MODEL + 512 + hd * 128 + 32 * vt + 4 * hh;
    const float* gn = hng + 32 * vt + 4 * hh;
#pragma unroll
    for (int g = 0; g < 4; ++g) {
        const u32x2 gv = *(const u32x2*)(gp + 8 * g);
        const f32x4 nn = *(const f32x4*)(gn + 8 * g);
        const float r0 = acc[4 * g] * rs * nn.x * silu_f(bflo(gv.x)), r1 = acc[4 * g + 1] * rs * nn.y * silu_f(bfhi(gv.x));
        const float r2 = acc[4 * g + 2] * rs * nn.z * silu_f(bflo(gv.y)), r3 = acc[4 * g + 3] * rs * nn.w * silu_f(bfhi(gv.y));
        u32x2 w; w.x = pk2(r0, r1); w.y = pk2(r2, r3);
        *(u32x2*)(yp + 8 * g) = w;
    }
    __syncthreads();
}

#define CTX() \
    const Params* kp_ = (const Params*)__builtin_amdgcn_kernarg_segment_ptr(); asm volatile("" : "+s"(kp_)); const Params& p = *kp_; \
    int tid_ = threadIdx.x; asm volatile("" : "+v"(tid_)); const int tid = tid_, lane = tid & 63, wave = __builtin_amdgcn_readfirstlane(tid >> 6); \
    const int G = gridDim.x, bid = blockIdx.x; const int gw = wave * G + bid, NGW = G * 8; unsigned char* ws = p.ws; \
    (void)lane; (void)gw; (void)NGW; (void)ws; (void)tid;
#define WLP(l) ((const bf16_t*)(ws + WS_WEIGHTS + (size_t)(l) * WL_SIZE))
#define MLP(l) ((const float*)(ws + WS_MOD) + (size_t)(l) * 2 * NMOD)

template <class Epi> DI void run_gemm(PG8_LAS unsigned char* glds, const bf16_t* A, const bf16_t* Bt, int N, int K, const Epi& E) {
    int G_ = gridDim.x, b_ = blockIdx.x; asm volatile("" : "+s"(G_), "+s"(b_));
    pg8::Gemm g{A, Bt, M_TOK, N, K}; pg8::StaticOrder S; S.init(M_TOK, N, G_, b_);
    GEMMCALL<Epi, pg8::StaticOrder, G_ALIGN, G_SP2>(glds, g, S, E);
}

__global__ void __launch_bounds__(512) fwd_kernel(Params p_unused) {
    extern __shared__ __attribute__((aligned(16))) unsigned char lds[];
    cg::grid_group grid = cg::this_grid();
    PG8_LAS unsigned char* glds = (PG8_LAS unsigned char*)lds;
#ifndef SKIP_PREP
    { CTX(); phase_prep(p, lds, gw, NGW, wave, lane); }
#endif
    grid.sync();

#pragma unroll 1
    for (int l = 0; l < DEPTH; ++l) {
        { CTX(); const float* ml = MLP(l); phase_norm((l == 0) ? p.x : p.out, ml + 0 * D_MODEL, ml + 1 * D_MODEL, (bf16_t*)(ws + WS_HB), gw, NGW, lane); }
        grid.sync();
        { CTX(); run_gemm(glds, (const bf16_t*)(ws + WS_HB), WLP(l) + WL_GU1 / 2, 2 * D_FF, D_MODEL, pg8::EpiSwiGLU{(bf16_t*)(ws + WS_ACT), D_FF}); }
        grid.sync();
        { CTX(); run_gemm(glds, (const bf16_t*)(ws + WS_ACT), WLP(l) + WL_DN1 / 2, D_MODEL, D_FF, pg8::EpiRes{(l == 0) ? p.x : p.out, p.out, MLP(l) + 2 * D_MODEL, NMOD, 0.5f}); }
        grid.sync();
        { CTX(); const float* ml = MLP(l); phase_norm(p.out, ml + 3 * D_MODEL, ml + 4 * D_MODEL, (bf16_t*)(ws + WS_HB), gw, NGW, lane); }
        grid.sync();
        { CTX(); run_gemm(glds, (const bf16_t*)(ws + WS_HB), WLP(l) + WL_IN / 2, PW, D_MODEL, pg8::EpiBf16{(bf16_t*)(ws + WS_ACT), PW}); }
        grid.sync();
#ifndef SKIP_H1
        { CTX(); for (int u = bid; u < 8 * NCHUNK; u += G) hgrn_h1_unit(lds, (const bf16_t*)(ws + WS_ACT), (const float*)(ws + WS_LB) + l * 512, (bf16_t*)(ws + WS_ST), (float*)(ws + WS_DEC), u, tid, wave, lane); }
#endif
#ifndef SKIP_QK
        { CTX(); for (int m = gw; m < M_TOK; m += NGW) qkprep_token((bf16_t*)(ws + WS_ACT), p.qng + l * 64, p.kng + l * 64, m, lane); }
#endif
#ifndef SKIP_SB
        { CTX(); for (int u = gw; u < 8 * (SEQ / 32); u += NGW) { const int bh = u / (SEQ / 32), qt = (SEQ / 32 - 1) - u % (SEQ / 32); sb_unit((const bf16_t*)(ws + WS_ACT), (bf16_t*)(ws + WS_Y), bh >> 2, bh & 3, qt, lane); } }
#endif
        grid.sync();
#ifndef SKIP_SCAN
        { CTX(); hgrn_scan((bf16_t*)(ws + WS_ST), (const float*)(ws + WS_DEC), bid * 512 + tid); }
#endif
#ifndef SKIP_DIL
        { CTX();
            float gq = fabsf(p.qng[l * 64 + lane]), gk = fabsf(p.kng[l * 64 + lane]);
#pragma unroll
            for (int o = 1; o < 64; o <<= 1) { gq = fmaxf(gq, shx(gq, o, lane)); gk = fmaxf(gk, shx(gk, o, lane)); }
            const float m2 = 8.0f * gq * gk * LOG2E;
            for (int u = gw; u < 3 * 8 * 512; u += NGW) {
                const int pat = u / 4096, rem = u % 4096, bh = rem / 512, tile = rem % 512;
                const int tpr = 512 >> (2 * pat);
                dil_unit((const bf16_t*)(ws + WS_ACT), (bf16_t*)(ws + WS_PNUM), (float*)(ws + WS_PDEN), bh >> 2, bh & 3, pat, tile / tpr, tile % tpr, m2, lane);
            }
        }
#endif
        grid.sync();
#ifndef SKIP_H3
        { CTX(); for (int u = bid; u < 8 * NCHUNK; u += G) hgrn_h3_unit(lds, (const bf16_t*)(ws + WS_ACT), (const float*)(ws + WS_LB) + l * 512, (const bf16_t*)(ws + WS_ST), p.hng + l * 128, (bf16_t*)(ws + WS_Y), u, tid, wave, lane); }
#endif
        { CTX(); for (int m = gw; m < M_TOK; m += NGW) dil_merge_row((const bf16_t*)(ws + WS_PNUM), (const float*)(ws + WS_PDEN), (bf16_t*)(ws + WS_Y), m, lane); }
        grid.sync();
        { CTX(); run_gemm(glds, (const bf16_t*)(ws + WS_Y), WLP(l) + WL_OUT / 2, D_MODEL, D_MODEL, pg8::EpiRes{p.out, p.out, MLP(l) + 5 * D_MODEL, NMOD, 1.0f}); }
        grid.sync();
        { CTX(); const float* ml = MLP(l); phase_norm(p.out, ml + 6 * D_MODEL, ml + 7 * D_MODEL, (bf16_t*)(ws + WS_HB), gw, NGW, lane); }
        grid.sync();
        { CTX(); run_gemm(glds, (const bf16_t*)(ws + WS_HB), WLP(l) + WL_GU2 / 2, 2 * D_FF, D_MODEL, pg8::EpiSwiGLU{(bf16_t*)(ws + WS_ACT), D_FF}); }
        grid.sync();
        { CTX(); run_gemm(glds, (const bf16_t*)(ws + WS_ACT), WLP(l) + WL_DN2 / 2, D_MODEL, D_FF, pg8::EpiRes{p.out, p.out, MLP(l) + 8 * D_MODEL, NMOD, 0.5f}); }
        grid.sync();
    }
}

extern "C" void kernel_launch(void* const* d_in, const int* in_sizes, int n_in, void* d_out, int out_size, void* d_ws, size_t ws_size, hipStream_t stream) {
    static int grid = 0;
    if (grid == 0) {
        if (n_in != 16 || ws_size < WS_END) { fprintf(stderr, "kernel_launch: unexpected n_in %d / ws %zu\n", n_in, ws_size); grid = -1; return; }
        int dev = 0, cus = 0, per_cu = 0;
        hipGetDevice(&dev);
        hipDeviceGetAttribute(&cus, hipDeviceAttributeMultiprocessorCount, dev);
        if (hipFuncSetAttribute((const void*)fwd_kernel, hipFuncAttributeMaxDynamicSharedMemorySize, LDS_BYTES) != hipSuccess) { fprintf(stderr, "kernel_launch: hipFuncSetAttribute failed\n"); grid = -1; return; }
        if (hipOccupancyMaxActiveBlocksPerMultiprocessor(&per_cu, (const void*)fwd_kernel, 512, LDS_BYTES) != hipSuccess || per_cu < 1) { fprintf(stderr, "kernel_launch: occupancy query gave %d\n", per_cu); per_cu = 1; }
        (void)hipGetLastError();
        grid = cus * per_cu;
    }
    if (grid < 0) return;
    Params p{};
    p.x = (const float*)d_in[0]; p.c = (const float*)d_in[1]; p.w_mod = (const float*)d_in[2]; p.b_mod = (const float*)d_in[3];
    p.f1g = (const float*)d_in[4]; p.f1u = (const float*)d_in[5]; p.f1d = (const float*)d_in[6]; p.w_in = (const float*)d_in[7]; p.w_out = (const float*)d_in[8];
    p.qng = (const float*)d_in[9]; p.kng = (const float*)d_in[10]; p.hng = (const float*)d_in[11]; p.lbl = (const float*)d_in[12];
    p.f2g = (const float*)d_in[13]; p.f2u = (const float*)d_in[14]; p.f2d = (const float*)d_in[15];
    p.out = (float*)d_out; p.ws = (unsigned char*)d_ws;
    void* args[] = {&p};
    hipError_t e = hipLaunchCooperativeKernel((const void*)fwd_kernel, dim3(grid), dim3(512), args, LDS_BYTES, stream);
    if (e != hipSuccess) fprintf(stderr, "cooperative launch failed: %s (grid %d)\n", hipGetErrorString(e), grid);
}
```

```cpp
#include <hip/hip_runtime.h>
#include <hip/hip_cooperative_groups.h>
#include <cstdio>
#include <cstdint>
namespace cg = cooperative_groups;

typedef unsigned short bf16_t;
typedef short bf16x8 __attribute__((ext_vector_type(8)));
typedef _Float16 f16x8 __attribute__((ext_vector_type(8)));
typedef float f32x2 __attribute__((ext_vector_type(2)));
typedef float f32x4 __attribute__((ext_vector_type(4)));
typedef float f32x16 __attribute__((ext_vector_type(16)));
typedef unsigned u32x2 __attribute__((ext_vector_type(2)));
typedef unsigned u32x4 __attribute__((ext_vector_type(4)));
typedef __bf16 bf16x2_t __attribute__((ext_vector_type(2)));

#define DI __device__ __forceinline__
#define LAS __attribute__((address_space(3)))

constexpr int D_MODEL = 1024, BATCH = 2, SEQ = 16384, DEPTH = 2, D_FF = 2816;
constexpr int M_TOK = BATCH * SEQ;
constexpr int PW = 3584;
constexpr int C_QA = 0, C_KA = 256, C_VA = 512, C_QD = 768, C_KD = 1024, C_VD = 1280, C_QH = 1536, C_FH = 2048, C_IH = 2560, C_GH = 3072;
constexpr int NMOD = 9 * D_MODEL;
constexpr float EPS = 1e-6f;
constexpr float LOG2E = 1.4426950408889634f;
constexpr int NCHUNK = SEQ / 64;

constexpr size_t MiB = 1u << 20;
constexpr size_t W_GU = (size_t)2 * D_FF * D_MODEL * 2;
constexpr size_t W_DN = (size_t)D_MODEL * D_FF * 2;
constexpr size_t W_IN = (size_t)PW * D_MODEL * 2;
constexpr size_t W_OUT = (size_t)D_MODEL * D_MODEL * 2;
constexpr size_t WL_GU1 = 0, WL_DN1 = WL_GU1 + W_GU, WL_IN = WL_DN1 + W_DN, WL_OUT = WL_IN + W_IN, WL_GU2 = WL_OUT + W_OUT, WL_DN2 = WL_GU2 + W_GU, WL_SIZE = WL_DN2 + W_DN;
static_assert(WL_SIZE == 44040192, "weights per layer");
constexpr size_t WS_WEIGHTS = 0;
constexpr size_t WS_SMALL = 84 * MiB;
constexpr size_t WS_MOD = WS_SMALL, WS_LB = WS_SMALL + 256 * 1024, WS_BAR = WS_SMALL + 512 * 1024;
constexpr size_t WS_DEC = 85 * MiB;
constexpr size_t WS_HB = 86 * MiB;
constexpr size_t WS_PNUM = WS_HB;
constexpr size_t WS_PDEN = WS_HB + 48 * MiB;
constexpr size_t WS_ACT = 150 * MiB;
constexpr size_t WS_Y = 374 * MiB;
constexpr size_t WS_ST = 438 * MiB;
constexpr size_t WS_END = 502 * MiB;

DI unsigned pk2(float lo, float hi) { f32x2 v = {lo, hi}; bf16x2_t b = __builtin_convertvector(v, bf16x2_t); return __builtin_bit_cast(unsigned, b); }
DI float bf2f(bf16_t b) { return __uint_as_float((unsigned)b << 16); }
DI float bflo(unsigned u) { return __uint_as_float(u << 16); }
DI float bfhi(unsigned u) { return __uint_as_float(u & 0xffff0000u); }
DI int crow(int reg, int h) { return (reg & 3) + 8 * (reg >> 2) + 4 * h; }
DI int krow(int s, int h, int j) { return 16 * s + 8 * (j >> 2) + 4 * h + (j & 3); }
DI float fexp2(float x) { return __builtin_amdgcn_exp2f(x); }
DI float flog2(float x) { return __builtin_amdgcn_logf(x); }
DI float frcp(float x) { return __builtin_amdgcn_rcpf(x); }
DI float silu_f(float g) { return g * frcp(1.0f + fexp2(-g * LOG2E)); }
#define MFMA_BF16(a, b, c) __builtin_amdgcn_mfma_f32_32x32x16_bf16((a), (b), (c), 0, 0, 0)
#define MFMA_F16(a, b, c) __builtin_amdgcn_mfma_f32_32x32x16_f16((a), (b), (c), 0, 0, 0)
#define LDS_WAIT() asm volatile("s_waitcnt lgkmcnt(0)" ::: "memory")

#ifdef SKIP_GEMM
#define GEMMCALL pg8::gemm_dummy
#else
#define GEMMCALL pg8::gemm_phase
#endif
namespace pg8 {
#define PG8_LAS __attribute__((address_space(3)))
constexpr int BM = 256, BK = 64, HALF = 128, HTB = HALF * BK * 2  , STAGE_BYTES = 8 * HTB, NXCD = 8, WGM = 8;

__host__ __device__ __forceinline__ int lds_byte(int r, int c) { const int st = (r >> 4) * 2 + (c >> 5), rr = r & 15, cc = c & 31, ob = rr * 64 + cc * 2; return st * 1024 + (ob ^ (((ob >> 9) & 1) << 5)); }
__host__ __device__ __forceinline__ void stage_rc(int b, int& R, int& C) { const int st = b / 1024, sb = b % 1024, swz = sb ^ (((sb >> 9) & 1) << 5); R = (st >> 1) * 16 + swz / 64; C = (st & 1) * 32 + (swz % 64) / 2; }
__host__ __device__ __forceinline__ int perm32(int rho) { const int n = rho >> 4, i = rho & 15; return 8 * (i >> 2) + 4 * n + (i & 3); }

struct Unit { int pm, pn; };
struct Gemm { const bf16_t* A; const bf16_t* Bt; int M, N, K; };

struct StaticOrder {
    int nM, nN, nwg, G, c;
    __host__ __device__ void init(int M, int N, int G_, int c_) { nM = M / BM; nN = N / BM; nwg = nM * nN; G = G_; c = c_; }
    __host__ __device__ bool next(int i, Unit& u) const {
        const long L = (long)i * G + c; if (L >= nwg) return false;
        int wgid = (int)L; { const int q = nwg / NXCD, r = nwg % NXCD, xcd = wgid % NXCD, off = wgid / NXCD; wgid = (xcd < r ? xcd * (q + 1) : r * (q + 1) + (xcd - r) * q) + off; }
        const int nig = WGM * nN, gid = wgid / nig, fm = gid * WGM, gsz = (nM - fm) < WGM ? (nM - fm) : WGM;
        u.pm = fm + ((wgid % nig) % gsz); u.pn = (wgid % nig) / gsz; return true;
    }
    __device__ __forceinline__ void a_ready(const Unit&) const {}
    __device__ __forceinline__ void done(const Unit&) const {}
};

struct EpiBf16 {
    static constexpr bool PERM = true, AFTER_DRAIN = false;
    bf16_t* O; int ldc;
    __device__ __forceinline__ void operator()(const f32x4 (&acc)[2][2][4][2], const Unit& u, int wr, int wc, int fr, int fq) const {
        const int row0 = u.pm * BM + wr * 64 + fr; const int col0 = u.pn * BM + wc * 32 + 8 * fq;
#pragma unroll
        for (int ai = 0; ai < 2; ++ai)
#pragma unroll
            for (int m = 0; m < 4; ++m) { bf16_t* rowp = O + (size_t)(row0 + ai * HALF + m * 16) * ldc + col0;
#pragma unroll
                for (int bj = 0; bj < 2; ++bj) { const f32x4 v0 = acc[ai][bj][m][0], v1 = acc[ai][bj][m][1];
                    u32x4 w; w.x = pk2(v0[0], v0[1]); w.y = pk2(v0[2], v0[3]); w.z = pk2(v1[0], v1[1]); w.w = pk2(v1[2], v1[3]);
                    *(u32x4*)(rowp + bj * HALF) = w; } }
    }
};
struct EpiSwiGLU {
    static constexpr bool PERM = true, AFTER_DRAIN = false;
    bf16_t* O; int ldc;
    __device__ __forceinline__ void operator()(const f32x4 (&acc)[2][2][4][2], const Unit& u, int wr, int wc, int fr, int fq) const {
        const int row0 = u.pm * BM + wr * 64 + fr; const int col0 = u.pn * HALF + wc * 32 + 8 * fq;
#pragma unroll
        for (int ai = 0; ai < 2; ++ai)
#pragma unroll
            for (int m = 0; m < 4; ++m) { bf16_t* rowp = O + (size_t)(row0 + ai * HALF + m * 16) * ldc + col0;
                const f32x4 g0 = acc[ai][0][m][0], g1 = acc[ai][0][m][1], u0 = acc[ai][1][m][0], u1 = acc[ai][1][m][1];
                float r[8];
#pragma unroll
                for (int e = 0; e < 4; ++e) { r[e] = silu_f(g0[e]) * u0[e]; r[4 + e] = silu_f(g1[e]) * u1[e]; }
                u32x4 w; w.x = pk2(r[0], r[1]); w.y = pk2(r[2], r[3]); w.z = pk2(r[4], r[5]); w.w = pk2(r[6], r[7]);
                *(u32x4*)rowp = w; }
    }
};
struct EpiRes {
    static constexpr bool PERM = true, AFTER_DRAIN = false;
    const float* X; float* Out; const float* gate; int gstride; float coef;
    __device__ __forceinline__ void operator()(const f32x4 (&acc)[2][2][4][2], const Unit& u, int wr, int wc, int fr, int fq) const {
        const int row0 = u.pm * BM + wr * 64 + fr; const int col0 = u.pn * BM + wc * 32 + 8 * fq;
        const float* gp = gate + (size_t)((u.pm * BM) / SEQ) * gstride + col0;
        f32x4 gv[2][2];
#pragma unroll
        for (int bj = 0; bj < 2; ++bj)
#pragma unroll
            for (int n = 0; n < 2; ++n) gv[bj][n] = *(const f32x4*)(gp + bj * HALF + 4 * n) * coef;
#pragma unroll
        for (int ai = 0; ai < 2; ++ai)
#pragma unroll
            for (int m = 0; m < 4; ++m) { const size_t ro = (size_t)(row0 + ai * HALF + m * 16) * D_MODEL + col0;
#pragma unroll
                for (int bj = 0; bj < 2; ++bj)
#pragma unroll
                    for (int n = 0; n < 2; ++n) { const f32x4 xv = *(const f32x4*)(X + ro + bj * HALF + 4 * n);
                        *(f32x4*)(Out + ro + bj * HALF + 4 * n) = xv + gv[bj][n] * acc[ai][bj][m][n]; } }
    }
};

template <class Epi, class Sched, bool ALIGN_EPI = false, bool SP2 = false>
__device__ __forceinline__ void gemm_phase(PG8_LAS unsigned char* lds, const Gemm g, const Sched& S, const Epi& E) {
    int tid_ = threadIdx.x; asm volatile("" : "+v"(tid_));
    const int tid = tid_, wid = __builtin_amdgcn_readfirstlane(tid >> 6), lane = tid & 63, wr = wid >> 2, wc = wid & 3, fr = lane & 15, fq = lane >> 4;
    const int K = g.K, nt = K / BK;
    unsigned voffA[2], voffB[2];
#pragma unroll
    for (int i = 0; i < 2; ++i) { int R, C; stage_rc(tid * 16 + i * 8192, R, C); const int Rb = Epi::PERM ? ((R & ~31) + perm32(R & 31)) : R;
        voffA[i] = (unsigned)(R * K + C) * 2u; voffB[i] = (unsigned)(Rb * K + C) * 2u; }
    const size_t kstep = (size_t)(BK * 2);
    const size_t hstep = (size_t)HALF * K * 2;
    const size_t tstep = 2 * hstep;
    const unsigned ldsw = (unsigned)wid * 1024u;
    const int aoff = lds_byte(wr * 64 + fr, fq * 8), boff = lds_byte(wc * 32 + fr, fq * 8);
#define PG8_SA(b, h) (((b) * 2 + (h)) * HTB)
#define PG8_SB(b, h) ((4 + (b) * 2 + (h)) * HTB)
#define PG8_STAGE(bufoff, gbase, voff) do { _Pragma("unroll") for (int _i = 0; _i < 2; ++_i) \
        __builtin_amdgcn_global_load_lds((const unsigned*)((const char*)(gbase) + (voff)[_i]), (PG8_LAS unsigned*)(lds + (bufoff) + ldsw + _i * 8192), 16, 0, 0); } while (0)
#define PG8_LDA(dst, b, h) do { _Pragma("unroll") for (int m = 0; m < 4; ++m) _Pragma("unroll") for (int k = 0; k < 2; ++k) dst[m][k] = *(const PG8_LAS bf16x8*)(lds + PG8_SA(b, h) + aoff + m * 2048 + k * 1024); } while (0)
#define PG8_LDB(dst, b, h) do { _Pragma("unroll") for (int n = 0; n < 2; ++n) _Pragma("unroll") for (int k = 0; k < 2; ++k) dst[n][k] = *(const PG8_LAS bf16x8*)(lds + PG8_SB(b, h) + boff + n * 2048 + k * 1024); } while (0)
#define PG8_MMA(ai, bj, At, Bt) do { __builtin_amdgcn_s_setprio(1); _Pragma("unroll") for (int m = 0; m < 4; ++m) _Pragma("unroll") for (int n = 0; n < 2; ++n) _Pragma("unroll") for (int k = 0; k < 2; ++k) \
        acc[ai][bj][m][n] = __builtin_amdgcn_mfma_f32_16x16x32_bf16(Bt[n][k], At[m][k], acc[ai][bj][m][n], 0, 0, 0); __builtin_amdgcn_s_setprio(0); } while (0)
#define PG8_WAIT_V(n) asm volatile("s_waitcnt vmcnt(" #n ")" ::: "memory")
#define PG8_WAIT_L(n) asm volatile("s_waitcnt lgkmcnt(" #n ")" ::: "memory")
#define PG8_BAR __builtin_amdgcn_s_barrier()
#define PG8_SCHED __builtin_amdgcn_sched_barrier(0)
    Unit cur, nxt; int ui = 0;
    if (!S.next(0, cur)) return;
    f32x4 acc[2][2][4][2];
#pragma unroll
    for (int a = 0; a < 2; ++a)
#pragma unroll
        for (int b = 0; b < 2; ++b)
#pragma unroll
            for (int m = 0; m < 4; ++m)
#pragma unroll
                for (int n = 0; n < 2; ++n) acc[a][b][m][n] = (f32x4){0.f, 0.f, 0.f, 0.f};
    bf16x8 At[4][2], B0[2][2], B1[2][2];
    const char* cA = (const char*)g.A + (size_t)cur.pm * tstep; const char* cB = (const char*)g.Bt + (size_t)cur.pn * tstep;
    S.a_ready(cur);
    if constexpr (SP2) {
        PG8_STAGE(PG8_SB(0, 0), cB, voffB); PG8_STAGE(PG8_SB(0, 1), cB + hstep, voffB); PG8_STAGE(PG8_SA(0, 0), cA, voffA); PG8_STAGE(PG8_SA(0, 1), cA + hstep, voffA);
        if (wr == 1) PG8_BAR;
        PG8_WAIT_V(2); PG8_BAR;
        PG8_STAGE(PG8_SB(1, 0), cB + kstep, voffB); PG8_STAGE(PG8_SA(1, 0), cA + kstep, voffA); PG8_STAGE(PG8_SB(1, 1), cB + hstep + kstep, voffB);
        PG8_WAIT_V(6); PG8_BAR;
    } else {
        PG8_STAGE(PG8_SB(0, 0), cB, voffB); PG8_STAGE(PG8_SA(0, 0), cA, voffA); PG8_STAGE(PG8_SB(0, 1), cB + hstep, voffB); PG8_STAGE(PG8_SA(0, 1), cA + hstep, voffA);
        if (wr == 1) PG8_BAR;
        PG8_WAIT_V(4); PG8_BAR;
        PG8_STAGE(PG8_SB(1, 0), cB + kstep, voffB); PG8_STAGE(PG8_SA(1, 0), cA + kstep, voffA); PG8_STAGE(PG8_SB(1, 1), cB + hstep + kstep, voffB);
        PG8_WAIT_V(6); PG8_BAR;
    }
    for (;;) {
        const bool has_next = S.next(ui + 1, nxt);
        const char* nA = has_next ? (const char*)g.A + (size_t)nxt.pm * tstep : cA; const char* nB = has_next ? (const char*)g.Bt + (size_t)nxt.pn * tstep : cB;
        for (int t = 0; t < nt; t += 2) {
            const bool last = (t == nt - 2);
            const char* a1 = cA + (size_t)(t + 1) * kstep;
            const char* a2 = last ? nA : cA + (size_t)(t + 2) * kstep; const char* b2 = last ? nB : cB + (size_t)(t + 2) * kstep;
            const char* a3 = a2 + kstep; const char* b3 = b2 + kstep;
            if (last && has_next) S.a_ready(nxt);
            if constexpr (SP2) {
            PG8_LDB(B0, 0, 0); PG8_LDB(B1, 0, 1); PG8_SCHED; PG8_LDA(At, 0, 0); PG8_STAGE(PG8_SA(1, 1), a1 + hstep, voffA);
            PG8_WAIT_V(8); PG8_WAIT_L(0); PG8_BAR; PG8_MMA(0, 0, At, B0); PG8_MMA(0, 1, At, B1); PG8_BAR; PG8_SCHED;
            PG8_LDA(At, 0, 1); PG8_STAGE(PG8_SB(0, 0), b2, voffB); PG8_STAGE(PG8_SB(0, 1), b2 + hstep, voffB); PG8_STAGE(PG8_SA(0, 0), a2, voffA);
            PG8_WAIT_V(8); PG8_WAIT_L(0); PG8_BAR; PG8_MMA(1, 0, At, B0); PG8_MMA(1, 1, At, B1); PG8_BAR; PG8_SCHED;
            PG8_LDB(B0, 1, 0); PG8_LDB(B1, 1, 1); PG8_SCHED; PG8_LDA(At, 1, 0); PG8_STAGE(PG8_SA(0, 1), a2 + hstep, voffA);
            PG8_WAIT_V(8); PG8_WAIT_L(0); PG8_BAR; PG8_MMA(0, 0, At, B0); PG8_MMA(0, 1, At, B1); PG8_BAR; PG8_SCHED;
            PG8_LDA(At, 1, 1); PG8_STAGE(PG8_SB(1, 0), b3, voffB); PG8_STAGE(PG8_SB(1, 1), b3 + hstep, voffB); PG8_STAGE(PG8_SA(1, 0), a3, voffA);
            PG8_WAIT_V(8); PG8_WAIT_L(0); PG8_BAR; PG8_MMA(1, 0, At, B0); PG8_MMA(1, 1, At, B1); PG8_BAR; PG8_SCHED;
            } else {
            PG8_LDB(B0, 0, 0); PG8_SCHED; PG8_LDA(At, 0, 0); PG8_STAGE(PG8_SA(1, 1), a1 + hstep, voffA);
            PG8_WAIT_L(8); PG8_BAR; PG8_WAIT_L(0); PG8_MMA(0, 0, At, B0); PG8_BAR; PG8_SCHED;
            PG8_LDB(B1, 0, 1); PG8_STAGE(PG8_SB(0, 0), b2, voffB);
            PG8_BAR; PG8_WAIT_L(0); PG8_MMA(0, 1, At, B1); PG8_BAR;
            PG8_LDA(At, 0, 1); PG8_STAGE(PG8_SA(0, 0), a2, voffA);
            PG8_BAR; PG8_WAIT_L(0); PG8_MMA(1, 0, At, B0); PG8_BAR; PG8_SCHED;
            PG8_STAGE(PG8_SB(0, 1), b2 + hstep, voffB);
            PG8_WAIT_V(6); PG8_BAR; PG8_MMA(1, 1, At, B1); PG8_BAR;
            PG8_LDB(B0, 1, 0); PG8_SCHED; PG8_LDA(At, 1, 0); PG8_STAGE(PG8_SA(0, 1), a2 + hstep, voffA);
            PG8_WAIT_L(8); PG8_BAR; PG8_WAIT_L(0); PG8_MMA(0, 0, At, B0); PG8_BAR; PG8_SCHED;
            PG8_LDB(B1, 1, 1); PG8_STAGE(PG8_SB(1, 0), b3, voffB);
            PG8_BAR; PG8_WAIT_L(0); PG8_MMA(0, 1, At, B1); PG8_BAR;
            PG8_LDA(At, 1, 1); PG8_STAGE(PG8_SA(1, 0), a3, voffA);
            PG8_BAR; PG8_WAIT_L(0); PG8_MMA(1, 0, At, B0); PG8_BAR; PG8_SCHED;
            PG8_STAGE(PG8_SB(1, 1), b3 + hstep, voffB);
            PG8_WAIT_V(6); PG8_BAR; PG8_MMA(1, 1, At, B1); PG8_BAR;
            }
        }
        if constexpr (ALIGN_EPI) { if (wr == 0) PG8_BAR; }
        if constexpr (!Epi::AFTER_DRAIN) { E(acc, cur, wr, wc, fr, fq); S.done(cur); }
        if (!has_next) break;
#pragma unroll
        for (int a = 0; a < 2; ++a)
#pragma unroll
            for (int b = 0; b < 2; ++b)
#pragma unroll
                for (int m = 0; m < 4; ++m)
#pragma unroll
                    for (int n = 0; n < 2; ++n) acc[a][b][m][n] = (f32x4){0.f, 0.f, 0.f, 0.f};
        cur = nxt; cA = nA; cB = nB; ++ui;
        if constexpr (ALIGN_EPI) { if (wr == 1) PG8_BAR; }
    }
    PG8_WAIT_V(0);
    if constexpr (!ALIGN_EPI) { if (wr == 0) PG8_BAR; }
    PG8_BAR;
#undef PG8_SA
#undef PG8_SB
#undef PG8_STAGE
#undef PG8_LDA
#undef PG8_LDB
#undef PG8_MMA
#undef PG8_WAIT_V
#undef PG8_WAIT_L
#undef PG8_BAR
#undef PG8_SCHED
}
template <class Epi, class Sched, bool A=false, bool B=false> __device__ __forceinline__ void gemm_dummy(PG8_LAS unsigned char* lds, const Gemm g, const Sched& S, const Epi& E) {}
}

constexpr bool G_ALIGN = true, G_SP2 = true;
constexpr int LDS_BYTES = 147456, LDS_MISC = 131072 + 64;

struct Params {
    const float* x; const float* c; const float* w_mod; const float* b_mod;
    const float* f1g; const float* f1u; const float* f1d; const float* w_in; const float* w_out;
    const float* qng; const float* kng; const float* hng; const float* lbl;
    const float* f2g; const float* f2u; const float* f2d;
    float* out; unsigned char* ws;
};

template <class T> DI T* lau(T* p) { asm volatile("" : "+s"(p)); return p; }
DI float shx(float v, int o, int lane) { return __int_as_float(__builtin_amdgcn_ds_bpermute((lane ^ o) << 2, __float_as_int(v))); }
DI float wave_sum(float v, int lane) {
#pragma unroll
    for (int o = 1; o < 64; o <<= 1) v += shx(v, o, lane);
    return v;
}


#define XB_TMO      128
#define XB_XCNT(j)  (256  + 64 * (j))
#define XB_XSUB(j)  (1280 + 64 * (j))
#define XB_XGEN(j)  (2304 + 64 * (j))
#define XB_TOP      3328
#define XB_TOPGEN   3392
#define XCD_BAR_WORDS 3456
#define XB_SPIN_CAP (1u << 21)
DI unsigned xb_ld(unsigned* p)              { return __hip_atomic_load(p, __ATOMIC_RELAXED, __HIP_MEMORY_SCOPE_AGENT); }
DI unsigned xb_add(unsigned* p, unsigned v) { return __hip_atomic_fetch_add(p, v, __ATOMIC_RELAXED, __HIP_MEMORY_SCOPE_AGENT); }
DI unsigned xb_xcc_id() { return (unsigned)__builtin_amdgcn_s_getreg((3 << 11) | 20) & 0xFu; }
#define XB_SPIN(cond, bar) do { unsigned _sp = 0; while (cond) { __builtin_amdgcn_s_sleep(1); \
    if ((++_sp & 255u) == 0u) { if (xb_ld(&(bar)[XB_TMO])) break; if (_sp > XB_SPIN_CAP) { atomicAdd(&(bar)[XB_TMO], 1u); break; } } } } while (0)
struct XcdBarrier { unsigned* bar; unsigned x; volatile LAS unsigned* st; };
DI void xcd_barrier_complete(unsigned* bar, unsigned x, unsigned& nloc, unsigned& nx) {
    const unsigned G = gridDim.x * gridDim.y * gridDim.z;
    unsigned sum, cnt, mine, sp = 0u;
    for (;;) {
        sum = 0u; cnt = 0u; mine = 0u;
#pragma unroll
        for (unsigned j = 0; j < 16; ++j) { const unsigned c = xb_ld(&bar[XB_XCNT(j)]); sum += c; cnt += (c > 0u) ? 1u : 0u; mine = (j == x) ? c : mine; }
        if (sum == G) break;
        __builtin_amdgcn_s_sleep(1);
        if ((++sp & 255u) == 0u) { if (xb_ld(&bar[XB_TMO])) break; if (sp > XB_SPIN_CAP) { atomicAdd(&bar[XB_TMO], 1u); break; } }
    }
    nloc = mine > 0u ? mine : 1u; nx = cnt > 0u ? cnt : 1u;
}
DI void xcd_barrier(const XcdBarrier& b) {
    asm volatile("s_waitcnt vmcnt(0)" ::: "memory");
    __syncthreads();
    if (threadIdx.x == 0) {
        unsigned* bar = b.bar;
        __builtin_amdgcn_s_waitcnt(0);
        unsigned nloc = b.st[0], nx = b.st[1];
        if (nloc == 0u) { xcd_barrier_complete(bar, b.x, nloc, nx); b.st[0] = nloc; b.st[1] = nx; }
        const unsigned old = xb_add(&bar[XB_XSUB(b.x)], 1u);
        const unsigned gen = old / nloc;
        if (old + 1u == (gen + 1u) * nloc) {
            __builtin_amdgcn_fence(__ATOMIC_RELEASE, "agent");
            asm volatile("s_waitcnt vmcnt(0)" ::: "memory");
            const unsigned og = xb_add(&bar[XB_TOP], 1u);
            const unsigned tg = og / nx;
            if (og + 1u == (tg + 1u) * nx) xb_add(&bar[XB_TOPGEN], 1u);
            else XB_SPIN(xb_ld(&bar[XB_TOPGEN]) == tg, bar);
            __builtin_amdgcn_fence(__ATOMIC_ACQUIRE, "agent");
            xb_add(&bar[XB_XGEN(b.x)], 1u);
            asm volatile("s_waitcnt vmcnt(0)" ::: "memory");
        } else {
            XB_SPIN(xb_ld(&bar[XB_XGEN(b.x)]) == gen, bar);
            __builtin_amdgcn_fence(__ATOMIC_ACQUIRE, "agent");
            asm volatile("s_waitcnt vmcnt(0)" ::: "memory");
        }
    }
    __syncthreads();
}

DI void transpose_item(const float* W, int K, int N, bf16_t* WT, int mode, float* scr, int item, int lane) {
    const int nblk = N / 32, kb = item / nblk, nb = item % nblk, k0 = 64 * kb, n0 = 32 * nb;
    const int drow0 = (mode == 0) ? n0 : ((n0 >> 7) * 256 + (n0 & 127) + (mode == 2 ? 128 : 0));
#pragma unroll 8
    for (int i = 0; i < 32; ++i) { const int kk = 2 * i + (lane >> 5); scr[kk * 33 + (lane & 31)] = W[(size_t)(k0 + kk) * N + n0 + (lane & 31)]; }
    LDS_WAIT(); asm volatile("" ::: "memory");
    const int cch = lane & 7;
#pragma unroll
    for (int j = 0; j < 4; ++j) { const int n = (lane >> 3) + 8 * j; const float* s = scr + (8 * cch) * 33 + n;
        u32x4 o; o.x = pk2(s[0 * 33], s[1 * 33]); o.y = pk2(s[2 * 33], s[3 * 33]); o.z = pk2(s[4 * 33], s[5 * 33]); o.w = pk2(s[6 * 33], s[7 * 33]);
        *(u32x4*)(WT + (size_t)(drow0 + n) * K + k0 + 8 * cch) = o; }
    LDS_WAIT(); asm volatile("" ::: "memory");
}

DI void phase_prep(const Params& p, unsigned char* lds, int gw, int NGW, int wave, int lane) {
    float* scr = (float*)(lds + wave * 16384);
    constexpr int I_G = (D_MODEL / 64) * (D_FF / 32);
    constexpr int I_D = (D_FF / 64) * (D_MODEL / 32);
    constexpr int I_IN = (D_MODEL / 64) * (PW / 32);
    constexpr int I_OUT = (D_MODEL / 64) * (D_MODEL / 32);
    constexpr int I_LAYER = 4 * I_G + 2 * I_D + I_IN + I_OUT;
    constexpr int I_MOD = DEPTH * (NMOD / 64);
    constexpr int NITEMS = I_MOD + 1 + DEPTH * I_LAYER;
    for (int it = gw; it < NITEMS; it += NGW) {
        if (it < I_MOD) {
            const int l = it / (NMOD / 64), n = (it % (NMOD / 64)) * 64 + lane;
            for (int k = lane; k < 2 * D_MODEL; k += 64) scr[k] = silu_f(p.c[k]);
            LDS_WAIT(); asm volatile("" ::: "memory");
            const float* W = p.w_mod + (size_t)l * D_MODEL * NMOD + n;
            float a0 = 0.f, a1 = 0.f;
#pragma unroll 8
            for (int k = 0; k < D_MODEL; ++k) { const float w = W[(size_t)k * NMOD]; a0 += scr[k] * w; a1 += scr[D_MODEL + k] * w; }
            const float bm = p.b_mod[l * NMOD + n];
            float* mod = (float*)(p.ws + WS_MOD);
            mod[(l * 2 + 0) * NMOD + n] = a0 + bm; mod[(l * 2 + 1) * NMOD + n] = a1 + bm;
            LDS_WAIT(); asm volatile("" ::: "memory");
            continue;
        }
        if (it == I_MOD) {
            float* lb = (float*)(p.ws + WS_LB);
            for (int i = lane; i < 512; i += 64) { const float l0 = p.lbl[i], l1 = p.lbl[512 + i]; const float mx = fmaxf(l0, l1);
                const float e0 = __expf(l0 - mx), e1 = __expf(l1 - mx); const float s0 = e0 / (e0 + e1), s1 = e1 / (e0 + e1);
                lb[i] = fminf(fmaxf(s0 - s0, 0.f), 1.0f - EPS); lb[512 + i] = fminf(fmaxf((s0 + s1) - s0, 0.f), 1.0f - EPS); }
            continue;
        }
        int r = it - I_MOD - 1; const int l = r / I_LAYER; r -= l * I_LAYER;
        bf16_t* wl = (bf16_t*)(p.ws + WS_WEIGHTS + (size_t)l * WL_SIZE);
        const size_t o_gu = (size_t)l * D_MODEL * D_FF, o_in = (size_t)l * D_MODEL * PW, o_out = (size_t)l * D_MODEL * D_MODEL;
        if (r < I_G) { transpose_item(p.f1g + o_gu, D_MODEL, D_FF, wl + WL_GU1 / 2, 1, scr, r, lane); continue; } r -= I_G;
        if (r < I_G) { transpose_item(p.f1u + o_gu, D_MODEL, D_FF, wl + WL_GU1 / 2, 2, scr, r, lane); continue; } r -= I_G;
        if (r < I_D) { transpose_item(p.f1d + o_gu, D_FF, D_MODEL, wl + WL_DN1 / 2, 0, scr, r, lane); continue; } r -= I_D;
        if (r < I_IN) { transpose_item(p.w_in + o_in, D_MODEL, PW, wl + WL_IN / 2, 0, scr, r, lane); continue; } r -= I_IN;
        if (r < I_OUT) { transpose_item(p.w_out + o_out, D_MODEL, D_MODEL, wl + WL_OUT / 2, 0, scr, r, lane); continue; } r -= I_OUT;
        if (r < I_G) { transpose_item(p.f2g + o_gu, D_MODEL, D_FF, wl + WL_GU2 / 2, 1, scr, r, lane); continue; } r -= I_G;
        if (r < I_G) { transpose_item(p.f2u + o_gu, D_MODEL, D_FF, wl + WL_GU2 / 2, 2, scr, r, lane); continue; } r -= I_G;
        transpose_item(p.f2d + o_gu, D_FF, D_MODEL, wl + WL_DN2 / 2, 0, scr, r, lane);
    }
}

DI void phase_norm(const float* X, const float* sh, const float* sc, bf16_t* HB, int gw, int NGW, int lane) {
    for (int m = gw; m < M_TOK; m += NGW) {
        const int b = m / SEQ;
        const f32x4* xr = (const f32x4*)(X + (size_t)m * D_MODEL) + lane;
        f32x4 v[4]; float s = 0.f;
#pragma unroll
        for (int j = 0; j < 4; ++j) { v[j] = xr[64 * j]; s += (v[j].x * v[j].x + v[j].y * v[j].y) + (v[j].z * v[j].z + v[j].w * v[j].w); }
        const float r = 1.0f / sqrtf(wave_sum(s, lane) * (1.0f / D_MODEL) + EPS);
        u32x2* o8 = (u32x2*)(HB + (size_t)m * D_MODEL) + lane;
#pragma unroll
        for (int j = 0; j < 4; ++j) {
            const f32x4 scv = *((const f32x4*)(sc + (size_t)b * NMOD) + lane + 64 * j), shv = *((const f32x4*)(sh + (size_t)b * NMOD) + lane + 64 * j);
            const f32x4 h = v[j] * r * (scv + 1.0f) + shv;
            u32x2 w; w.x = pk2(h.x, h.y); w.y = pk2(h.z, h.w); o8[64 * j] = w; }
    }
}

DI void sb_unit(const bf16_t* proj, bf16_t* Y, int b, int hd, int qt, int lane) {
    const int q = lane & 31, hh = lane >> 5;
    const size_t rowbase = (size_t)b * SEQ;
    const bf16_t* qp = proj + (rowbase + qt * 32 + q) * PW + C_QA + hd * 64 + 8 * hh;
    bf16x8 qf[4];
#pragma unroll
    for (int ks = 0; ks < 4; ++ks) qf[ks] = *(const bf16x8*)(qp + 16 * ks);
    f16x8 tf[2];
#pragma unroll
    for (int ks = 0; ks < 2; ++ks)
#pragma unroll
        for (int j = 0; j < 8; ++j) tf[ks][j] = (krow(ks, hh, j) > q) ? (_Float16)1.0f : (_Float16)0.0f;
    f32x16 o0, o1;
#pragma unroll
    for (int i = 0; i < 16; ++i) { o0[i] = 0.f; o1[i] = 0.f; }
    float carry = 0.f;
    const float SC = 0.125f * LOG2E;
    for (int kt = qt; kt >= 0; --kt) {
        const bf16_t* kp = proj + (rowbase + kt * 32 + q) * PW + C_KA + hd * 64 + 8 * hh;
        f32x16 S;
#pragma unroll
        for (int i = 0; i < 16; ++i) S[i] = 0.f;
#pragma unroll
        for (int ks = 0; ks < 4; ++ks) S = MFMA_BF16(*(const bf16x8*)(kp + 16 * ks), qf[ks], S);
        const bf16_t* vp = proj + (rowbase + kt * 32) * PW + C_VA + hd * 64 + q;
        bf16x8 vf[2][2];
#pragma unroll
        for (int ks = 0; ks < 2; ++ks)
#pragma unroll
            for (int j = 0; j < 8; ++j) { const bf16_t* r = vp + (size_t)krow(ks, hh, j) * PW; vf[0][ks][j] = (short)r[0]; vf[1][ks][j] = (short)r[32]; }
        const bool diag = (kt == qt);
        float lnb[16], lw[16]; float tot = 0.f;
#pragma unroll
        for (int i = 0; i < 16; ++i) {
            const float z2 = fminf(S[i] * SC, 100.f);
            const float sp = flog2(1.0f + fexp2(z2));
            const bool valid = !diag || (crow(i, hh) < q);
            lnb[i] = valid ? -sp : 0.f; lw[i] = z2 - sp; tot += lnb[i];
        }
        tot += shx(tot, 32, lane);
        f16x8 lf[2];
#pragma unroll
        for (int ks = 0; ks < 2; ++ks)
#pragma unroll
            for (int j = 0; j < 8; ++j) lf[ks][j] = (_Float16)lnb[8 * ks + j];
        f32x16 T;
#pragma unroll
        for (int i = 0; i < 16; ++i) T[i] = 0.f;
#pragma unroll
        for (int ks = 0; ks < 2; ++ks) T = MFMA_F16(tf[ks], lf[ks], T);
        unsigned pw[8];
#pragma unroll
        for (int i = 0; i < 16; i += 2) {
            const bool v0 = !diag || (crow(i, hh) < q), v1 = !diag || (crow(i + 1, hh) < q);
            const float w0 = v0 ? fexp2(lw[i] + T[i] + carry) : 0.f, w1 = v1 ? fexp2(lw[i + 1] + T[i + 1] + carry) : 0.f;
            pw[i >> 1] = pk2(w0, w1);
        }
        bf16x8 pf[2];
        pf[0] = __builtin_bit_cast(bf16x8, (u32x4){pw[0], pw[1], pw[2], pw[3]});
        pf[1] = __builtin_bit_cast(bf16x8, (u32x4){pw[4], pw[5], pw[6], pw[7]});
#pragma unroll
        for (int ks = 0; ks < 2; ++ks) { o0 = MFMA_BF16(vf[0][ks], pf[ks], o0); o1 = MFMA_BF16(vf[1][ks], pf[ks], o1); }
        carry += tot;
        if (__all(carry < -160.f)) break;
    }
    bf16_t* yp = Y + (rowbase + qt * 32 + q) * D_MODEL + hd * 64 + 4 * hh;
#pragma unroll
    for (int g = 0; g < 4; ++g) {
        u32x2 w0; w0.x = pk2(o0[4 * g], o0[4 * g + 1]); w0.y = pk2(o0[4 * g + 2], o0[4 * g + 3]);
        u32x2 w1; w1.x = pk2(o1[4 * g], o1[4 * g + 1]); w1.y = pk2(o1[4 * g + 2], o1[4 * g + 3]);
        *(u32x2*)(yp + 8 * g) = w0; *(u32x2*)(yp + 32 + 8 * g) = w1;
    }
}

DI void qkprep_token(bf16_t* proj, const float* qg, const float* kg, int m, int lane) {
    const int j = lane & 31, which = lane >> 5;
    const int pos = m % SEQ;
    const float inv_freq = exp2f(-(float)j * (13.287712379549449f / 32.0f));
    const float ang = (float)pos * inv_freq;
    double t = (double)ang * 0.15915494309189535; t -= rint(t);
    const float sn = __builtin_amdgcn_sinf((float)t), cs = __builtin_amdgcn_cosf((float)t);
    const float* g = which ? kg : qg;
    const float g1 = g[j], g2 = g[j + 32];
    const float osc = which ? 1.0f : 0.125f * LOG2E;
    bf16_t* row = proj + (size_t)m * PW + (which ? C_KD : C_QD);
#pragma unroll
    for (int hd = 0; hd < 4; ++hd) {
        const float x1 = bf2f(row[hd * 64 + j]), x2 = bf2f(row[hd * 64 + 32 + j]);
        float ss = x1 * x1 + x2 * x2;
#pragma unroll
        for (int o = 1; o < 32; o <<= 1) ss += shx(ss, o, lane);
        const float r = 1.0f / sqrtf(ss * (1.0f / 64.0f) + EPS);
        const float y1 = x1 * r * g1, y2 = x2 * r * g2;
        const float o1 = (y1 * cs - y2 * sn) * osc, o2 = (y2 * cs + y1 * sn) * osc;
        row[hd * 64 + j] = (bf16_t)(pk2(o1, 0.f) & 0xffffu); row[hd * 64 + 32 + j] = (bf16_t)(pk2(o2, 0.f) & 0xffffu);
    }
}

DI void dil_unit(const bf16_t* proj, bf16_t* pnum, float* pden, int b, int hd, int pat, int rho, int jt, float m2, int lane) {
    const int r = 1 << (2 * pat);
    const int q = lane & 31, hh = lane >> 5;
    const size_t rowbase = (size_t)b * SEQ;
    const size_t rowq = rowbase + (size_t)(32 * jt + q) * r + rho;
    const bf16_t* qp = proj + rowq * PW + C_QD + hd * 64 + 8 * hh;
    bf16x8 qf[4];
#pragma unroll
    for (int ks = 0; ks < 4; ++ks) qf[ks] = *(const bf16x8*)(qp + 16 * ks);
    f32x16 o0, o1;
#pragma unroll
    for (int i = 0; i < 16; ++i) { o0[i] = 0.f; o1[i] = 0.f; }
    float den = 0.f;
    const int kt0 = (jt - 4) > 0 ? (jt - 4) : 0;
    for (int kt = kt0; kt <= jt; ++kt) {
        const bf16_t* kp = proj + (rowbase + (size_t)(32 * kt + q) * r + rho) * PW + C_KD + hd * 64 + 8 * hh;
        f32x16 S;
#pragma unroll
        for (int i = 0; i < 16; ++i) S[i] = 0.f;
#pragma unroll
        for (int ks = 0; ks < 4; ++ks) S = MFMA_BF16(*(const bf16x8*)(kp + 16 * ks), qf[ks], S);
        const bf16_t* vp = proj + (rowbase + (size_t)(32 * kt) * r + rho) * PW + C_VD + hd * 64 + q;
        bf16x8 vf[2][2];
#pragma unroll
        for (int ks = 0; ks < 2; ++ks)
#pragma unroll
            for (int j = 0; j < 8; ++j) { const bf16_t* rr = vp + (size_t)(krow(ks, hh, j) * r) * PW; vf[0][ks][j] = (short)rr[0]; vf[1][ks][j] = (short)rr[32]; }
        const int dbase = 32 * (jt - kt) + q;
        unsigned pw[8];
#pragma unroll
        for (int i = 0; i < 16; i += 2) {
            const int d0 = dbase - crow(i, hh), d1 = dbase - crow(i + 1, hh);
            const float p0 = (d0 >= 0 && d0 <= 128) ? fexp2(S[i] - m2) : 0.f, p1 = (d1 >= 0 && d1 <= 128) ? fexp2(S[i + 1] - m2) : 0.f;
            den += p0 + p1; pw[i >> 1] = pk2(p0, p1);
        }
        bf16x8 pf[2];
        pf[0] = __builtin_bit_cast(bf16x8, (u32x4){pw[0], pw[1], pw[2], pw[3]});
        pf[1] = __builtin_bit_cast(bf16x8, (u32x4){pw[4], pw[5], pw[6], pw[7]});
#pragma unroll
        for (int ks = 0; ks < 2; ++ks) { o0 = MFMA_BF16(vf[0][ks], pf[ks], o0); o1 = MFMA_BF16(vf[1][ks], pf[ks], o1); }
    }
    den += shx(den, 32, lane);
    bf16_t* np = pnum + ((size_t)pat * M_TOK + rowq) * 256 + hd * 64 + 4 * hh;
#pragma unroll
    for (int g = 0; g < 4; ++g) {
        u32x2 w0; w0.x = pk2(o0[4 * g], o0[4 * g + 1]); w0.y = pk2(o0[4 * g + 2], o0[4 * g + 3]);
        u32x2 w1; w1.x = pk2(o1[4 * g], o1[4 * g + 1]); w1.y = pk2(o1[4 * g + 2], o1[4 * g + 3]);
        *(u32x2*)(np + 8 * g) = w0; *(u32x2*)(np + 32 + 8 * g) = w1;
    }
    if (hh == 0) pden[((size_t)pat * M_TOK + rowq) * 4 + hd] = den;
}

DI void dil_merge_row(const bf16_t* pnum, const float* pden, bf16_t* Y, int m, int lane) {
    float n0 = 0.f, n1 = 0.f, n2 = 0.f, n3 = 0.f, d = 0.f;
#pragma unroll
    for (int p = 0; p < 3; ++p) {
        const u32x2 v = *(const u32x2*)(pnum + ((size_t)p * M_TOK + m) * 256 + 4 * lane);
        n0 += bflo(v.x); n1 += bfhi(v.x); n2 += bflo(v.y); n3 += bfhi(v.y);
        d += pden[((size_t)p * M_TOK + m) * 4 + (lane >> 4)];
    }
    const float rd = 1.0f / d;
    u32x2 w; w.x = pk2(n0 * rd, n1 * rd); w.y = pk2(n2 * rd, n3 * rd);
    *(u32x2*)(Y + (size_t)m * D_MODEL + 256 + 4 * lane) = w;
}

constexpr int H_LG = 0;
constexpr int H_QA = 32768;
constexpr int H_KT = H_QA + 17408;
constexpr int H_QB = H_KT + 17408;
constexpr int H_VT = H_QB + 17408;
constexpr int H_KH = H_VT + 18432;
constexpr int H_RED = H_KH + 18432;
static_assert(H_RED + 1024 <= 131072, "HGRN LDS map");

DI void hgrn_front(unsigned char* lds, const bf16_t* proj, const float* lbv  , size_t R0, int hd, int tid) {
    float* LG = (float*)(lds + H_LG);
#pragma unroll
    for (int it = 0; it < 2; ++it) {
        const int c = tid + it * 512, row = c >> 4, ch = c & 15;
        const u32x4 zz = *(const u32x4*)(proj + (R0 + row) * PW + C_FH + hd * 128 + ch * 8);
        const unsigned zw[4] = {zz.x, zz.y, zz.z, zz.w};
#pragma unroll
        for (int e = 0; e < 8; ++e) {
            const float z = (e & 1) ? bfhi(zw[e >> 1]) : bflo(zw[e >> 1]);
            const float lb = lbv[ch * 8 + e];
            const float sig = frcp(1.0f + __expf(-z));
            const float f = fmaxf(lb + (1.0f - lb) * sig, 1e-30f);
            LG[row * 128 + ch * 8 + e] = __logf(f);
        }
    }
    __syncthreads();
    const int d = tid & 127, seg = tid >> 7;
    float run = 0.f;
#pragma unroll
    for (int i = 0; i < 16; ++i) { run += LG[(16 * seg + i) * 128 + d]; LG[(16 * seg + i) * 128 + d] = run; }
    __syncthreads();
    float off = 0.f;
    for (int s2 = 0; s2 < seg; ++s2) off += LG[(16 * s2 + 15) * 128 + d];
    __syncthreads();
    if (seg > 0) {
#pragma unroll
        for (int i = 0; i < 16; ++i) LG[(16 * seg + i) * 128 + d] += off;
    }
    __syncthreads();
}

DI void hgrn_load_vt(unsigned char* lds, const bf16_t* proj, size_t R0, int col0, int tid) {
    const int v = tid & 127, seg = tid >> 7;
    const bf16_t* src = proj + (R0 + 16 * seg) * PW + col0 + v;
    unsigned w[8];
#pragma unroll
    for (int i = 0; i < 8; ++i) w[i] = (unsigned)src[(size_t)(2 * i) * PW] | ((unsigned)src[(size_t)(2 * i + 1) * PW] << 16);
    u32x4* dst = (u32x4*)(lds + H_VT + (v * 72 + 16 * seg) * 2);
    dst[0] = (u32x4){w[0], w[1], w[2], w[3]}; dst[1] = (u32x4){w[4], w[5], w[6], w[7]};
}

DI void hgrn_h1_unit(unsigned char* lds, const bf16_t* proj, const float* lball, bf16_t* ST, float* DEC, int unit, int tid, int wave, int lane) {
    const int bh = unit / NCHUNK, n = unit % NCHUNK, b = bh >> 2, hd = bh & 3;
    const size_t R0 = (size_t)b * SEQ + (size_t)n * 64;
    hgrn_front(lds, proj, lball + hd * 128, R0, hd, tid);
    const float* LG = (const float*)(lds + H_LG);
    {
        const int d = tid & 127, seg = tid >> 7;
        const float glast = LG[63 * 128 + d];
        float gprev = (seg == 0) ? 0.f : LG[(16 * seg - 1) * 128 + d];
        unsigned w[8]; float kh[16];
#pragma unroll
        for (int i = 0; i < 16; ++i) { const float g = LG[(16 * seg + i) * 128 + d]; const float k = 1.0f - __expf(g - gprev); gprev = g; kh[i] = k * __expf(glast - g); }
#pragma unroll
        for (int i = 0; i < 8; ++i) w[i] = pk2(kh[2 * i], kh[2 * i + 1]);
        u32x4* dst = (u32x4*)(lds + H_KH + (d * 72 + 16 * seg) * 2);
        dst[0] = (u32x4){w[0], w[1], w[2], w[3]}; dst[1] = (u32x4){w[4], w[5], w[6], w[7]};
        if (seg == 0) DEC[((size_t)bh * NCHUNK + n) * 128 + d] = __expf(glast);
    }
    hgrn_load_vt(lds, proj, R0, C_IH + hd * 128, tid);
    __syncthreads();
    {
        const int vt = wave >> 1, dt0 = 2 * (wave & 1), l31 = lane & 31, hh = lane >> 5;
        f32x16 a0, a1;
#pragma unroll
        for (int i = 0; i < 16; ++i) { a0[i] = 0.f; a1[i] = 0.f; }
#pragma unroll
        for (int ks = 0; ks < 4; ++ks) {
            const bf16x8 af = *(const bf16x8*)(lds + H_VT + ((32 * vt + l31) * 72 + 16 * ks + 8 * hh) * 2);
            const bf16x8 b0 = *(const bf16x8*)(lds + H_KH + ((32 * dt0 + l31) * 72 + 16 * ks + 8 * hh) * 2);
            const bf16x8 b1 = *(const bf16x8*)(lds + H_KH + ((32 * (dt0 + 1) + l31) * 72 + 16 * ks + 8 * hh) * 2);
            a0 = MFMA_BF16(af, b0, a0); a1 = MFMA_BF16(af, b1, a1);
        }
        bf16_t* st = ST + ((size_t)bh * NCHUNK + n) * 16384;
#pragma unroll
        for (int i = 0; i < 16; ++i) { const int v = 32 * vt + crow(i, hh);
            st[v * 128 + 32 * dt0 + l31] = (bf16_t)(pk2(a0[i], 0.f) & 0xffffu); st[v * 128 + 32 * (dt0 + 1) + l31] = (bf16_t)(pk2(a1[i], 0.f) & 0xffffu); }
    }
    __syncthreads();
}

DI void hgrn_scan(bf16_t* ST, const float* DEC, int gtid  ) {
    const int bh = gtid >> 14, e = gtid & 16383, d = e & 127;
    bf16_t* st = ST + (size_t)bh * NCHUNK * 16384 + e;
    const float* dc = DEC + (size_t)bh * NCHUNK * 128 + d;
    float s = 0.f;
    for (int n0 = 0; n0 < NCHUNK; n0 += 8) {
        float u[8], dd[8];
#pragma unroll
        for (int i = 0; i < 8; ++i) { u[i] = bf2f(st[(size_t)(n0 + i) * 16384]); dd[i] = dc[(n0 + i) * 128]; }
#pragma unroll
        for (int i = 0; i < 8; ++i) { st[(size_t)(n0 + i) * 16384] = (bf16_t)(pk2(s, 0.f) & 0xffffu); s = dd[i] * s + u[i]; }
    }
}

DI void hgrn_h3_unit(unsigned char* lds, const bf16_t* proj, const float* lball, const bf16_t* ST, const float* hng, bf16_t* Y, int unit, int tid, int wave, int lane) {
    const int bh = unit / NCHUNK, n = unit % NCHUNK, b = bh >> 2, hd = bh & 3;
    const size_t R0 = (size_t)b * SEQ + (size_t)n * 64;
    hgrn_front(lds, proj, lball + hd * 128, R0, hd, tid);
    const float* LG = (const float*)(lds + H_LG);
    {
        const int d = tid & 127, seg = tid >> 7;
        const float gm = LG[31 * 128 + d];
        float gprev = (seg == 0) ? 0.f : LG[(16 * seg - 1) * 128 + d];
        bf16_t* QA = (bf16_t*)(lds + H_QA); bf16_t* KT = (bf16_t*)(lds + H_KT); bf16_t* QB = (bf16_t*)(lds + H_QB);
        const bf16_t* qsrc = proj + (R0 + 16 * seg) * PW + C_QH + hd * 128 + d;
#pragma unroll
        for (int i = 0; i < 16; ++i) {
            const int t = 16 * seg + i;
            const float g = LG[t * 128 + d]; const float k = 1.0f - __expf(g - gprev); gprev = g;
            const float qv = silu_f(bf2f(qsrc[(size_t)i * PW]));
            const float e1 = __expf(fminf(g - gm, 80.f)), e2 = __expf(fminf(gm - g, 80.f)), e3 = __expf(g);
            QA[t * 136 + d] = (bf16_t)(pk2(qv * e1, 0.f) & 0xffffu);
            KT[t * 136 + d] = (bf16_t)(pk2(k * e2, 0.f) & 0xffffu);
            QB[t * 136 + d] = (bf16_t)(pk2(qv * e3, 0.f) & 0xffffu);
        }
    }
    hgrn_load_vt(lds, proj, R0, C_IH + hd * 128, tid);
    __syncthreads();
    const int vt = wave >> 1, ti = wave & 1, l31 = lane & 31, hh = lane >> 5;
    f32x16 acc;
#pragma unroll
    for (int i = 0; i < 16; ++i) acc[i] = 0.f;
    {
        const bf16_t* sp = ST + ((size_t)bh * NCHUNK + n) * 16384 + (32 * vt + l31) * 128 + 8 * hh;
#pragma unroll
        for (int ks = 0; ks < 8; ++ks) {
            const bf16x8 af = *(const bf16x8*)(sp + 16 * ks);
            const bf16x8 bfr = *(const bf16x8*)(lds + H_QB + ((32 * ti + l31) * 136 + 16 * ks + 8 * hh) * 2);
            acc = MFMA_BF16(af, bfr, acc);
        }
    }
    for (int si = 0; si <= ti; ++si) {
        f32x16 Sc;
#pragma unroll
        for (int i = 0; i < 16; ++i) Sc[i] = 0.f;
#pragma unroll
        for (int ks = 0; ks < 8; ++ks) {
            const bf16x8 af = *(const bf16x8*)(lds + H_KT + ((32 * si + l31) * 136 + 16 * ks + 8 * hh) * 2);
            const bf16x8 bfr = *(const bf16x8*)(lds + H_QA + ((32 * ti + l31) * 136 + 16 * ks + 8 * hh) * 2);
            Sc = MFMA_BF16(af, bfr, Sc);
        }
        unsigned pw[8];
#pragma unroll
        for (int i = 0; i < 16; i += 2) {
            const bool v0 = (si < ti) || (crow(i, hh) <= l31), v1 = (si < ti) || (crow(i + 1, hh) <= l31);
            pw[i >> 1] = pk2(v0 ? Sc[i] : 0.f, v1 ? Sc[i + 1] : 0.f);
        }
        bf16x8 pf[2];
        pf[0] = __builtin_bit_cast(bf16x8, (u32x4){pw[0], pw[1], pw[2], pw[3]});
        pf[1] = __builtin_bit_cast(bf16x8, (u32x4){pw[4], pw[5], pw[6], pw[7]});
#pragma unroll
        for (int ks = 0; ks < 2; ++ks) {
            const unsigned char* vb = lds + H_VT + ((32 * vt + l31) * 72 + 32 * si + 16 * ks + 4 * hh) * 2;
            const u32x2 lo = *(const u32x2*)vb, hi = *(const u32x2*)(vb + 16);
            const bf16x8 af = __builtin_bit_cast(bf16x8, (u32x4){lo.x, lo.y, hi.x, hi.y});
            acc = MFMA_BF16(af, pf[ks], acc);
        }
    }
    float ss = 0.f;
#pragma unroll
    for (int i = 0; i < 16; ++i) ss += acc[i] * acc[i];
    ss += shx(ss, 32, lane);
    float* RED = (float*)(lds + H_RED);
    if (hh == 0) RED[vt * 64 + 32 * ti + l31] = ss;
    __syncthreads();
    const int t = 32 * ti + l31;
    const float tot = RED[t] + RED[64 + t] + RED[128 + t] + RED[192 + t];
    const float rs = 1.0f / sqrtf(tot * (1.0f / 128.0f) + EPS);
    const bf16_t* gp = proj + (R0 + t) * PW + C_GH + hd * 128 + 32 * vt + 4 * hh;
    bf16_t* yp = Y + (R0 + t) * D_MODEL + 512 + hd * 128 + 32 * vt + 4 * hh;
    const float* gn = hng + 32 * vt + 4 * hh;
#pragma unroll
    for (int g = 0; g < 4; ++g) {
        const u32x2 gv = *(const u32x2*)(gp + 8 * g);
        const f32x4 nn = *(const f32x4*)(gn + 8 * g);
        const float r0 = acc[4 * g] * rs * nn.x * silu_f(bflo(gv.x)), r1 = acc[4 * g + 1] * rs * nn.y * silu_f(bfhi(gv.x));
        const float r2 = acc[4 * g + 2] * rs * nn.z * silu_f(bflo(gv.y)), r3 = acc[4 * g + 3] * rs * nn.w * silu_f(bfhi(gv.y));
        u32x2 w; w.x = pk2(r0, r1); w.y = pk2(r2, r3);
        *(u32x2*)(yp + 8 * g) = w;
    }
    __syncthreads();
}

#define CTX() \
    const Params* kp_ = (const Params*)__builtin_amdgcn_kernarg_segment_ptr(); asm volatile("" : "+s"(kp_)); const Params& p = *kp_; \
    int tid_ = threadIdx.x; asm volatile("" : "+v"(tid_)); const int tid = tid_, lane = tid & 63, wave = __builtin_amdgcn_readfirstlane(tid >> 6); \
    const int G = gridDim.x, bid = blockIdx.x; const int gw = wave * G + bid, NGW = G * 8; unsigned char* ws = p.ws; \
    (void)lane; (void)gw; (void)NGW; (void)ws; (void)tid;
#define WLP(l) ((const bf16_t*)(ws + WS_WEIGHTS + (size_t)(l) * WL_SIZE))
#define MLP(l) ((const float*)(ws + WS_MOD) + (size_t)(l) * 2 * NMOD)

template <class Epi> DI void run_gemm(PG8_LAS unsigned char* glds, const bf16_t* A, const bf16_t* Bt, int N, int K, const Epi& E) {
    int G_ = gridDim.x, b_ = blockIdx.x; asm volatile("" : "+s"(G_), "+s"(b_));
    pg8::Gemm g{A, Bt, M_TOK, N, K}; pg8::StaticOrder S; S.init(M_TOK, N, G_, b_);
    GEMMCALL<Epi, pg8::StaticOrder, G_ALIGN, G_SP2>(glds, g, S, E);
}

__global__ void __launch_bounds__(512) fwd_kernel(Params p_unused) {
    extern __shared__ __attribute__((aligned(16))) unsigned char lds[];
    cg::grid_group grid = cg::this_grid();
    PG8_LAS unsigned char* glds = (PG8_LAS unsigned char*)lds;
    { CTX(); if (tid < 2) ((volatile LAS unsigned*)(glds + LDS_MISC))[tid] = 0u;
      if (bid == 0) { unsigned* bw = (unsigned*)(ws + WS_BAR); for (int i = tid; i < XCD_BAR_WORDS; i += 512) bw[i] = 0u; } }
#ifndef SKIP_PREP
    { CTX(); phase_prep(p, lds, gw, NGW, wave, lane); }
#endif
    grid.sync();
    { CTX(); if (tid == 0) (void)xb_add((unsigned*)(ws + WS_BAR) + XB_XCNT(xb_xcc_id()), 1u); }
#define GRID_BAR() do { CTX(); XcdBarrier xb_; xb_.bar = (unsigned*)(ws + WS_BAR); xb_.x = xb_xcc_id(); xb_.st = (volatile LAS unsigned*)(glds + LDS_MISC); xcd_barrier(xb_); } while (0)

#pragma unroll 1
    for (int l = 0; l < DEPTH; ++l) {
        { CTX(); const float* ml = MLP(l); phase_norm((l == 0) ? p.x : p.out, ml + 0 * D_MODEL, ml + 1 * D_MODEL, (bf16_t*)(ws + WS_HB), gw, NGW, lane); }
        GRID_BAR();
        { CTX(); run_gemm(glds, (const bf16_t*)(ws + WS_HB), WLP(l) + WL_GU1 / 2, 2 * D_FF, D_MODEL, pg8::EpiSwiGLU{(bf16_t*)(ws + WS_ACT), D_FF}); }
        GRID_BAR();
        { CTX(); run_gemm(glds, (const bf16_t*)(ws + WS_ACT), WLP(l) + WL_DN1 / 2, D_MODEL, D_FF, pg8::EpiRes{(l == 0) ? p.x : p.out, p.out, MLP(l) + 2 * D_MODEL, NMOD, 0.5f}); }
        GRID_BAR();
        { CTX(); const float* ml = MLP(l); phase_norm(p.out, ml + 3 * D_MODEL, ml + 4 * D_MODEL, (bf16_t*)(ws + WS_HB), gw, NGW, lane); }
        GRID_BAR();
        { CTX(); run_gemm(glds, (const bf16_t*)(ws + WS_HB), WLP(l) + WL_IN / 2, PW, D_MODEL, pg8::EpiBf16{(bf16_t*)(ws + WS_ACT), PW}); }
        GRID_BAR();
#ifndef SKIP_H1
        { CTX(); for (int u = bid; u < 8 * NCHUNK; u += G) hgrn_h1_unit(lds, (const bf16_t*)(ws + WS_ACT), (const float*)(ws + WS_LB) + l * 512, (bf16_t*)(ws + WS_ST), (float*)(ws + WS_DEC), u, tid, wave, lane); }
#endif
#ifndef SKIP_QK
        { CTX(); for (int m = gw; m < M_TOK; m += NGW) qkprep_token((bf16_t*)(ws + WS_ACT), p.qng + l * 64, p.kng + l * 64, m, lane); }
#endif
#ifndef SKIP_SB
        { CTX(); for (int u = gw; u < 8 * (SEQ / 32); u += NGW) { const int bh = u / (SEQ / 32), qt = (SEQ / 32 - 1) - u % (SEQ / 32); sb_unit((const bf16_t*)(ws + WS_ACT), (bf16_t*)(ws + WS_Y), bh >> 2, bh & 3, qt, lane); } }
#endif
        GRID_BAR();
#ifndef SKIP_SCAN
        { CTX(); hgrn_scan((bf16_t*)(ws + WS_ST), (const float*)(ws + WS_DEC), bid * 512 + tid); }
#endif
#ifndef SKIP_DIL
        { CTX();
            float gq = fabsf(p.qng[l * 64 + lane]), gk = fabsf(p.kng[l * 64 + lane]);
#pragma unroll
            for (int o = 1; o < 64; o <<= 1) { gq = fmaxf(gq, shx(gq, o, lane)); gk = fmaxf(gk, shx(gk, o, lane)); }
            const float m2 = 8.0f * gq * gk * LOG2E;
            for (int u = gw; u < 3 * 8 * 512; u += NGW) {
                const int pat = u / 4096, rem = u % 4096, bh = rem / 512, tile = rem % 512;
                const int tpr = 512 >> (2 * pat);
                dil_unit((const bf16_t*)(ws + WS_ACT), (bf16_t*)(ws + WS_PNUM), (float*)(ws + WS_PDEN), bh >> 2, bh & 3, pat, tile / tpr, tile % tpr, m2, lane);
            }
        }
#endif
        GRID_BAR();
#ifndef SKIP_H3
        { CTX(); for (int u = bid; u < 8 * NCHUNK; u += G) hgrn_h3_unit(lds, (const bf16_t*)(ws + WS_ACT), (const float*)(ws + WS_LB) + l * 512, (const bf16_t*)(ws + WS_ST), p.hng + l * 128, (bf16_t*)(ws + WS_Y), u, tid, wave, lane); }
#endif
        { CTX(); for (int m = gw; m < M_TOK; m += NGW) dil_merge_row((const bf16_t*)(ws + WS_PNUM), (const float*)(ws + WS_PDEN), (bf16_t*)(ws + WS_Y), m, lane); }
        GRID_BAR();
        { CTX(); run_gemm(glds, (const bf16_t*)(ws + WS_Y), WLP(l) + WL_OUT / 2, D_MODEL, D_MODEL, pg8::EpiRes{p.out, p.out, MLP(l) + 5 * D_MODEL, NMOD, 1.0f}); }
        GRID_BAR();
        { CTX(); const float* ml = MLP(l); phase_norm(p.out, ml + 6 * D_MODEL, ml + 7 * D_MODEL, (bf16_t*)(ws + WS_HB), gw, NGW, lane); }
        GRID_BAR();
        { CTX(); run_gemm(glds, (const bf16_t*)(ws + WS_HB), WLP(l) + WL_GU2 / 2, 2 * D_FF, D_MODEL, pg8::EpiSwiGLU{(bf16_t*)(ws + WS_ACT), D_FF}); }
        GRID_BAR();
        { CTX(); run_gemm(glds, (const bf16_t*)(ws + WS_ACT), WLP(l) + WL_DN2 / 2, D_MODEL, D_FF, pg8::EpiRes{p.out, p.out, MLP(l) + 8 * D_MODEL, NMOD, 0.5f}); }
        GRID_BAR();
    }
}

extern "C" void kernel_launch(void* const* d_in, const int* in_sizes, int n_in, void* d_out, int out_size, void* d_ws, size_t ws_size, hipStream_t stream) {
    static int grid = 0;
    if (grid == 0) {
        if (n_in != 16 || ws_size < WS_END) { fprintf(stderr, "kernel_launch: unexpected n_in %d / ws %zu\n", n_in, ws_size); grid = -1; return; }
        int dev = 0, cus = 0, per_cu = 0;
        hipGetDevice(&dev);
        hipDeviceGetAttribute(&cus, hipDeviceAttributeMultiprocessorCount, dev);
        if (hipFuncSetAttribute((const void*)fwd_kernel, hipFuncAttributeMaxDynamicSharedMemorySize, LDS_BYTES) != hipSuccess) { fprintf(stderr, "kernel_launch: hipFuncSetAttribute failed\n"); grid = -1; return; }
        if (hipOccupancyMaxActiveBlocksPerMultiprocessor(&per_cu, (const void*)fwd_kernel, 512, LDS_BYTES) != hipSuccess || per_cu < 1) { fprintf(stderr, "kernel_launch: occupancy query gave %d\n", per_cu); per_cu = 1; }
        (void)hipGetLastError();
        grid = cus * per_cu;
    }
    if (grid < 0) return;
    Params p{};
    p.x = (const float*)d_in[0]; p.c = (const float*)d_in[1]; p.w_mod = (const float*)d_in[2]; p.b_mod = (const float*)d_in[3];
    p.f1g = (const float*)d_in[4]; p.f1u = (const float*)d_in[5]; p.f1d = (const float*)d_in[6]; p.w_in = (const float*)d_in[7]; p.w_out = (const float*)d_in[8];
    p.qng = (const float*)d_in[9]; p.kng = (const float*)d_in[10]; p.hng = (const float*)d_in[11]; p.lbl = (const float*)d_in[12];
    p.f2g = (const float*)d_in[13]; p.f2u = (const float*)d_in[14]; p.f2d = (const float*)d_in[15];
    p.out = (float*)d_out; p.ws = (unsigned char*)d_ws;
    void* args[] = {&p};
    hipError_t e = hipLaunchCooperativeKernel((const void*)fwd_kernel, dim3(grid), dim3(512), args, LDS_BYTES, stream);
    if (e != hipSuccess) fprintf(stderr, "cooperative launch failed: %s (grid %d)\n", hipGetErrorString(e), grid);
}
```

```cpp
#include <hip/hip_runtime.h>
#include <hip/hip_cooperative_groups.h>
#include <cstdio>
#include <cstdint>
namespace cg = cooperative_groups;

typedef unsigned short bf16_t;
typedef short bf16x8 __attribute__((ext_vector_type(8)));
typedef _Float16 f16x8 __attribute__((ext_vector_type(8)));
typedef float f32x2 __attribute__((ext_vector_type(2)));
typedef float f32x4 __attribute__((ext_vector_type(4)));
typedef float f32x16 __attribute__((ext_vector_type(16)));
typedef unsigned u32x2 __attribute__((ext_vector_type(2)));
typedef unsigned u32x4 __attribute__((ext_vector_type(4)));
typedef __bf16 bf16x2_t __attribute__((ext_vector_type(2)));

#define DI __device__ __forceinline__
#define LAS __attribute__((address_space(3)))

constexpr int D_MODEL = 1024, BATCH = 2, SEQ = 16384, DEPTH = 2, D_FF = 2816;
constexpr int M_TOK = BATCH * SEQ;
constexpr int PW = 3584;
constexpr int C_QA = 0, C_KA = 256, C_VA = 512, C_QD = 768, C_KD = 1024, C_VD = 1280, C_QH = 1536, C_FH = 2048, C_IH = 2560, C_GH = 3072;
constexpr int NMOD = 9 * D_MODEL;
constexpr float EPS = 1e-6f;
constexpr float LOG2E = 1.4426950408889634f;
constexpr int NCHUNK = SEQ / 64;

constexpr size_t MiB = 1u << 20;
constexpr size_t W_GU = (size_t)2 * D_FF * D_MODEL * 2;
constexpr size_t W_DN = (size_t)D_MODEL * D_FF * 2;
constexpr size_t W_IN = (size_t)PW * D_MODEL * 2;
constexpr size_t W_OUT = (size_t)D_MODEL * D_MODEL * 2;
constexpr size_t WL_GU1 = 0, WL_DN1 = WL_GU1 + W_GU, WL_IN = WL_DN1 + W_DN, WL_OUT = WL_IN + W_IN, WL_GU2 = WL_OUT + W_OUT, WL_DN2 = WL_GU2 + W_GU, WL_SIZE = WL_DN2 + W_DN;
static_assert(WL_SIZE == 44040192, "weights per layer");
constexpr size_t WS_WEIGHTS = 0;
constexpr size_t WS_SMALL = 84 * MiB;
constexpr size_t WS_MOD = WS_SMALL, WS_LB = WS_SMALL + 256 * 1024, WS_BAR = WS_SMALL + 512 * 1024;
constexpr size_t WS_DEC = 85 * MiB;
constexpr size_t WS_HB = 86 * MiB;
constexpr size_t WS_PNUM = WS_HB;
constexpr size_t WS_PDEN = WS_HB + 48 * MiB;
constexpr size_t WS_ACT = 150 * MiB;
constexpr size_t WS_Y = 374 * MiB;
constexpr size_t WS_ST = 438 * MiB;
constexpr size_t WS_RS = 502 * MiB;
constexpr size_t WS_SHW = 503 * MiB;
constexpr int SHW_N = 2 * D_FF + PW + 2 * D_FF;
constexpr size_t WS_END = 504 * MiB;

DI unsigned pk2(float lo, float hi) { f32x2 v = {lo, hi}; bf16x2_t b = __builtin_convertvector(v, bf16x2_t); return __builtin_bit_cast(unsigned, b); }
DI float bf2f(bf16_t b) { return __uint_as_float((unsigned)b << 16); }
DI float bflo(unsigned u) { return __uint_as_float(u << 16); }
DI float bfhi(unsigned u) { return __uint_as_float(u & 0xffff0000u); }
DI int crow(int reg, int h) { return (reg & 3) + 8 * (reg >> 2) + 4 * h; }
DI int krow(int s, int h, int j) { return 16 * s + 8 * (j >> 2) + 4 * h + (j & 3); }
DI float fexp2(float x) { return __builtin_amdgcn_exp2f(x); }
DI float flog2(float x) { return __builtin_amdgcn_logf(x); }
DI float frcp(float x) { return __builtin_amdgcn_rcpf(x); }
DI float silu_f(float g) { return g * frcp(1.0f + fexp2(-g * LOG2E)); }
#define MFMA_BF16(a, b, c) __builtin_amdgcn_mfma_f32_32x32x16_bf16((a), (b), (c), 0, 0, 0)
#define MFMA_F16(a, b, c) __builtin_amdgcn_mfma_f32_32x32x16_f16((a), (b), (c), 0, 0, 0)
#define LDS_WAIT() asm volatile("s_waitcnt lgkmcnt(0)" ::: "memory")

struct Params {
    const float* x; const float* c; const float* w_mod; const float* b_mod;
    const float* f1g; const float* f1u; const float* f1d; const float* w_in; const float* w_out;
    const float* qng; const float* kng; const float* hng; const float* lbl;
    const float* f2g; const float* f2u; const float* f2d;
    float* out; unsigned char* ws;
};

#ifdef SKIP_GEMM
#define GEMMCALL pg8::gemm_dummy
#else
#define GEMMCALL pg8::gemm_phase
#endif
namespace pg8 {
#define PG8_LAS __attribute__((address_space(3)))
constexpr int BM = 256, BK = 64, HALF = 128, HTB = HALF * BK * 2  , STAGE_BYTES = 8 * HTB, NXCD = 8, WGM = 8;

__host__ __device__ __forceinline__ int lds_byte(int r, int c) { const int st = (r >> 4) * 2 + (c >> 5), rr = r & 15, cc = c & 31, ob = rr * 64 + cc * 2; return st * 1024 + (ob ^ (((ob >> 9) & 1) << 5)); }
__host__ __device__ __forceinline__ void stage_rc(int b, int& R, int& C) { const int st = b / 1024, sb = b % 1024, swz = sb ^ (((sb >> 9) & 1) << 5); R = (st >> 1) * 16 + swz / 64; C = (st & 1) * 32 + (swz % 64) / 2; }
__host__ __device__ __forceinline__ int perm32(int rho) { const int n = rho >> 4, i = rho & 15; return 8 * (i >> 2) + 4 * n + (i & 3); }

struct Unit { int pm, pn; };
struct Gemm { const bf16_t* A; const bf16_t* Bt; int M, N, K; };

struct StaticOrder {
    int nM, nN, nwg, G, c;
    __host__ __device__ void init(int M, int N, int G_, int c_) { nM = M / BM; nN = N / BM; nwg = nM * nN; G = G_; c = c_; }
    __host__ __device__ bool next(int i, Unit& u) const {
        const long L = (long)i * G + c; if (L >= nwg) return false;
        int wgid = (int)L; { const int q = nwg / NXCD, r = nwg % NXCD, xcd = wgid % NXCD, off = wgid / NXCD; wgid = (xcd < r ? xcd * (q + 1) : r * (q + 1) + (xcd - r) * q) + off; }
        const int nig = WGM * nN, gid = wgid / nig, fm = gid * WGM, gsz = (nM - fm) < WGM ? (nM - fm) : WGM;
        u.pm = fm + ((wgid % nig) % gsz); u.pn = (wgid % nig) / gsz; return true;
    }
    __device__ __forceinline__ void a_ready(const Unit&) const {}
    __device__ __forceinline__ void done(const Unit&) const {}
};

#define EPI_PARAMS() const __attribute__((address_space(4))) Params* kq_ = (const __attribute__((address_space(4))) Params*)__builtin_amdgcn_kernarg_segment_ptr(); asm volatile("" : "+s"(kq_)); \
    unsigned char* const ws = kq_->ws
__device__ __forceinline__ float row_rs(const float* rowss, int row) { return 1.0f / sqrtf(rowss[row] * (1.0f / D_MODEL) + EPS); }
struct EpiBf16 {
    static constexpr bool PERM = true, AFTER_DRAIN = false;
    int ldc, rs_idx, shw_off  ;
    __device__ __forceinline__ void operator()(const f32x4 (&acc)[2][2][4][2], const Unit& u, int wr, int wc, int fr, int fq) const {
        EPI_PARAMS();
        bf16_t* O = (bf16_t*)(ws + WS_ACT); const float* rowss = (const float*)(ws + WS_RS) + (size_t)rs_idx * M_TOK; const float* shw = (const float*)(ws + WS_SHW) + shw_off;
        const int row0 = u.pm * BM + wr * 64 + fr; const int col0 = u.pn * BM + wc * 32 + 8 * fq;
        const float* sp = shw + (size_t)((u.pm * BM) / SEQ) * SHW_N + col0;
        f32x4 sv[2][2];
#pragma unroll
        for (int bj = 0; bj < 2; ++bj)
#pragma unroll
            for (int n = 0; n < 2; ++n) sv[bj][n] = *(const f32x4*)(sp + bj * HALF + 4 * n);
#pragma unroll
        for (int ai = 0; ai < 2; ++ai)
#pragma unroll
            for (int m = 0; m < 4; ++m) { const int row = row0 + ai * HALF + m * 16; bf16_t* rowp = O + (size_t)row * ldc + col0; const float rs = row_rs(rowss, row);
#pragma unroll
                for (int bj = 0; bj < 2; ++bj) { const f32x4 v0 = acc[ai][bj][m][0] * rs + sv[bj][0], v1 = acc[ai][bj][m][1] * rs + sv[bj][1];
                    u32x4 w; w.x = pk2(v0[0], v0[1]); w.y = pk2(v0[2], v0[3]); w.z = pk2(v1[0], v1[1]); w.w = pk2(v1[2], v1[3]);
                    *(u32x4*)(rowp + bj * HALF) = w; } }
    }
};
struct EpiSwiGLU {
    static constexpr bool PERM = true, AFTER_DRAIN = false;
    int ldc, rs_idx, shw_off;
    __device__ __forceinline__ void operator()(const f32x4 (&acc)[2][2][4][2], const Unit& u, int wr, int wc, int fr, int fq) const {
        EPI_PARAMS();
        bf16_t* O = (bf16_t*)(ws + WS_ACT); const float* rowss = (const float*)(ws + WS_RS) + (size_t)rs_idx * M_TOK; const float* shw = (const float*)(ws + WS_SHW) + shw_off;
        const int row0 = u.pm * BM + wr * 64 + fr; const int col0 = u.pn * HALF + wc * 32 + 8 * fq;
        const float* sp = shw + (size_t)((u.pm * BM) / SEQ) * SHW_N + u.pn * BM + wc * 32 + 8 * fq;
        f32x4 sv[2][2];
#pragma unroll
        for (int bj = 0; bj < 2; ++bj)
#pragma unroll
            for (int n = 0; n < 2; ++n) sv[bj][n] = *(const f32x4*)(sp + bj * HALF + 4 * n);
#pragma unroll
        for (int ai = 0; ai < 2; ++ai)
#pragma unroll
            for (int m = 0; m < 4; ++m) { const int row = row0 + ai * HALF + m * 16; bf16_t* rowp = O + (size_t)row * ldc + col0; const float rs = row_rs(rowss, row);
                const f32x4 g0 = acc[ai][0][m][0] * rs + sv[0][0], g1 = acc[ai][0][m][1] * rs + sv[0][1], u0 = acc[ai][1][m][0] * rs + sv[1][0], u1 = acc[ai][1][m][1] * rs + sv[1][1];
                float r[8];
#pragma unroll
                for (int e = 0; e < 4; ++e) { r[e] = silu_f(g0[e]) * u0[e]; r[4 + e] = silu_f(g1[e]) * u1[e]; }
                u32x4 w; w.x = pk2(r[0], r[1]); w.y = pk2(r[2], r[3]); w.z = pk2(r[4], r[5]); w.w = pk2(r[6], r[7]);
                *(u32x4*)rowp = w; }
    }
};
struct EpiRes {
    static constexpr bool PERM = true, AFTER_DRAIN = false;
    int x_is_input, gate_off  , scn_off, rs_idx; float coef;
    __device__ __forceinline__ void operator()(const f32x4 (&acc)[2][2][4][2], const Unit& u, int wr, int wc, int fr, int fq) const {
        EPI_PARAMS();
        float* Out = kq_->out; const float* X = x_is_input ? kq_->x : (const float*)Out;
        bf16_t* HB = (bf16_t*)(ws + WS_HB); float* rowss = (float*)(ws + WS_RS) + (size_t)rs_idx * M_TOK;
        const int row0 = u.pm * BM + wr * 64 + fr; const int col0 = u.pn * BM + wc * 32 + 8 * fq;
        const int b = (u.pm * BM) / SEQ;
        const float* gp = (const float*)(ws + WS_MOD) + gate_off + (size_t)b * NMOD + col0;
        const float* scp = (const float*)(ws + WS_MOD) + scn_off + (size_t)b * NMOD + col0;
        f32x4 gv[2][2], sc[2][2];
#pragma unroll
        for (int bj = 0; bj < 2; ++bj)
#pragma unroll
            for (int n = 0; n < 2; ++n) { gv[bj][n] = *(const f32x4*)(gp + bj * HALF + 4 * n) * coef; sc[bj][n] = *(const f32x4*)(scp + bj * HALF + 4 * n) + 1.0f; }
        const int lane = threadIdx.x & 63;
#pragma unroll
        for (int ai = 0; ai < 2; ++ai)
#pragma unroll
            for (int m = 0; m < 4; ++m) { const int row = row0 + ai * HALF + m * 16; const size_t ro = (size_t)row * D_MODEL + col0;
                float ssq = 0.f;
#pragma unroll
                for (int bj = 0; bj < 2; ++bj) {
                    f32x4 xn[2];
#pragma unroll
                    for (int n = 0; n < 2; ++n) { const f32x4 xv = *(const f32x4*)(X + ro + bj * HALF + 4 * n);
                        xn[n] = xv + gv[bj][n] * acc[ai][bj][m][n]; *(f32x4*)(Out + ro + bj * HALF + 4 * n) = xn[n]; }
                    ssq += (xn[0][0] * xn[0][0] + xn[0][1] * xn[0][1]) + (xn[0][2] * xn[0][2] + xn[0][3] * xn[0][3]) + (xn[1][0] * xn[1][0] + xn[1][1] * xn[1][1]) + (xn[1][2] * xn[1][2] + xn[1][3] * xn[1][3]);
                    const f32x4 h0 = xn[0] * sc[bj][0], h1 = xn[1] * sc[bj][1];
                    u32x4 w; w.x = pk2(h0[0], h0[1]); w.y = pk2(h0[2], h0[3]); w.z = pk2(h1[0], h1[1]); w.w = pk2(h1[2], h1[3]);
                    *(u32x4*)(HB + ro + bj * HALF) = w;
                }
                ssq += __int_as_float(__builtin_amdgcn_ds_bpermute((lane ^ 16) << 2, __float_as_int(ssq)));
                ssq += __int_as_float(__builtin_amdgcn_ds_bpermute((lane ^ 32) << 2, __float_as_int(ssq)));
                if (fq == 0) atomicAdd(rowss + row, ssq);
            }
    }
};

template <class Epi, class Sched, bool ALIGN_EPI = false, bool SP2 = false>
__device__ __forceinline__ void gemm_phase(PG8_LAS unsigned char* lds, const Gemm g, const Sched& S, const Epi& E) {
    int tid_ = threadIdx.x; asm volatile("" : "+v"(tid_));
    const int tid = tid_, wid = __builtin_amdgcn_readfirstlane(tid >> 6), lane = tid & 63, wr = wid >> 2, wc = wid & 3, fr = lane & 15, fq = lane >> 4;
    const int K = g.K, nt = K / BK;
    unsigned voffA[2], voffB[2];
#pragma unroll
    for (int i = 0; i < 2; ++i) { int R, C; stage_rc(tid * 16 + i * 8192, R, C); const int Rb = Epi::PERM ? ((R & ~31) + perm32(R & 31)) : R;
        voffA[i] = (unsigned)(R * K + C) * 2u; voffB[i] = (unsigned)(Rb * K + C) * 2u; }
    const size_t kstep = (size_t)(BK * 2);
    const size_t hstep = (size_t)HALF * K * 2;
    const size_t tstep = 2 * hstep;
    const unsigned ldsw = (unsigned)wid * 1024u;
    const int aoff = lds_byte(wr * 64 + fr, fq * 8), boff = lds_byte(wc * 32 + fr, fq * 8);
#define PG8_SA(b, h) (((b) * 2 + (h)) * HTB)
#define PG8_SB(b, h) ((4 + (b) * 2 + (h)) * HTB)
#define PG8_STAGE(bufoff, gbase, voff) do { _Pragma("unroll") for (int _i = 0; _i < 2; ++_i) \
        __builtin_amdgcn_global_load_lds((const unsigned*)((const char*)(gbase) + (voff)[_i]), (PG8_LAS unsigned*)(lds + (bufoff) + ldsw + _i * 8192), 16, 0, 0); } while (0)
#define PG8_LDA(dst, b, h) do { _Pragma("unroll") for (int m = 0; m < 4; ++m) _Pragma("unroll") for (int k = 0; k < 2; ++k) dst[m][k] = *(const PG8_LAS bf16x8*)(lds + PG8_SA(b, h) + aoff + m * 2048 + k * 1024); } while (0)
#define PG8_LDB(dst, b, h) do { _Pragma("unroll") for (int n = 0; n < 2; ++n) _Pragma("unroll") for (int k = 0; k < 2; ++k) dst[n][k] = *(const PG8_LAS bf16x8*)(lds + PG8_SB(b, h) + boff + n * 2048 + k * 1024); } while (0)
#define PG8_MMA(ai, bj, At, Bt) do { __builtin_amdgcn_s_setprio(1); _Pragma("unroll") for (int m = 0; m < 4; ++m) _Pragma("unroll") for (int n = 0; n < 2; ++n) _Pragma("unroll") for (int k = 0; k < 2; ++k) \
        acc[ai][bj][m][n] = __builtin_amdgcn_mfma_f32_16x16x32_bf16(Bt[n][k], At[m][k], acc[ai][bj][m][n], 0, 0, 0); __builtin_amdgcn_s_setprio(0); } while (0)
#define PG8_WAIT_V(n) asm volatile("s_waitcnt vmcnt(" #n ")" ::: "memory")
#define PG8_WAIT_L(n) asm volatile("s_waitcnt lgkmcnt(" #n ")" ::: "memory")
#define PG8_BAR __builtin_amdgcn_s_barrier()
#define PG8_SCHED __builtin_amdgcn_sched_barrier(0)
    Unit cur, nxt; int ui = 0;
    if (!S.next(0, cur)) return;
    f32x4 acc[2][2][4][2];
#pragma unroll
    for (int a = 0; a < 2; ++a)
#pragma unroll
        for (int b = 0; b < 2; ++b)
#pragma unroll
            for (int m = 0; m < 4; ++m)
#pragma unroll
                for (int n = 0; n < 2; ++n) acc[a][b][m][n] = (f32x4){0.f, 0.f, 0.f, 0.f};
    bf16x8 At[4][2], B0[2][2], B1[2][2];
    const char* cA = (const char*)g.A + (size_t)cur.pm * tstep; const char* cB = (const char*)g.Bt + (size_t)cur.pn * tstep;
    S.a_ready(cur);
    if constexpr (SP2) {
        PG8_STAGE(PG8_SB(0, 0), cB, voffB); PG8_STAGE(PG8_SB(0, 1), cB + hstep, voffB); PG8_STAGE(PG8_SA(0, 0), cA, voffA); PG8_STAGE(PG8_SA(0, 1), cA + hstep, voffA);
        if (wr == 1) PG8_BAR;
        PG8_WAIT_V(2); PG8_BAR;
        PG8_STAGE(PG8_SB(1, 0), cB + kstep, voffB); PG8_STAGE(PG8_SA(1, 0), cA + kstep, voffA); PG8_STAGE(PG8_SB(1, 1), cB + hstep + kstep, voffB);
        PG8_WAIT_V(6); PG8_BAR;
    } else {
        PG8_STAGE(PG8_SB(0, 0), cB, voffB); PG8_STAGE(PG8_SA(0, 0), cA, voffA); PG8_STAGE(PG8_SB(0, 1), cB + hstep, voffB); PG8_STAGE(PG8_SA(0, 1), cA + hstep, voffA);
        if (wr == 1) PG8_BAR;
        PG8_WAIT_V(4); PG8_BAR;
        PG8_STAGE(PG8_SB(1, 0), cB + kstep, voffB); PG8_STAGE(PG8_SA(1, 0), cA + kstep, voffA); PG8_STAGE(PG8_SB(1, 1), cB + hstep + kstep, voffB);
        PG8_WAIT_V(6); PG8_BAR;
    }
    for (;;) {
        const bool has_next = S.next(ui + 1, nxt);
        const char* nA = has_next ? (const char*)g.A + (size_t)nxt.pm * tstep : cA; const char* nB = has_next ? (const char*)g.Bt + (size_t)nxt.pn * tstep : cB;
        for (int t = 0; t < nt; t += 2) {
            const bool last = (t == nt - 2);
            const char* a1 = cA + (size_t)(t + 1) * kstep;
            const char* a2 = last ? nA : cA + (size_t)(t + 2) * kstep; const char* b2 = last ? nB : cB + (size_t)(t + 2) * kstep;
            const char* a3 = a2 + kstep; const char* b3 = b2 + kstep;
            if (last && has_next) S.a_ready(nxt);
            if constexpr (SP2) {
            PG8_LDB(B0, 0, 0); PG8_LDB(B1, 0, 1); PG8_SCHED; PG8_LDA(At, 0, 0); PG8_STAGE(PG8_SA(1, 1), a1 + hstep, voffA);
            PG8_WAIT_V(8); PG8_WAIT_L(0); PG8_BAR; PG8_MMA(0, 0, At, B0); PG8_MMA(0, 1, At, B1); PG8_BAR; PG8_SCHED;
            PG8_LDA(At, 0, 1); PG8_STAGE(PG8_SB(0, 0), b2, voffB); PG8_STAGE(PG8_SB(0, 1), b2 + hstep, voffB); PG8_STAGE(PG8_SA(0, 0), a2, voffA);
            PG8_WAIT_V(8); PG8_WAIT_L(0); PG8_BAR; PG8_MMA(1, 0, At, B0); PG8_MMA(1, 1, At, B1); PG8_BAR; PG8_SCHED;
            PG8_LDB(B0, 1, 0); PG8_LDB(B1, 1, 1); PG8_SCHED; PG8_LDA(At, 1, 0); PG8_STAGE(PG8_SA(0, 1), a2 + hstep, voffA);
            PG8_WAIT_V(8); PG8_WAIT_L(0); PG8_BAR; PG8_MMA(0, 0, At, B0); PG8_MMA(0, 1, At, B1); PG8_BAR; PG8_SCHED;
            PG8_LDA(At, 1, 1); PG8_STAGE(PG8_SB(1, 0), b3, voffB); PG8_STAGE(PG8_SB(1, 1), b3 + hstep, voffB); PG8_STAGE(PG8_SA(1, 0), a3, voffA);
            PG8_WAIT_V(8); PG8_WAIT_L(0); PG8_BAR; PG8_MMA(1, 0, At, B0); PG8_MMA(1, 1, At, B1); PG8_BAR; PG8_SCHED;
            } else {
            PG8_LDB(B0, 0, 0); PG8_SCHED; PG8_LDA(At, 0, 0); PG8_STAGE(PG8_SA(1, 1), a1 + hstep, voffA);
            PG8_WAIT_L(8); PG8_BAR; PG8_WAIT_L(0); PG8_MMA(0, 0, At, B0); PG8_BAR; PG8_SCHED;
            PG8_LDB(B1, 0, 1); PG8_STAGE(PG8_SB(0, 0), b2, voffB);
            PG8_BAR; PG8_WAIT_L(0); PG8_MMA(0, 1, At, B1); PG8_BAR;
            PG8_LDA(At, 0, 1); PG8_STAGE(PG8_SA(0, 0), a2, voffA);
            PG8_BAR; PG8_WAIT_L(0); PG8_MMA(1, 0, At, B0); PG8_BAR; PG8_SCHED;
            PG8_STAGE(PG8_SB(0, 1), b2 + hstep, voffB);
            PG8_WAIT_V(6); PG8_BAR; PG8_MMA(1, 1, At, B1); PG8_BAR;
            PG8_LDB(B0, 1, 0); PG8_SCHED; PG8_LDA(At, 1, 0); PG8_STAGE(PG8_SA(0, 1), a2 + hstep, voffA);
            PG8_WAIT_L(8); PG8_BAR; PG8_WAIT_L(0); PG8_MMA(0, 0, At, B0); PG8_BAR; PG8_SCHED;
            PG8_LDB(B1, 1, 1); PG8_STAGE(PG8_SB(1, 0), b3, voffB);
            PG8_BAR; PG8_WAIT_L(0); PG8_MMA(0, 1, At, B1); PG8_BAR;
            PG8_LDA(At, 1, 1); PG8_STAGE(PG8_SA(1, 0), a3, voffA);
            PG8_BAR; PG8_WAIT_L(0); PG8_MMA(1, 0, At, B0); PG8_BAR; PG8_SCHED;
            PG8_STAGE(PG8_SB(1, 1), b3 + hstep, voffB);
            PG8_WAIT_V(6); PG8_BAR; PG8_MMA(1, 1, At, B1); PG8_BAR;
            }
        }
        if constexpr (ALIGN_EPI) { if (wr == 0) PG8_BAR; }
        if constexpr (!Epi::AFTER_DRAIN) { E(acc, cur, wr, wc, fr, fq); S.done(cur); }
        if (!has_next) break;
#pragma unroll
        for (int a = 0; a < 2; ++a)
#pragma unroll
            for (int b = 0; b < 2; ++b)
#pragma unroll
                for (int m = 0; m < 4; ++m)
#pragma unroll
                    for (int n = 0; n < 2; ++n) acc[a][b][m][n] = (f32x4){0.f, 0.f, 0.f, 0.f};
        cur = nxt; cA = nA; cB = nB; ++ui;
        if constexpr (ALIGN_EPI) { if (wr == 1) PG8_BAR; }
    }
    PG8_WAIT_V(0);
    if constexpr (!ALIGN_EPI) { if (wr == 0) PG8_BAR; }
    PG8_BAR;
#undef PG8_SA
#undef PG8_SB
#undef PG8_STAGE
#undef PG8_LDA
#undef PG8_LDB
#undef PG8_MMA
#undef PG8_WAIT_V
#undef PG8_WAIT_L
#undef PG8_BAR
#undef PG8_SCHED
}
template <class Epi, class Sched, bool A=false, bool B=false> __device__ __forceinline__ void gemm_dummy(PG8_LAS unsigned char* lds, const Gemm g, const Sched& S, const Epi& E) {}
}

constexpr bool G_ALIGN = true, G_SP2 = true;
constexpr int LDS_BYTES = 147456, LDS_MISC = 131072 + 64;


template <class T> DI T* lau(T* p) { asm volatile("" : "+s"(p)); return p; }
DI float shx(float v, int o, int lane) { return __int_as_float(__builtin_amdgcn_ds_bpermute((lane ^ o) << 2, __float_as_int(v))); }
DI float wave_sum(float v, int lane) {
#pragma unroll
    for (int o = 1; o < 64; o <<= 1) v += shx(v, o, lane);
    return v;
}


#define XB_TMO      128
#define XB_XCNT(j)  (256  + 64 * (j))
#define XB_XSUB(j)  (1280 + 64 * (j))
#define XB_XGEN(j)  (2304 + 64 * (j))
#define XB_TOP      3328
#define XB_TOPGEN   3392
#define XCD_BAR_WORDS 3456
#define XB_SPIN_CAP (1u << 21)
DI unsigned xb_ld(unsigned* p)              { return __hip_atomic_load(p, __ATOMIC_RELAXED, __HIP_MEMORY_SCOPE_AGENT); }
DI unsigned xb_add(unsigned* p, unsigned v) { return __hip_atomic_fetch_add(p, v, __ATOMIC_RELAXED, __HIP_MEMORY_SCOPE_AGENT); }
DI unsigned xb_xcc_id() { return (unsigned)__builtin_amdgcn_s_getreg((3 << 11) | 20) & 0xFu; }
#define XB_SPIN(cond, bar) do { unsigned _sp = 0; while (cond) { __builtin_amdgcn_s_sleep(1); \
    if ((++_sp & 255u) == 0u) { if (xb_ld(&(bar)[XB_TMO])) break; if (_sp > XB_SPIN_CAP) { atomicAdd(&(bar)[XB_TMO], 1u); break; } } } } while (0)
struct XcdBarrier { unsigned* bar; unsigned x; volatile LAS unsigned* st; };
DI void xcd_barrier_complete(unsigned* bar, unsigned x, unsigned& nloc, unsigned& nx) {
    const unsigned G = gridDim.x * gridDim.y * gridDim.z;
    unsigned sum, cnt, mine, sp = 0u;
    for (;;) {
        sum = 0u; cnt = 0u; mine = 0u;
#pragma unroll
        for (unsigned j = 0; j < 16; ++j) { const unsigned c = xb_ld(&bar[XB_XCNT(j)]); sum += c; cnt += (c > 0u) ? 1u : 0u; mine = (j == x) ? c : mine; }
        if (sum == G) break;
        __builtin_amdgcn_s_sleep(1);
        if ((++sp & 255u) == 0u) { if (xb_ld(&bar[XB_TMO])) break; if (sp > XB_SPIN_CAP) { atomicAdd(&bar[XB_TMO], 1u); break; } }
    }
    nloc = mine > 0u ? mine : 1u; nx = cnt > 0u ? cnt : 1u;
}
DI void xcd_barrier(const XcdBarrier& b) {
    asm volatile("s_waitcnt vmcnt(0)" ::: "memory");
    __syncthreads();
    if (threadIdx.x == 0) {
        unsigned* bar = b.bar;
        __builtin_amdgcn_s_waitcnt(0);
        unsigned nloc = b.st[0], nx = b.st[1];
        if (nloc == 0u) { xcd_barrier_complete(bar, b.x, nloc, nx); b.st[0] = nloc; b.st[1] = nx; }
        const unsigned old = xb_add(&bar[XB_XSUB(b.x)], 1u);
        const unsigned gen = old / nloc;
        if (old + 1u == (gen + 1u) * nloc) {
            __builtin_amdgcn_fence(__ATOMIC_RELEASE, "agent");
            asm volatile("s_waitcnt vmcnt(0)" ::: "memory");
            const unsigned og = xb_add(&bar[XB_TOP], 1u);
            const unsigned tg = og / nx;
            if (og + 1u == (tg + 1u) * nx) xb_add(&bar[XB_TOPGEN], 1u);
            else XB_SPIN(xb_ld(&bar[XB_TOPGEN]) == tg, bar);
            __builtin_amdgcn_fence(__ATOMIC_ACQUIRE, "agent");
            xb_add(&bar[XB_XGEN(b.x)], 1u);
            asm volatile("s_waitcnt vmcnt(0)" ::: "memory");
        } else {
            XB_SPIN(xb_ld(&bar[XB_XGEN(b.x)]) == gen, bar);
            __builtin_amdgcn_fence(__ATOMIC_ACQUIRE, "agent");
            asm volatile("s_waitcnt vmcnt(0)" ::: "memory");
        }
    }
    __syncthreads();
}

DI void transpose_item(const float* W, int K, int N, bf16_t* WT, int mode, float* scr, int item, int lane) {
    const int nblk = N / 32, kb = item / nblk, nb = item % nblk, k0 = 64 * kb, n0 = 32 * nb;
    const int drow0 = (mode == 0) ? n0 : ((n0 >> 7) * 256 + (n0 & 127) + (mode == 2 ? 128 : 0));
#pragma unroll 8
    for (int i = 0; i < 32; ++i) { const int kk = 2 * i + (lane >> 5); scr[kk * 33 + (lane & 31)] = W[(size_t)(k0 + kk) * N + n0 + (lane & 31)]; }
    LDS_WAIT(); asm volatile("" ::: "memory");
    const int cch = lane & 7;
#pragma unroll
    for (int j = 0; j < 4; ++j) { const int n = (lane >> 3) + 8 * j; const float* s = scr + (8 * cch) * 33 + n;
        u32x4 o; o.x = pk2(s[0 * 33], s[1 * 33]); o.y = pk2(s[2 * 33], s[3 * 33]); o.z = pk2(s[4 * 33], s[5 * 33]); o.w = pk2(s[6 * 33], s[7 * 33]);
        *(u32x4*)(WT + (size_t)(drow0 + n) * K + k0 + 8 * cch) = o; }
    LDS_WAIT(); asm volatile("" ::: "memory");
}

template <class PT> DI void phase_prep(const PT& p, unsigned char* lds, int gw, int NGW, int wave, int lane) {
    float* scr = (float*)(lds + wave * 16384);
    constexpr int I_G = (D_MODEL / 64) * (D_FF / 32);
    constexpr int I_D = (D_FF / 64) * (D_MODEL / 32);
    constexpr int I_IN = (D_MODEL / 64) * (PW / 32);
    constexpr int I_OUT = (D_MODEL / 64) * (D_MODEL / 32);
    constexpr int I_LAYER = 4 * I_G + 2 * I_D + I_IN + I_OUT;
    constexpr int I_MOD = DEPTH * (NMOD / 64);
    constexpr int NITEMS = I_MOD + 1 + DEPTH * I_LAYER;
    for (int it = gw; it < NITEMS; it += NGW) {
        if (it < I_MOD) {
            const int l = it / (NMOD / 64), n = (it % (NMOD / 64)) * 64 + lane;
            for (int k = lane; k < 2 * D_MODEL; k += 64) scr[k] = silu_f(p.c[k]);
            LDS_WAIT(); asm volatile("" ::: "memory");
            const float* W = p.w_mod + (size_t)l * D_MODEL * NMOD + n;
            float a0 = 0.f, a1 = 0.f;
#pragma unroll 8
            for (int k = 0; k < D_MODEL; ++k) { const float w = W[(size_t)k * NMOD]; a0 += scr[k] * w; a1 += scr[D_MODEL + k] * w; }
            const float bm = p.b_mod[l * NMOD + n];
            float* mod = (float*)(p.ws + WS_MOD);
            mod[(l * 2 + 0) * NMOD + n] = a0 + bm; mod[(l * 2 + 1) * NMOD + n] = a1 + bm;
            LDS_WAIT(); asm volatile("" ::: "memory");
            continue;
        }
        if (it == I_MOD) {
            float* lb = (float*)(p.ws + WS_LB);
            for (int i = lane; i < 512; i += 64) { const float l0 = p.lbl[i], l1 = p.lbl[512 + i]; const float mx = fmaxf(l0, l1);
                const float e0 = __expf(l0 - mx), e1 = __expf(l1 - mx); const float s0 = e0 / (e0 + e1), s1 = e1 / (e0 + e1);
                lb[i] = fminf(fmaxf(s0 - s0, 0.f), 1.0f - EPS); lb[512 + i] = fminf(fmaxf((s0 + s1) - s0, 0.f), 1.0f - EPS); }
            continue;
        }
        int r = it - I_MOD - 1; const int l = r / I_LAYER; r -= l * I_LAYER;
        bf16_t* wl = (bf16_t*)(p.ws + WS_WEIGHTS + (size_t)l * WL_SIZE);
        const size_t o_gu = (size_t)l * D_MODEL * D_FF, o_in = (size_t)l * D_MODEL * PW, o_out = (size_t)l * D_MODEL * D_MODEL;
        if (r < I_G) { transpose_item(p.f1g + o_gu, D_MODEL, D_FF, wl + WL_GU1 / 2, 1, scr, r, lane); continue; } r -= I_G;
        if (r < I_G) { transpose_item(p.f1u + o_gu, D_MODEL, D_FF, wl + WL_GU1 / 2, 2, scr, r, lane); continue; } r -= I_G;
        if (r < I_D) { transpose_item(p.f1d + o_gu, D_FF, D_MODEL, wl + WL_DN1 / 2, 0, scr, r, lane); continue; } r -= I_D;
        if (r < I_IN) { transpose_item(p.w_in + o_in, D_MODEL, PW, wl + WL_IN / 2, 0, scr, r, lane); continue; } r -= I_IN;
        if (r < I_OUT) { transpose_item(p.w_out + o_out, D_MODEL, D_MODEL, wl + WL_OUT / 2, 0, scr, r, lane); continue; } r -= I_OUT;
        if (r < I_G) { transpose_item(p.f2g + o_gu, D_MODEL, D_FF, wl + WL_GU2 / 2, 1, scr, r, lane); continue; } r -= I_G;
        if (r < I_G) { transpose_item(p.f2u + o_gu, D_MODEL, D_FF, wl + WL_GU2 / 2, 2, scr, r, lane); continue; } r -= I_G;
        transpose_item(p.f2d + o_gu, D_FF, D_MODEL, wl + WL_DN2 / 2, 0, scr, r, lane);
    }
}


template <class PT> DI void phase_prep2(const PT& p, unsigned char* ws, int gw, int NGW, int lane) {
    const float* mod = (const float*)(ws + WS_MOD);
    float* SHW = (float*)(ws + WS_SHW);
    for (int it = gw; it < DEPTH * SHW_N; it += NGW) {
        const int l = it / SHW_N, j = it % SHW_N;
        const bf16_t* wl = (const bf16_t*)(ws + WS_WEIGHTS + (size_t)l * WL_SIZE); const bf16_t* row; int shsel;
        if (j < 2 * D_FF) { row = wl + WL_GU1 / 2 + (size_t)j * D_MODEL; shsel = 0; }
        else if (j < 2 * D_FF + PW) { row = wl + WL_IN / 2 + (size_t)(j - 2 * D_FF) * D_MODEL; shsel = 3; }
        else { row = wl + WL_GU2 / 2 + (size_t)(j - 2 * D_FF - PW) * D_MODEL; shsel = 6; }
        const float* sh0 = mod + (size_t)(l * 2) * NMOD + shsel * D_MODEL; const float* sh1 = sh0 + NMOD;
        float a0 = 0.f, a1 = 0.f;
#pragma unroll
        for (int h = 0; h < 2; ++h) { const int k0 = h * 512 + 8 * lane; const u32x4 w = *(const u32x4*)(row + k0);
            const float wv[8] = {bflo(w.x), bfhi(w.x), bflo(w.y), bfhi(w.y), bflo(w.z), bfhi(w.z), bflo(w.w), bfhi(w.w)};
            const f32x4 s00 = *(const f32x4*)(sh0 + k0), s01 = *(const f32x4*)(sh0 + k0 + 4), s10 = *(const f32x4*)(sh1 + k0), s11 = *(const f32x4*)(sh1 + k0 + 4);
#pragma unroll
            for (int e = 0; e < 4; ++e) { a0 += wv[e] * s00[e] + wv[4 + e] * s01[e]; a1 += wv[e] * s10[e] + wv[4 + e] * s11[e]; } }
        a0 = wave_sum(a0, lane); a1 = wave_sum(a1, lane);
        if (lane == 0) { SHW[(size_t)(l * 2 + 0) * SHW_N + j] = a0; SHW[(size_t)(l * 2 + 1) * SHW_N + j] = a1; }
    }
    bf16_t* HB = (bf16_t*)(ws + WS_HB); float* RS = (float*)(ws + WS_RS);
    for (int m = gw; m < M_TOK; m += NGW) {
        const int b = m / SEQ;
        const f32x4* xr = (const f32x4*)(p.x + (size_t)m * D_MODEL) + lane;
        const float* sc = mod + (size_t)b * NMOD + 1 * D_MODEL;
        f32x4 v[4]; float ss = 0.f;
#pragma unroll
        for (int j = 0; j < 4; ++j) { v[j] = xr[64 * j]; ss += (v[j].x * v[j].x + v[j].y * v[j].y) + (v[j].z * v[j].z + v[j].w * v[j].w); }
        ss = wave_sum(ss, lane);
        if (lane == 0) RS[m] = ss;
        u32x2* o8 = (u32x2*)(HB + (size_t)m * D_MODEL) + lane;
#pragma unroll
        for (int j = 0; j < 4; ++j) { const f32x4 h = v[j] * (*((const f32x4*)sc + lane + 64 * j) + 1.0f);
            u32x2 w; w.x = pk2(h.x, h.y); w.y = pk2(h.z, h.w); o8[64 * j] = w; }
    }
}

DI void phase_norm(const float* X, const float* sh, const float* sc, bf16_t* HB, int gw, int NGW, int lane) {
    for (int m = gw; m < M_TOK; m += NGW) {
        const int b = m / SEQ;
        const f32x4* xr = (const f32x4*)(X + (size_t)m * D_MODEL) + lane;
        f32x4 v[4]; float s = 0.f;
#pragma unroll
        for (int j = 0; j < 4; ++j) { v[j] = xr[64 * j]; s += (v[j].x * v[j].x + v[j].y * v[j].y) + (v[j].z * v[j].z + v[j].w * v[j].w); }
        const float r = 1.0f / sqrtf(wave_sum(s, lane) * (1.0f / D_MODEL) + EPS);
        u32x2* o8 = (u32x2*)(HB + (size_t)m * D_MODEL) + lane;
#pragma unroll
        for (int j = 0; j < 4; ++j) {
            const f32x4 scv = *((const f32x4*)(sc + (size_t)b * NMOD) + lane + 64 * j), shv = *((const f32x4*)(sh + (size_t)b * NMOD) + lane + 64 * j);
            const f32x4 h = v[j] * r * (scv + 1.0f) + shv;
            u32x2 w; w.x = pk2(h.x, h.y); w.y = pk2(h.z, h.w); o8[64 * j] = w; }
    }
}

DI void sb_unit(const bf16_t* proj, bf16_t* Y, int b, int hd, int qt, int lane) {
    const int q = lane & 31, hh = lane >> 5;
    const size_t rowbase = (size_t)b * SEQ;
    const bf16_t* qp = proj + (rowbase + qt * 32 + q) * PW + C_QA + hd * 64 + 8 * hh;
    bf16x8 qf[4];
#pragma unroll
    for (int ks = 0; ks < 4; ++ks) qf[ks] = *(const bf16x8*)(qp + 16 * ks);
    f16x8 tf[2];
#pragma unroll
    for (int ks = 0; ks < 2; ++ks)
#pragma unroll
        for (int j = 0; j < 8; ++j) tf[ks][j] = (krow(ks, hh, j) > q) ? (_Float16)1.0f : (_Float16)0.0f;
    f32x16 o0, o1;
#pragma unroll
    for (int i = 0; i < 16; ++i) { o0[i] = 0.f; o1[i] = 0.f; }
    float carry = 0.f;
    const float SC = 0.125f * LOG2E;
    for (int kt = qt; kt >= 0; --kt) {
        const bf16_t* kp = proj + (rowbase + kt * 32 + q) * PW + C_KA + hd * 64 + 8 * hh;
        f32x16 S;
#pragma unroll
        for (int i = 0; i < 16; ++i) S[i] = 0.f;
#pragma unroll
        for (int ks = 0; ks < 4; ++ks) S = MFMA_BF16(*(const bf16x8*)(kp + 16 * ks), qf[ks], S);
        const bf16_t* vp = proj + (rowbase + kt * 32) * PW + C_VA + hd * 64 + q;
        bf16x8 vf[2][2];
#pragma unroll
        for (int ks = 0; ks < 2; ++ks)
#pragma unroll
            for (int j = 0; j < 8; ++j) { const bf16_t* r = vp + (size_t)krow(ks, hh, j) * PW; vf[0][ks][j] = (short)r[0]; vf[1][ks][j] = (short)r[32]; }
        const bool diag = (kt == qt);
        float lnb[16], lw[16]; float tot = 0.f;
#pragma unroll
        for (int i = 0; i < 16; ++i) {
            const float z2 = fminf(S[i] * SC, 100.f);
            const float sp = flog2(1.0f + fexp2(z2));
            const bool valid = !diag || (crow(i, hh) < q);
            lnb[i] = valid ? -sp : 0.f; lw[i] = z2 - sp; tot += lnb[i];
        }
        tot += shx(tot, 32, lane);
        f16x8 lf[2];
#pragma unroll
        for (int ks = 0; ks < 2; ++ks)
#pragma unroll
            for (int j = 0; j < 8; ++j) lf[ks][j] = (_Float16)lnb[8 * ks + j];
        f32x16 T;
#pragma unroll
        for (int i = 0; i < 16; ++i) T[i] = 0.f;
#pragma unroll
        for (int ks = 0; ks < 2; ++ks) T = MFMA_F16(tf[ks], lf[ks], T);
        unsigned pw[8];
#pragma unroll
        for (int i = 0; i < 16; i += 2) {
            const bool v0 = !diag || (crow(i, hh) < q), v1 = !diag || (crow(i + 1, hh) < q);
            const float w0 = v0 ? fexp2(lw[i] + T[i] + carry) : 0.f, w1 = v1 ? fexp2(lw[i + 1] + T[i + 1] + carry) : 0.f;
            pw[i >> 1] = pk2(w0, w1);
        }
        bf16x8 pf[2];
        pf[0] = __builtin_bit_cast(bf16x8, (u32x4){pw[0], pw[1], pw[2], pw[3]});
        pf[1] = __builtin_bit_cast(bf16x8, (u32x4){pw[4], pw[5], pw[6], pw[7]});
#pragma unroll
        for (int ks = 0; ks < 2; ++ks) { o0 = MFMA_BF16(vf[0][ks], pf[ks], o0); o1 = MFMA_BF16(vf[1][ks], pf[ks], o1); }
        carry += tot;
        if (__all(carry < -160.f)) break;
    }
    bf16_t* yp = Y + (rowbase + qt * 32 + q) * D_MODEL + hd * 64 + 4 * hh;
#pragma unroll
    for (int g = 0; g < 4; ++g) {
        u32x2 w0; w0.x = pk2(o0[4 * g], o0[4 * g + 1]); w0.y = pk2(o0[4 * g + 2], o0[4 * g + 3]);
        u32x2 w1; w1.x = pk2(o1[4 * g], o1[4 * g + 1]); w1.y = pk2(o1[4 * g + 2], o1[4 * g + 3]);
        *(u32x2*)(yp + 8 * g) = w0; *(u32x2*)(yp + 32 + 8 * g) = w1;
    }
}

DI void qkprep_token(bf16_t* proj, const float* qg, const float* kg, int m, int lane) {
    const int j = lane & 31, which = lane >> 5;
    const int pos = m % SEQ;
    const float inv_freq = exp2f(-(float)j * (13.287712379549449f / 32.0f));
    const float ang = (float)pos * inv_freq;
    double t = (double)ang * 0.15915494309189535; t -= rint(t);
    const float sn = __builtin_amdgcn_sinf((float)t), cs = __builtin_amdgcn_cosf((float)t);
    const float* g = which ? kg : qg;
    const float g1 = g[j], g2 = g[j + 32];
    const float osc = which ? 1.0f : 0.125f * LOG2E;
    bf16_t* row = proj + (size_t)m * PW + (which ? C_KD : C_QD);
#pragma unroll
    for (int hd = 0; hd < 4; ++hd) {
        const float x1 = bf2f(row[hd * 64 + j]), x2 = bf2f(row[hd * 64 + 32 + j]);
        float ss = x1 * x1 + x2 * x2;
#pragma unroll
        for (int o = 1; o < 32; o <<= 1) ss += shx(ss, o, lane);
        const float r = 1.0f / sqrtf(ss * (1.0f / 64.0f) + EPS);
        const float y1 = x1 * r * g1, y2 = x2 * r * g2;
        const float o1 = (y1 * cs - y2 * sn) * osc, o2 = (y2 * cs + y1 * sn) * osc;
        row[hd * 64 + j] = (bf16_t)(pk2(o1, 0.f) & 0xffffu); row[hd * 64 + 32 + j] = (bf16_t)(pk2(o2, 0.f) & 0xffffu);
    }
}

DI void dil_unit(const bf16_t* proj, bf16_t* pnum, float* pden, int b, int hd, int pat, int rho, int jt, float m2, int lane) {
    const int r = 1 << (2 * pat);
    const int q = lane & 31, hh = lane >> 5;
    const size_t rowbase = (size_t)b * SEQ;
    const size_t rowq = rowbase + (size_t)(32 * jt + q) * r + rho;
    const bf16_t* qp = proj + rowq * PW + C_QD + hd * 64 + 8 * hh;
    bf16x8 qf[4];
#pragma unroll
    for (int ks = 0; ks < 4; ++ks) qf[ks] = *(const bf16x8*)(qp + 16 * ks);
    f32x16 o0, o1;
#pragma unroll
    for (int i = 0; i < 16; ++i) { o0[i] = 0.f; o1[i] = 0.f; }
    float den = 0.f;
    const int kt0 = (jt - 4) > 0 ? (jt - 4) : 0;
    for (int kt = kt0; kt <= jt; ++kt) {
        const bf16_t* kp = proj + (rowbase + (size_t)(32 * kt + q) * r + rho) * PW + C_KD + hd * 64 + 8 * hh;
        f32x16 S;
#pragma unroll
        for (int i = 0; i < 16; ++i) S[i] = 0.f;
#pragma unroll
        for (int ks = 0; ks < 4; ++ks) S = MFMA_BF16(*(const bf16x8*)(kp + 16 * ks), qf[ks], S);
        const bf16_t* vp = proj + (rowbase + (size_t)(32 * kt) * r + rho) * PW + C_VD + hd * 64 + q;
        bf16x8 vf[2][2];
#pragma unroll
        for (int ks = 0; ks < 2; ++ks)
#pragma unroll
            for (int j = 0; j < 8; ++j) { const bf16_t* rr = vp + (size_t)(krow(ks, hh, j) * r) * PW; vf[0][ks][j] = (short)rr[0]; vf[1][ks][j] = (short)rr[32]; }
        const int dbase = 32 * (jt - kt) + q;
        unsigned pw[8];
#pragma unroll
        for (int i = 0; i < 16; i += 2) {
            const int d0 = dbase - crow(i, hh), d1 = dbase - crow(i + 1, hh);
            const float p0 = (d0 >= 0 && d0 <= 128) ? fexp2(S[i] - m2) : 0.f, p1 = (d1 >= 0 && d1 <= 128) ? fexp2(S[i + 1] - m2) : 0.f;
            den += p0 + p1; pw[i >> 1] = pk2(p0, p1);
        }
        bf16x8 pf[2];
        pf[0] = __builtin_bit_cast(bf16x8, (u32x4){pw[0], pw[1], pw[2], pw[3]});
        pf[1] = __builtin_bit_cast(bf16x8, (u32x4){pw[4], pw[5], pw[6], pw[7]});
#pragma unroll
        for (int ks = 0; ks < 2; ++ks) { o0 = MFMA_BF16(vf[0][ks], pf[ks], o0); o1 = MFMA_BF16(vf[1][ks], pf[ks], o1); }
    }
    den += shx(den, 32, lane);
    bf16_t* np = pnum + ((size_t)pat * M_TOK + rowq) * 256 + hd * 64 + 4 * hh;
#pragma unroll
    for (int g = 0; g < 4; ++g) {
        u32x2 w0; w0.x = pk2(o0[4 * g], o0[4 * g + 1]); w0.y = pk2(o0[4 * g + 2], o0[4 * g + 3]);
        u32x2 w1; w1.x = pk2(o1[4 * g], o1[4 * g + 1]); w1.y = pk2(o1[4 * g + 2], o1[4 * g + 3]);
        *(u32x2*)(np + 8 * g) = w0; *(u32x2*)(np + 32 + 8 * g) = w1;
    }
    if (hh == 0) pden[((size_t)pat * M_TOK + rowq) * 4 + hd] = den;
}

DI void dil_merge_row(const bf16_t* pnum, const float* pden, bf16_t* Y, int m, int lane) {
    float n0 = 0.f, n1 = 0.f, n2 = 0.f, n3 = 0.f, d = 0.f;
#pragma unroll
    for (int p = 0; p < 3; ++p) {
        const u32x2 v = *(const u32x2*)(pnum + ((size_t)p * M_TOK + m) * 256 + 4 * lane);
        n0 += bflo(v.x); n1 += bfhi(v.x); n2 += bflo(v.y); n3 += bfhi(v.y);
        d += pden[((size_t)p * M_TOK + m) * 4 + (lane >> 4)];
    }
    const float rd = 1.0f / d;
    u32x2 w; w.x = pk2(n0 * rd, n1 * rd); w.y = pk2(n2 * rd, n3 * rd);
    *(u32x2*)(Y + (size_t)m * D_MODEL + 256 + 4 * lane) = w;
}

constexpr int H_LG = 0;
constexpr int H_QA = 32768;
constexpr int H_KT = H_QA + 17408;
constexpr int H_QB = H_KT + 17408;
constexpr int H_VT = H_QB + 17408;
constexpr int H_KH = H_VT + 18432;
constexpr int H_RED = H_KH + 18432;
static_assert(H_RED + 1024 <= 131072, "HGRN LDS map");

DI void hgrn_front(unsigned char* lds, const bf16_t* proj, const float* lbv  , size_t R0, int hd, int tid) {
    float* LG = (float*)(lds + H_LG);
#pragma unroll
    for (int it = 0; it < 2; ++it) {
        const int c = tid + it * 512, row = c >> 4, ch = c & 15;
        const u32x4 zz = *(const u32x4*)(proj + (R0 + row) * PW + C_FH + hd * 128 + ch * 8);
        const unsigned zw[4] = {zz.x, zz.y, zz.z, zz.w};
#pragma unroll
        for (int e = 0; e < 8; ++e) {
            const float z = (e & 1) ? bfhi(zw[e >> 1]) : bflo(zw[e >> 1]);
            const float lb = lbv[ch * 8 + e];
            const float sig = frcp(1.0f + __expf(-z));
            const float f = fmaxf(lb + (1.0f - lb) * sig, 1e-30f);
            LG[row * 128 + ch * 8 + e] = __logf(f);
        }
    }
    __syncthreads();
    const int d = tid & 127, seg = tid >> 7;
    float run = 0.f;
#pragma unroll
    for (int i = 0; i < 16; ++i) { run += LG[(16 * seg + i) * 128 + d]; LG[(16 * seg + i) * 128 + d] = run; }
    __syncthreads();
    float off = 0.f;
    for (int s2 = 0; s2 < seg; ++s2) off += LG[(16 * s2 + 15) * 128 + d];
    __syncthreads();
    if (seg > 0) {
#pragma unroll
        for (int i = 0; i < 16; ++i) LG[(16 * seg + i) * 128 + d] += off;
    }
    __syncthreads();
}

DI void hgrn_load_vt(unsigned char* lds, const bf16_t* proj, size_t R0, int col0, int tid) {
    const int v = tid & 127, seg = tid >> 7;
    const bf16_t* src = proj + (R0 + 16 * seg) * PW + col0 + v;
    unsigned w[8];
#pragma unroll
    for (int i = 0; i < 8; ++i) w[i] = (unsigned)src[(size_t)(2 * i) * PW] | ((unsigned)src[(size_t)(2 * i + 1) * PW] << 16);
    u32x4* dst = (u32x4*)(lds + H_VT + (v * 72 + 16 * seg) * 2);
    dst[0] = (u32x4){w[0], w[1], w[2], w[3]}; dst[1] = (u32x4){w[4], w[5], w[6], w[7]};
}

DI void hgrn_h1_unit(unsigned char* lds, const bf16_t* proj, const float* lball, bf16_t* ST, float* DEC, int unit, int tid, int wave, int lane) {
    const int bh = unit / NCHUNK, n = unit % NCHUNK, b = bh >> 2, hd = bh & 3;
    const size_t R0 = (size_t)b * SEQ + (size_t)n * 64;
    hgrn_front(lds, proj, lball + hd * 128, R0, hd, tid);
    const float* LG = (const float*)(lds + H_LG);
    {
        const int d = tid & 127, seg = tid >> 7;
        const float glast = LG[63 * 128 + d];
        float gprev = (seg == 0) ? 0.f : LG[(16 * seg - 1) * 128 + d];
        unsigned w[8]; float kh[16];
#pragma unroll
        for (int i = 0; i < 16; ++i) { const float g = LG[(16 * seg + i) * 128 + d]; const float k = 1.0f - __expf(g - gprev); gprev = g; kh[i] = k * __expf(glast - g); }
#pragma unroll
        for (int i = 0; i < 8; ++i) w[i] = pk2(kh[2 * i], kh[2 * i + 1]);
        u32x4* dst = (u32x4*)(lds + H_KH + (d * 72 + 16 * seg) * 2);
        dst[0] = (u32x4){w[0], w[1], w[2], w[3]}; dst[1] = (u32x4){w[4], w[5], w[6], w[7]};
        if (seg == 0) DEC[((size_t)bh * NCHUNK + n) * 128 + d] = __expf(glast);
    }
    hgrn_load_vt(lds, proj, R0, C_IH + hd * 128, tid);
    __syncthreads();
    {
        const int vt = wave >> 1, dt0 = 2 * (wave & 1), l31 = lane & 31, hh = lane >> 5;
        f32x16 a0, a1;
#pragma unroll
        for (int i = 0; i < 16; ++i) { a0[i] = 0.f; a1[i] = 0.f; }
#pragma unroll
        for (int ks = 0; ks < 4; ++ks) {
            const bf16x8 af = *(const bf16x8*)(lds + H_VT + ((32 * vt + l31) * 72 + 16 * ks + 8 * hh) * 2);
            const bf16x8 b0 = *(const bf16x8*)(lds + H_KH + ((32 * dt0 + l31) * 72 + 16 * ks + 8 * hh) * 2);
            const bf16x8 b1 = *(const bf16x8*)(lds + H_KH + ((32 * (dt0 + 1) + l31) * 72 + 16 * ks + 8 * hh) * 2);
            a0 = MFMA_BF16(af, b0, a0); a1 = MFMA_BF16(af, b1, a1);
        }
        bf16_t* st = ST + ((size_t)bh * NCHUNK + n) * 16384;
#pragma unroll
        for (int i = 0; i < 16; ++i) { const int v = 32 * vt + crow(i, hh);
            st[v * 128 + 32 * dt0 + l31] = (bf16_t)(pk2(a0[i], 0.f) & 0xffffu); st[v * 128 + 32 * (dt0 + 1) + l31] = (bf16_t)(pk2(a1[i], 0.f) & 0xffffu); }
    }
    __syncthreads();
}

DI void hgrn_scan(bf16_t* ST, const float* DEC, int gtid  ) {
    const int bh = gtid >> 14, e = gtid & 16383, d = e & 127;
    bf16_t* st = ST + (size_t)bh * NCHUNK * 16384 + e;
    const float* dc = DEC + (size_t)bh * NCHUNK * 128 + d;
    float s = 0.f;
    for (int n0 = 0; n0 < NCHUNK; n0 += 8) {
        float u[8], dd[8];
#pragma unroll
        for (int i = 0; i < 8; ++i) { u[i] = bf2f(st[(size_t)(n0 + i) * 16384]); dd[i] = dc[(n0 + i) * 128]; }
#pragma unroll
        for (int i = 0; i < 8; ++i) { st[(size_t)(n0 + i) * 16384] = (bf16_t)(pk2(s, 0.f) & 0xffffu); s = dd[i] * s + u[i]; }
    }
}

DI void hgrn_h3_unit(unsigned char* lds, const bf16_t* proj, const float* lball, const bf16_t* ST, const float* hng, bf16_t* Y, int unit, int tid, int wave, int lane) {
    const int bh = unit / NCHUNK, n = unit % NCHUNK, b = bh >> 2, hd = bh & 3;
    const size_t R0 = (size_t)b * SEQ + (size_t)n * 64;
    hgrn_front(lds, proj, lball + hd * 128, R0, hd, tid);
    const float* LG = (const float*)(lds + H_LG);
    {
        const int d = tid & 127, seg = tid >> 7;
        const float gm = LG[31 * 128 + d];
        float gprev = (seg == 0) ? 0.f : LG[(16 * seg - 1) * 128 + d];
        bf16_t* QA = (bf16_t*)(lds + H_QA); bf16_t* KT = (bf16_t*)(lds + H_KT); bf16_t* QB = (bf16_t*)(lds + H_QB);
        const bf16_t* qsrc = proj + (R0 + 16 * seg) * PW + C_QH + hd * 128 + d;
#pragma unroll
        for (int i = 0; i < 16; ++i) {
            const int t = 16 * seg + i;
            const float g = LG[t * 128 + d]; const float k = 1.0f - __expf(g - gprev); gprev = g;
            const float qv = silu_f(bf2f(qsrc[(size_t)i * PW]));
            const float e1 = __expf(fminf(g - gm, 80.f)), e2 = __expf(fminf(gm - g, 80.f)), e3 = __expf(g);
            QA[t * 136 + d] = (bf16_t)(pk2(qv * e1, 0.f) & 0xffffu);
            KT[t * 136 + d] = (bf16_t)(pk2(k * e2, 0.f) & 0xffffu);
            QB[t * 136 + d] = (bf16_t)(pk2(qv * e3, 0.f) & 0xffffu);
        }
    }
    hgrn_load_vt(lds, proj, R0, C_IH + hd * 128, tid);
    __syncthreads();
    const int vt = wave >> 1, ti = wave & 1, l31 = lane & 31, hh = lane >> 5;
    f32x16 acc;
#pragma unroll
    for (int i = 0; i < 16; ++i) acc[i] = 0.f;
    {
        const bf16_t* sp = ST + ((size_t)bh * NCHUNK + n) * 16384 + (32 * vt + l31) * 128 + 8 * hh;
#pragma unroll
        for (int ks = 0; ks < 8; ++ks) {
            const bf16x8 af = *(const bf16x8*)(sp + 16 * ks);
            const bf16x8 bfr = *(const bf16x8*)(lds + H_QB + ((32 * ti + l31) * 136 + 16 * ks + 8 * hh) * 2);
            acc = MFMA_BF16(af, bfr, acc);
        }
    }
    for (int si = 0; si <= ti; ++si) {
        f32x16 Sc;
#pragma unroll
        for (int i = 0; i < 16; ++i) Sc[i] = 0.f;
#pragma unroll
        for (int ks = 0; ks < 8; ++ks) {
            const bf16x8 af = *(const bf16x8*)(lds + H_KT + ((32 * si + l31) * 136 + 16 * ks + 8 * hh) * 2);
            const bf16x8 bfr = *(const bf16x8*)(lds + H_QA + ((32 * ti + l31) * 136 + 16 * ks + 8 * hh) * 2);
            Sc = MFMA_BF16(af, bfr, Sc);
        }
        unsigned pw[8];
#pragma unroll
        for (int i = 0; i < 16; i += 2) {
            const bool v0 = (si < ti) || (crow(i, hh) <= l31), v1 = (si < ti) || (crow(i + 1, hh) <= l31);
            pw[i >> 1] = pk2(v0 ? Sc[i] : 0.f, v1 ? Sc[i + 1] : 0.f);
        }
        bf16x8 pf[2];
        pf[0] = __builtin_bit_cast(bf16x8, (u32x4){pw[0], pw[1], pw[2], pw[3]});
        pf[1] = __builtin_bit_cast(bf16x8, (u32x4){pw[4], pw[5], pw[6], pw[7]});
#pragma unroll
        for (int ks = 0; ks < 2; ++ks) {
            const unsigned char* vb = lds + H_VT + ((32 * vt + l31) * 72 + 32 * si + 16 * ks + 4 * hh) * 2;
            const u32x2 lo = *(const u32x2*)vb, hi = *(const u32x2*)(vb + 16);
            const bf16x8 af = __builtin_bit_cast(bf16x8, (u32x4){lo.x, lo.y, hi.x, hi.y});
            acc = MFMA_BF16(af, pf[ks], acc);
        }
    }
    float ss = 0.f;
#pragma unroll
    for (int i = 0; i < 16; ++i) ss += acc[i] * acc[i];
    ss += shx(ss, 32, lane);
    float* RED = (float*)(lds + H_RED);
    if (hh == 0) RED[vt * 64 + 32 * ti + l31] = ss;
    __syncthreads();
    const int t = 32 * ti + l31;
    const float tot = RED[t] + RED[64 + t] + RED[128 + t] + RED[192 + t];
    const float rs = 1.0f / sqrtf(tot * (1.0f / 128.0f) + EPS);
    const bf16_t* gp = proj + (R0 + t) * PW + C_GH + hd * 128 + 32 * vt + 4 * hh;
    bf16_t* yp = Y + (R0 + t) * D_MODEL + 512 + hd * 128 + 32 * vt + 4 * hh;
    const float* gn = hng + 32 * vt + 4 * hh;
#pragma unroll
    for (int g = 0; g < 4; ++g) {
        const u32x2 gv = *(const u32x2*)(gp + 8 * g);
        const f32x4 nn = *(const f32x4*)(gn + 8 * g);
        const float r0 = acc[4 * g] * rs * nn.x * silu_f(bflo(gv.x)), r1 = acc[4 * g + 1] * rs * nn.y * silu_f(bfhi(gv.x));
        const float r2 = acc[4 * g + 2] * rs * nn.z * silu_f(bflo(gv.y)), r3 = acc[4 * g + 3] * rs * nn.w * silu_f(bfhi(gv.y));
        u32x2 w; w.x = pk2(r0, r1); w.y = pk2(r2, r3);
        *(u32x2*)(yp + 8 * g) = w;
    }
    __syncthreads();
}

#define CTX() \
    const __attribute__((address_space(4))) Params* kp_ = (const __attribute__((address_space(4))) Params*)__builtin_amdgcn_kernarg_segment_ptr(); asm volatile("" : "+s"(kp_)); const __attribute__((address_space(4))) Params& p = *kp_; \
    int tid_ = threadIdx.x; asm volatile("" : "+v"(tid_)); const int tid = tid_, lane = tid & 63, wave = __builtin_amdgcn_readfirstlane(tid >> 6); \
    const int G = gridDim.x, bid = blockIdx.x; const int gw = wave * G + bid, NGW = G * 8; unsigned char* ws = p.ws; \
    (void)lane; (void)gw; (void)NGW; (void)ws; (void)tid;
#define WLP(l) ((const bf16_t*)(ws + WS_WEIGHTS + (size_t)(l) * WL_SIZE))
#define MLP(l) ((const float*)(ws + WS_MOD) + (size_t)(l) * 2 * NMOD)

template <class Epi> DI void run_gemm(PG8_LAS unsigned char* glds, const bf16_t* A, const bf16_t* Bt, int N, int K, const Epi E) {
    int G_ = gridDim.x, b_ = blockIdx.x; asm volatile("" : "+s"(G_), "+s"(b_));
    pg8::Gemm g{A, Bt, M_TOK, N, K}; pg8::StaticOrder S; S.init(M_TOK, N, G_, b_);
    GEMMCALL<Epi, pg8::StaticOrder, G_ALIGN, G_SP2>(glds, g, S, E);
}

__global__ void __launch_bounds__(512) fwd_kernel(Params p_unused) {
    extern __shared__ __attribute__((aligned(16))) unsigned char lds[];
    cg::grid_group grid = cg::this_grid();
    PG8_LAS unsigned char* glds = (PG8_LAS unsigned char*)lds;
    { CTX(); if (tid < 2) ((volatile LAS unsigned*)(glds + LDS_MISC))[tid] = 0u;
      if (bid == 0) { unsigned* bw = (unsigned*)(ws + WS_BAR); for (int i = tid; i < XCD_BAR_WORDS; i += 512) bw[i] = 0u; }
      { float* RS = (float*)(ws + WS_RS); for (int i = bid * 512 + tid; i < (DEPTH + 1) * 3 * M_TOK; i += G * 512) RS[i] = 0.f; } }
#ifndef SKIP_PREP
    { CTX(); phase_prep(p, lds, gw, NGW, wave, lane); }
#endif
    grid.sync();
    { CTX(); if (tid == 0) (void)xb_add((unsigned*)(ws + WS_BAR) + XB_XCNT(xb_xcc_id()), 1u); }
#define GRID_BAR() do { CTX(); XcdBarrier xb_; xb_.bar = (unsigned*)(ws + WS_BAR); xb_.x = xb_xcc_id(); xb_.st = (volatile LAS unsigned*)(glds + LDS_MISC); xcd_barrier(xb_); } while (0)
    { CTX(); phase_prep2(p, ws, gw, NGW, lane); }
    GRID_BAR();
#define RSP(l, k) ((float*)(ws + WS_RS) + (size_t)((l) * 3 + (k)) * M_TOK)
#define SHWP(l) ((const float*)(ws + WS_SHW) + (size_t)(l) * 2 * SHW_N)

#pragma unroll 1
    for (int l = 0; l < DEPTH; ++l) {
        { CTX(); run_gemm(glds, (const bf16_t*)(ws + WS_HB), WLP(l) + WL_GU1 / 2, 2 * D_FF, D_MODEL, pg8::EpiSwiGLU{D_FF, l * 3 + 0, l * 2 * SHW_N}); }
        GRID_BAR();
        { CTX(); run_gemm(glds, (const bf16_t*)(ws + WS_ACT), WLP(l) + WL_DN1 / 2, D_MODEL, D_FF, pg8::EpiRes{(l == 0) ? 1 : 0, l * 2 * NMOD + 2 * D_MODEL, l * 2 * NMOD + 4 * D_MODEL, l * 3 + 1, 0.5f}); }
        GRID_BAR();
        { CTX(); run_gemm(glds, (const bf16_t*)(ws + WS_HB), WLP(l) + WL_IN / 2, PW, D_MODEL, pg8::EpiBf16{PW, l * 3 + 1, l * 2 * SHW_N + 2 * D_FF}); }
        GRID_BAR();
#ifndef SKIP_H1
        { CTX(); for (int u = bid; u < 8 * NCHUNK; u += G) hgrn_h1_unit(lds, (const bf16_t*)(ws + WS_ACT), (const float*)(ws + WS_LB) + l * 512, (bf16_t*)(ws + WS_ST), (float*)(ws + WS_DEC), u, tid, wave, lane); }
#endif
#ifndef SKIP_QK
        { CTX(); for (int m = gw; m < M_TOK; m += NGW) qkprep_token((bf16_t*)(ws + WS_ACT), p.qng + l * 64, p.kng + l * 64, m, lane); }
#endif
#ifndef SKIP_SB
        { CTX(); for (int u = gw; u < 8 * (SEQ / 32); u += NGW) { const int bh = u / (SEQ / 32), qt = (SEQ / 32 - 1) - u % (SEQ / 32); sb_unit((const bf16_t*)(ws + WS_ACT), (bf16_t*)(ws + WS_Y), bh >> 2, bh & 3, qt, lane); } }
#endif
        GRID_BAR();
#ifndef SKIP_SCAN
        { CTX(); hgrn_scan((bf16_t*)(ws + WS_ST), (const float*)(ws + WS_DEC), bid * 512 + tid); }
#endif
#ifndef SKIP_DIL
        { CTX();
            float gq = fabsf(p.qng[l * 64 + lane]), gk = fabsf(p.kng[l * 64 + lane]);
#pragma unroll
            for (int o = 1; o < 64; o <<= 1) { gq = fmaxf(gq, shx(gq, o, lane)); gk = fmaxf(gk, shx(gk, o, lane)); }
            const float m2 = 8.0f * gq * gk * LOG2E;
            for (int u = gw; u < 3 * 8 * 512; u += NGW) {
                const int pat = u / 4096, rem = u % 4096, bh = rem / 512, tile = rem % 512;
                const int tpr = 512 >> (2 * pat);
                dil_unit((const bf16_t*)(ws + WS_ACT), (bf16_t*)(ws + WS_PNUM), (float*)(ws + WS_PDEN), bh >> 2, bh & 3, pat, tile / tpr, tile % tpr, m2, lane);
            }
        }
#endif
        GRID_BAR();
#ifndef SKIP_H3
        { CTX(); for (int u = bid; u < 8 * NCHUNK; u += G) hgrn_h3_unit(lds, (const bf16_t*)(ws + WS_ACT), (const float*)(ws + WS_LB) + l * 512, (const bf16_t*)(ws + WS_ST), p.hng + l * 128, (bf16_t*)(ws + WS_Y), u, tid, wave, lane); }
#endif
        { CTX(); for (int m = gw; m < M_TOK; m += NGW) dil_merge_row((const bf16_t*)(ws + WS_PNUM), (const float*)(ws + WS_PDEN), (bf16_t*)(ws + WS_Y), m, lane); }
        GRID_BAR();
        { CTX(); run_gemm(glds, (const bf16_t*)(ws + WS_Y), WLP(l) + WL_OUT / 2, D_MODEL, D_MODEL, pg8::EpiRes{0, l * 2 * NMOD + 5 * D_MODEL, l * 2 * NMOD + 7 * D_MODEL, l * 3 + 2, 1.0f}); }
        GRID_BAR();
        { CTX(); run_gemm(glds, (const bf16_t*)(ws + WS_HB), WLP(l) + WL_GU2 / 2, 2 * D_FF, D_MODEL, pg8::EpiSwiGLU{D_FF, l * 3 + 2, l * 2 * SHW_N + 2 * D_FF + PW}); }
        GRID_BAR();
        { CTX(); run_gemm(glds, (const bf16_t*)(ws + WS_ACT), WLP(l) + WL_DN2 / 2, D_MODEL, D_FF, pg8::EpiRes{0, l * 2 * NMOD + 8 * D_MODEL, ((l + 1 < DEPTH) ? l + 1 : l) * 2 * NMOD + 1 * D_MODEL, (l + 1) * 3 + 0, 0.5f}); }
        GRID_BAR();
    }
}

extern "C" void kernel_launch(void* const* d_in, const int* in_sizes, int n_in, void* d_out, int out_size, void* d_ws, size_t ws_size, hipStream_t stream) {
    static int grid = 0;
    if (grid == 0) {
        if (n_in != 16 || ws_size < WS_END) { fprintf(stderr, "kernel_launch: unexpected n_in %d / ws %zu\n", n_in, ws_size); grid = -1; return; }
        int dev = 0, cus = 0, per_cu = 0;
        hipGetDevice(&dev);
        hipDeviceGetAttribute(&cus, hipDeviceAttributeMultiprocessorCount, dev);
        if (hipFuncSetAttribute((const void*)fwd_kernel, hipFuncAttributeMaxDynamicSharedMemorySize, LDS_BYTES) != hipSuccess) { fprintf(stderr, "kernel_launch: hipFuncSetAttribute failed\n"); grid = -1; return; }
        if (hipOccupancyMaxActiveBlocksPerMultiprocessor(&per_cu, (const void*)fwd_kernel, 512, LDS_BYTES) != hipSuccess || per_cu < 1) { fprintf(stderr, "kernel_launch: occupancy query gave %d\n", per_cu); per_cu = 1; }
        (void)hipGetLastError();
        grid = cus * per_cu;
    }
    if (grid < 0) return;
    Params p{};
    p.x = (const float*)d_in[0]; p.c = (const float*)d_in[1]; p.w_mod = (const float*)d_in[2]; p.b_mod = (const float*)d_in[3];
    p.f1g = (const float*)d_in[4]; p.f1u = (const float*)d_in[5]; p.f1d = (const float*)d_in[6]; p.w_in = (const float*)d_in[7]; p.w_out = (const float*)d_in[8];
    p.qng = (const float*)d_in[9]; p.kng = (const float*)d_in[10]; p.hng = (const float*)d_in[11]; p.lbl = (const float*)d_in[12];
    p.f2g = (const float*)d_in[13]; p.f2u = (const float*)d_in[14]; p.f2d = (const float*)d_in[15];
    p.out = (float*)d_out; p.ws = (unsigned char*)d_ws;
    void* args[] = {&p};
    hipError_t e = hipLaunchCooperativeKernel((const void*)fwd_kernel, dim3(grid), dim3(512), args, LDS_BYTES, stream);
    if (e != hipSuccess) fprintf(stderr, "cooperative launch failed: %s (grid %d)\n", hipGetErrorString(e), grid);
}
```

```cpp
#include <hip/hip_runtime.h>
#include <hip/hip_cooperative_groups.h>
#include <cstdio>
#include <cstdint>
namespace cg = cooperative_groups;

typedef unsigned short bf16_t;
typedef short bf16x8 __attribute__((ext_vector_type(8)));
typedef _Float16 f16x8 __attribute__((ext_vector_type(8)));
typedef float f32x2 __attribute__((ext_vector_type(2)));
typedef float f32x4 __attribute__((ext_vector_type(4)));
typedef float f32x16 __attribute__((ext_vector_type(16)));
typedef unsigned u32x2 __attribute__((ext_vector_type(2)));
typedef unsigned u32x4 __attribute__((ext_vector_type(4)));
typedef __bf16 bf16x2_t __attribute__((ext_vector_type(2)));

#define DI __device__ __forceinline__
#define LAS __attribute__((address_space(3)))

constexpr int D_MODEL = 1024, BATCH = 2, SEQ = 16384, DEPTH = 2, D_FF = 2816;
constexpr int M_TOK = BATCH * SEQ;
constexpr int PW = 3584;
constexpr int C_QA = 0, C_KA = 256, C_VA = 512, C_QD = 768, C_KD = 1024, C_VD = 1280, C_QH = 1536, C_FH = 2048, C_IH = 2560, C_GH = 3072;
constexpr int NMOD = 9 * D_MODEL;
constexpr float EPS = 1e-6f;
constexpr float LOG2E = 1.4426950408889634f;
constexpr int NCHUNK = SEQ / 64;

constexpr size_t MiB = 1u << 20;
constexpr size_t W_GU = (size_t)2 * D_FF * D_MODEL * 2;
constexpr size_t W_DN = (size_t)D_MODEL * D_FF * 2;
constexpr size_t W_IN = (size_t)PW * D_MODEL * 2;
constexpr size_t W_OUT = (size_t)D_MODEL * D_MODEL * 2;
constexpr size_t WL_GU1 = 0, WL_DN1 = WL_GU1 + W_GU, WL_IN = WL_DN1 + W_DN, WL_OUT = WL_IN + W_IN, WL_GU2 = WL_OUT + W_OUT, WL_DN2 = WL_GU2 + W_GU, WL_SIZE = WL_DN2 + W_DN;
static_assert(WL_SIZE == 44040192, "weights per layer");
constexpr size_t WS_WEIGHTS = 0;
constexpr size_t WS_SMALL = 84 * MiB;
constexpr size_t WS_MOD = WS_SMALL, WS_LB = WS_SMALL + 256 * 1024, WS_BAR = WS_SMALL + 512 * 1024;
constexpr size_t WS_DEC = 85 * MiB;
constexpr size_t WS_HB = 86 * MiB;
constexpr size_t WS_PNUM = WS_HB;
constexpr size_t WS_PDEN = WS_HB + 48 * MiB;
constexpr size_t WS_ACT = 150 * MiB;
constexpr size_t WS_Y = 374 * MiB;
constexpr size_t WS_ST = 438 * MiB;
constexpr size_t WS_RS = 502 * MiB;
constexpr size_t WS_SHW = 503 * MiB;
constexpr int SHW_N = 2 * D_FF + PW + 2 * D_FF;
constexpr size_t WS_END = 504 * MiB;

DI unsigned pk2(float lo, float hi) { f32x2 v = {lo, hi}; bf16x2_t b = __builtin_convertvector(v, bf16x2_t); return __builtin_bit_cast(unsigned, b); }
DI float bf2f(bf16_t b) { return __uint_as_float((unsigned)b << 16); }
DI float bflo(unsigned u) { return __uint_as_float(u << 16); }
DI float bfhi(unsigned u) { return __uint_as_float(u & 0xffff0000u); }
DI int crow(int reg, int h) { return (reg & 3) + 8 * (reg >> 2) + 4 * h; }
DI int krow(int s, int h, int j) { return 16 * s + 8 * (j >> 2) + 4 * h + (j & 3); }
DI float fexp2(float x) { return __builtin_amdgcn_exp2f(x); }
DI float flog2(float x) { return __builtin_amdgcn_logf(x); }
DI float frcp(float x) { return __builtin_amdgcn_rcpf(x); }
DI float silu_f(float g) { return g * frcp(1.0f + fexp2(-g * LOG2E)); }
#define MFMA_BF16(a, b, c) __builtin_amdgcn_mfma_f32_32x32x16_bf16((a), (b), (c), 0, 0, 0)
#define MFMA_F16(a, b, c) __builtin_amdgcn_mfma_f32_32x32x16_f16((a), (b), (c), 0, 0, 0)
#define LDS_WAIT() asm volatile("s_waitcnt lgkmcnt(0)" ::: "memory")

struct Params {
    const float* x; const float* c; const float* w_mod; const float* b_mod;
    const float* f1g; const float* f1u; const float* f1d; const float* w_in; const float* w_out;
    const float* qng; const float* kng; const float* hng; const float* lbl;
    const float* f2g; const float* f2u; const float* f2d;
    float* out; unsigned char* ws;
};

#ifdef SKIP_GEMM
#define GEMMCALL pg8::gemm_dummy
#else
#define GEMMCALL pg8::gemm_phase
#endif
namespace pg8 {
#define PG8_LAS __attribute__((address_space(3)))
constexpr int BM = 256, BK = 64, HALF = 128, HTB = HALF * BK * 2  , STAGE_BYTES = 8 * HTB, NXCD = 8, WGM = 8;

__host__ __device__ __forceinline__ int lds_byte(int r, int c) { const int st = (r >> 4) * 2 + (c >> 5), rr = r & 15, cc = c & 31, ob = rr * 64 + cc * 2; return st * 1024 + (ob ^ (((ob >> 9) & 1) << 5)); }
__host__ __device__ __forceinline__ void stage_rc(int b, int& R, int& C) { const int st = b / 1024, sb = b % 1024, swz = sb ^ (((sb >> 9) & 1) << 5); R = (st >> 1) * 16 + swz / 64; C = (st & 1) * 32 + (swz % 64) / 2; }
__host__ __device__ __forceinline__ int perm32(int rho) { const int n = rho >> 4, i = rho & 15; return 8 * (i >> 2) + 4 * n + (i & 3); }

struct Unit { int pm, pn; };
struct Gemm { const bf16_t* A; const bf16_t* Bt; int M, N, K; };

struct StaticOrder {
    int nM, nN, nwg, G, c;
    __host__ __device__ void init(int M, int N, int G_, int c_) { nM = M / BM; nN = N / BM; nwg = nM * nN; G = G_; c = c_; }
    __host__ __device__ bool next(int i, Unit& u) const {
        const long L = (long)i * G + c; if (L >= nwg) return false;
        int wgid = (int)L; { const int q = nwg / NXCD, r = nwg % NXCD, xcd = wgid % NXCD, off = wgid / NXCD; wgid = (xcd < r ? xcd * (q + 1) : r * (q + 1) + (xcd - r) * q) + off; }
        const int nig = WGM * nN, gid = wgid / nig, fm = gid * WGM, gsz = (nM - fm) < WGM ? (nM - fm) : WGM;
        u.pm = fm + ((wgid % nig) % gsz); u.pn = (wgid % nig) / gsz; return true;
    }
    __device__ __forceinline__ void a_ready(const Unit&) const {}
    __device__ __forceinline__ void done(const Unit&) const {}
};

#define EPI_PARAMS() const __attribute__((address_space(4))) Params* kq_ = (const __attribute__((address_space(4))) Params*)__builtin_amdgcn_kernarg_segment_ptr(); asm volatile("" : "+s"(kq_)); \
    unsigned char* const ws = kq_->ws
__device__ __forceinline__ float row_rs(const float* rowss, int row) { return 1.0f / sqrtf(rowss[row] * (1.0f / D_MODEL) + EPS); }
struct EpiBf16 {
    static constexpr bool PERM = true, AFTER_DRAIN = false;
    int ldc, rs_idx, shw_off  ;
    __device__ __forceinline__ void operator()(const f32x4 (&acc)[2][2][4][2], const Unit& u, int wr, int wc, int fr, int fq) const {
        EPI_PARAMS();
        bf16_t* O = (bf16_t*)(ws + WS_ACT); const float* rowss = (const float*)(ws + WS_RS) + (size_t)rs_idx * M_TOK; const float* shw = (const float*)(ws + WS_SHW) + shw_off;
        const int row0 = u.pm * BM + wr * 64 + fr; const int col0 = u.pn * BM + wc * 32 + 8 * fq;
        const float* sp = shw + (size_t)((u.pm * BM) / SEQ) * SHW_N + col0;
        f32x4 sv[2][2];
#pragma unroll
        for (int bj = 0; bj < 2; ++bj)
#pragma unroll
            for (int n = 0; n < 2; ++n) sv[bj][n] = *(const f32x4*)(sp + bj * HALF + 4 * n);
#pragma unroll
        for (int ai = 0; ai < 2; ++ai)
#pragma unroll
            for (int m = 0; m < 4; ++m) { const int row = row0 + ai * HALF + m * 16; bf16_t* rowp = O + (size_t)row * ldc + col0; const float rs = row_rs(rowss, row);
#pragma unroll
                for (int bj = 0; bj < 2; ++bj) { const f32x4 v0 = acc[ai][bj][m][0] * rs + sv[bj][0], v1 = acc[ai][bj][m][1] * rs + sv[bj][1];
                    u32x4 w; w.x = pk2(v0[0], v0[1]); w.y = pk2(v0[2], v0[3]); w.z = pk2(v1[0], v1[1]); w.w = pk2(v1[2], v1[3]);
                    *(u32x4*)(rowp + bj * HALF) = w; } }
    }
};
struct EpiSwiGLU {
    static constexpr bool PERM = true, AFTER_DRAIN = false;
    int ldc, rs_idx, shw_off;
    __device__ __forceinline__ void operator()(const f32x4 (&acc)[2][2][4][2], const Unit& u, int wr, int wc, int fr, int fq) const {
        EPI_PARAMS();
        bf16_t* O = (bf16_t*)(ws + WS_ACT); const float* rowss = (const float*)(ws + WS_RS) + (size_t)rs_idx * M_TOK; const float* shw = (const float*)(ws + WS_SHW) + shw_off;
        const int row0 = u.pm * BM + wr * 64 + fr; const int col0 = u.pn * HALF + wc * 32 + 8 * fq;
        const float* sp = shw + (size_t)((u.pm * BM) / SEQ) * SHW_N + u.pn * BM + wc * 32 + 8 * fq;
        f32x4 sv[2][2];
#pragma unroll
        for (int bj = 0; bj < 2; ++bj)
#pragma unroll
            for (int n = 0; n < 2; ++n) sv[bj][n] = *(const f32x4*)(sp + bj * HALF + 4 * n);
#pragma unroll
        for (int ai = 0; ai < 2; ++ai)
#pragma unroll
            for (int m = 0; m < 4; ++m) { const int row = row0 + ai * HALF + m * 16; bf16_t* rowp = O + (size_t)row * ldc + col0; const float rs = row_rs(rowss, row);
                const f32x4 g0 = acc[ai][0][m][0] * rs + sv[0][0], g1 = acc[ai][0][m][1] * rs + sv[0][1], u0 = acc[ai][1][m][0] * rs + sv[1][0], u1 = acc[ai][1][m][1] * rs + sv[1][1];
                float r[8];
#pragma unroll
                for (int e = 0; e < 4; ++e) { r[e] = silu_f(g0[e]) * u0[e]; r[4 + e] = silu_f(g1[e]) * u1[e]; }
                u32x4 w; w.x = pk2(r[0], r[1]); w.y = pk2(r[2], r[3]); w.z = pk2(r[4], r[5]); w.w = pk2(r[6], r[7]);
                *(u32x4*)rowp = w; }
    }
};
struct EpiRes {
    static constexpr bool PERM = true, AFTER_DRAIN = false;
    int x_is_input, gate_off  , scn_off, rs_idx; float coef;
    __device__ __forceinline__ void operator()(const f32x4 (&acc)[2][2][4][2], const Unit& u, int wr, int wc, int fr, int fq) const {
        EPI_PARAMS();
        float* Out = kq_->out; const float* X = x_is_input ? kq_->x : (const float*)Out;
        bf16_t* HB = (bf16_t*)(ws + WS_HB); float* rowss = (float*)(ws + WS_RS) + (size_t)rs_idx * M_TOK;
        const int row0 = u.pm * BM + wr * 64 + fr; const int col0 = u.pn * BM + wc * 32 + 8 * fq;
        const int b = (u.pm * BM) / SEQ;
        const float* gp = (const float*)(ws + WS_MOD) + gate_off + (size_t)b * NMOD + col0;
        const float* scp = (const float*)(ws + WS_MOD) + scn_off + (size_t)b * NMOD + col0;
        f32x4 gv[2][2], sc[2][2];
#pragma unroll
        for (int bj = 0; bj < 2; ++bj)
#pragma unroll
            for (int n = 0; n < 2; ++n) { gv[bj][n] = *(const f32x4*)(gp + bj * HALF + 4 * n) * coef; sc[bj][n] = *(const f32x4*)(scp + bj * HALF + 4 * n) + 1.0f; }
        const int lane = threadIdx.x & 63;
#pragma unroll
        for (int ai = 0; ai < 2; ++ai)
#pragma unroll
            for (int m = 0; m < 4; ++m) { const int row = row0 + ai * HALF + m * 16; const size_t ro = (size_t)row * D_MODEL + col0;
                float ssq = 0.f;
#pragma unroll
                for (int bj = 0; bj < 2; ++bj) {
                    f32x4 xn[2];
#pragma unroll
                    for (int n = 0; n < 2; ++n) { const f32x4 xv = *(const f32x4*)(X + ro + bj * HALF + 4 * n);
                        xn[n] = xv + gv[bj][n] * acc[ai][bj][m][n]; *(f32x4*)(Out + ro + bj * HALF + 4 * n) = xn[n]; }
                    ssq += (xn[0][0] * xn[0][0] + xn[0][1] * xn[0][1]) + (xn[0][2] * xn[0][2] + xn[0][3] * xn[0][3]) + (xn[1][0] * xn[1][0] + xn[1][1] * xn[1][1]) + (xn[1][2] * xn[1][2] + xn[1][3] * xn[1][3]);
                    const f32x4 h0 = xn[0] * sc[bj][0], h1 = xn[1] * sc[bj][1];
                    u32x4 w; w.x = pk2(h0[0], h0[1]); w.y = pk2(h0[2], h0[3]); w.z = pk2(h1[0], h1[1]); w.w = pk2(h1[2], h1[3]);
                    *(u32x4*)(HB + ro + bj * HALF) = w;
                }
                ssq += __int_as_float(__builtin_amdgcn_ds_bpermute((lane ^ 16) << 2, __float_as_int(ssq)));
                ssq += __int_as_float(__builtin_amdgcn_ds_bpermute((lane ^ 32) << 2, __float_as_int(ssq)));
                if (fq == 0) atomicAdd(rowss + row, ssq);
            }
    }
};

template <class Epi, class Sched, bool ALIGN_EPI = false, bool SP2 = false>
__device__ __forceinline__ void gemm_phase(PG8_LAS unsigned char* lds, const Gemm g, const Sched& S, const Epi& E) {
    int tid_ = threadIdx.x; asm volatile("" : "+v"(tid_));
    const int tid = tid_, wid = __builtin_amdgcn_readfirstlane(tid >> 6), lane = tid & 63, wr = wid >> 2, wc = wid & 3, fr = lane & 15, fq = lane >> 4;
    const int K = g.K, nt = K / BK;
    unsigned voffA[2], voffB[2];
#pragma unroll
    for (int i = 0; i < 2; ++i) { int R, C; stage_rc(tid * 16 + i * 8192, R, C); const int Rb = Epi::PERM ? ((R & ~31) + perm32(R & 31)) : R;
        voffA[i] = (unsigned)(R * K + C) * 2u; voffB[i] = (unsigned)(Rb * K + C) * 2u; }
    const size_t kstep = (size_t)(BK * 2);
    const size_t hstep = (size_t)HALF * K * 2;
    const size_t tstep = 2 * hstep;
    const unsigned ldsw = (unsigned)wid * 1024u;
    const int aoff = lds_byte(wr * 64 + fr, fq * 8), boff = lds_byte(wc * 32 + fr, fq * 8);
#define PG8_SA(b, h) (((b) * 2 + (h)) * HTB)
#define PG8_SB(b, h) ((4 + (b) * 2 + (h)) * HTB)
#define PG8_STAGE(bufoff, gbase, voff) do { _Pragma("unroll") for (int _i = 0; _i < 2; ++_i) \
        __builtin_amdgcn_global_load_lds((const unsigned*)((const char*)(gbase) + (voff)[_i]), (PG8_LAS unsigned*)(lds + (bufoff) + ldsw + _i * 8192), 16, 0, 0); } while (0)
#define PG8_LDA(dst, b, h) do { _Pragma("unroll") for (int m = 0; m < 4; ++m) _Pragma("unroll") for (int k = 0; k < 2; ++k) dst[m][k] = *(const PG8_LAS bf16x8*)(lds + PG8_SA(b, h) + aoff + m * 2048 + k * 1024); } while (0)
#define PG8_LDB(dst, b, h) do { _Pragma("unroll") for (int n = 0; n < 2; ++n) _Pragma("unroll") for (int k = 0; k < 2; ++k) dst[n][k] = *(const PG8_LAS bf16x8*)(lds + PG8_SB(b, h) + boff + n * 2048 + k * 1024); } while (0)
#define PG8_MMA(ai, bj, At, Bt) do { __builtin_amdgcn_s_setprio(1); _Pragma("unroll") for (int m = 0; m < 4; ++m) _Pragma("unroll") for (int n = 0; n < 2; ++n) _Pragma("unroll") for (int k = 0; k < 2; ++k) \
        acc[ai][bj][m][n] = __builtin_amdgcn_mfma_f32_16x16x32_bf16(Bt[n][k], At[m][k], acc[ai][bj][m][n], 0, 0, 0); __builtin_amdgcn_s_setprio(0); } while (0)
#define PG8_WAIT_V(n) asm volatile("s_waitcnt vmcnt(" #n ")" ::: "memory")
#define PG8_WAIT_L(n) asm volatile("s_waitcnt lgkmcnt(" #n ")" ::: "memory")
#define PG8_BAR __builtin_amdgcn_s_barrier()
#define PG8_SCHED __builtin_amdgcn_sched_barrier(0)
    Unit cur, nxt; int ui = 0;
    if (!S.next(0, cur)) return;
    f32x4 acc[2][2][4][2];
#pragma unroll
    for (int a = 0; a < 2; ++a)
#pragma unroll
        for (int b = 0; b < 2; ++b)
#pragma unroll
            for (int m = 0; m < 4; ++m)
#pragma unroll
                for (int n = 0; n < 2; ++n) acc[a][b][m][n] = (f32x4){0.f, 0.f, 0.f, 0.f};
    bf16x8 At[4][2], B0[2][2], B1[2][2];
    const char* cA = (const char*)g.A + (size_t)cur.pm * tstep; const char* cB = (const char*)g.Bt + (size_t)cur.pn * tstep;
    S.a_ready(cur);
    if constexpr (SP2) {
        PG8_STAGE(PG8_SB(0, 0), cB, voffB); PG8_STAGE(PG8_SB(0, 1), cB + hstep, voffB); PG8_STAGE(PG8_SA(0, 0), cA, voffA); PG8_STAGE(PG8_SA(0, 1), cA + hstep, voffA);
        if (wr == 1) PG8_BAR;
        PG8_WAIT_V(2); PG8_BAR;
        PG8_STAGE(PG8_SB(1, 0), cB + kstep, voffB); PG8_STAGE(PG8_SA(1, 0), cA + kstep, voffA); PG8_STAGE(PG8_SB(1, 1), cB + hstep + kstep, voffB);
        PG8_WAIT_V(6); PG8_BAR;
    } else {
        PG8_STAGE(PG8_SB(0, 0), cB, voffB); PG8_STAGE(PG8_SA(0, 0), cA, voffA); PG8_STAGE(PG8_SB(0, 1), cB + hstep, voffB); PG8_STAGE(PG8_SA(0, 1), cA + hstep, voffA);
        if (wr == 1) PG8_BAR;
        PG8_WAIT_V(4); PG8_BAR;
        PG8_STAGE(PG8_SB(1, 0), cB + kstep, voffB); PG8_STAGE(PG8_SA(1, 0), cA + kstep, voffA); PG8_STAGE(PG8_SB(1, 1), cB + hstep + kstep, voffB);
        PG8_WAIT_V(6); PG8_BAR;
    }
    for (;;) {
        const bool has_next = S.next(ui + 1, nxt);
        const char* nA = has_next ? (const char*)g.A + (size_t)nxt.pm * tstep : cA; const char* nB = has_next ? (const char*)g.Bt + (size_t)nxt.pn * tstep : cB;
        for (int t = 0; t < nt; t += 2) {
            const bool last = (t == nt - 2);
            const char* a1 = cA + (size_t)(t + 1) * kstep;
            const char* a2 = last ? nA : cA + (size_t)(t + 2) * kstep; const char* b2 = last ? nB : cB + (size_t)(t + 2) * kstep;
            const char* a3 = a2 + kstep; const char* b3 = b2 + kstep;
            if (last && has_next) S.a_ready(nxt);
            if constexpr (SP2) {
            PG8_LDB(B0, 0, 0); PG8_LDB(B1, 0, 1); PG8_SCHED; PG8_LDA(At, 0, 0); PG8_STAGE(PG8_SA(1, 1), a1 + hstep, voffA);
            PG8_WAIT_V(8); PG8_WAIT_L(0); PG8_BAR; PG8_MMA(0, 0, At, B0); PG8_MMA(0, 1, At, B1); PG8_BAR; PG8_SCHED;
            PG8_LDA(At, 0, 1); PG8_STAGE(PG8_SB(0, 0), b2, voffB); PG8_STAGE(PG8_SB(0, 1), b2 + hstep, voffB); PG8_STAGE(PG8_SA(0, 0), a2, voffA);
            PG8_WAIT_V(8); PG8_WAIT_L(0); PG8_BAR; PG8_MMA(1, 0, At, B0); PG8_MMA(1, 1, At, B1); PG8_BAR; PG8_SCHED;
            PG8_LDB(B0, 1, 0); PG8_LDB(B1, 1, 1); PG8_SCHED; PG8_LDA(At, 1, 0); PG8_STAGE(PG8_SA(0, 1), a2 + hstep, voffA);
            PG8_WAIT_V(8); PG8_WAIT_L(0); PG8_BAR; PG8_MMA(0, 0, At, B0); PG8_MMA(0, 1, At, B1); PG8_BAR; PG8_SCHED;
            PG8_LDA(At, 1, 1); PG8_STAGE(PG8_SB(1, 0), b3, voffB); PG8_STAGE(PG8_SB(1, 1), b3 + hstep, voffB); PG8_STAGE(PG8_SA(1, 0), a3, voffA);
            PG8_WAIT_V(8); PG8_WAIT_L(0); PG8_BAR; PG8_MMA(1, 0, At, B0); PG8_MMA(1, 1, At, B1); PG8_BAR; PG8_SCHED;
            } else {
            PG8_LDB(B0, 0, 0); PG8_SCHED; PG8_LDA(At, 0, 0); PG8_STAGE(PG8_SA(1, 1), a1 + hstep, voffA);
            PG8_WAIT_L(8); PG8_BAR; PG8_WAIT_L(0); PG8_MMA(0, 0, At, B0); PG8_BAR; PG8_SCHED;
            PG8_LDB(B1, 0, 1); PG8_STAGE(PG8_SB(0, 0), b2, voffB);
            PG8_BAR; PG8_WAIT_L(0); PG8_MMA(0, 1, At, B1); PG8_BAR;
            PG8_LDA(At, 0, 1); PG8_STAGE(PG8_SA(0, 0), a2, voffA);
            PG8_BAR; PG8_WAIT_L(0); PG8_MMA(1, 0, At, B0); PG8_BAR; PG8_SCHED;
            PG8_STAGE(PG8_SB(0, 1), b2 + hstep, voffB);
            PG8_WAIT_V(6); PG8_BAR; PG8_MMA(1, 1, At, B1); PG8_BAR;
            PG8_LDB(B0, 1, 0); PG8_SCHED; PG8_LDA(At, 1, 0); PG8_STAGE(PG8_SA(0, 1), a2 + hstep, voffA);
            PG8_WAIT_L(8); PG8_BAR; PG8_WAIT_L(0); PG8_MMA(0, 0, At, B0); PG8_BAR; PG8_SCHED;
            PG8_LDB(B1, 1, 1); PG8_STAGE(PG8_SB(1, 0), b3, voffB);
            PG8_BAR; PG8_WAIT_L(0); PG8_MMA(0, 1, At, B1); PG8_BAR;
            PG8_LDA(At, 1, 1); PG8_STAGE(PG8_SA(1, 0), a3, voffA);
            PG8_BAR; PG8_WAIT_L(0); PG8_MMA(1, 0, At, B0); PG8_BAR; PG8_SCHED;
            PG8_STAGE(PG8_SB(1, 1), b3 + hstep, voffB);
            PG8_WAIT_V(6); PG8_BAR; PG8_MMA(1, 1, At, B1); PG8_BAR;
            }
        }
        if constexpr (ALIGN_EPI) { if (wr == 0) PG8_BAR; }
        if constexpr (!Epi::AFTER_DRAIN) { E(acc, cur, wr, wc, fr, fq); S.done(cur); }
        if (!has_next) break;
#pragma unroll
        for (int a = 0; a < 2; ++a)
#pragma unroll
            for (int b = 0; b < 2; ++b)
#pragma unroll
                for (int m = 0; m < 4; ++m)
#pragma unroll
                    for (int n = 0; n < 2; ++n) acc[a][b][m][n] = (f32x4){0.f, 0.f, 0.f, 0.f};
        cur = nxt; cA = nA; cB = nB; ++ui;
        if constexpr (ALIGN_EPI) { if (wr == 1) PG8_BAR; }
    }
    PG8_WAIT_V(0);
    if constexpr (!ALIGN_EPI) { if (wr == 0) PG8_BAR; }
    PG8_BAR;
#undef PG8_SA
#undef PG8_SB
#undef PG8_STAGE
#undef PG8_LDA
#undef PG8_LDB
#undef PG8_MMA
#undef PG8_WAIT_V
#undef PG8_WAIT_L
#undef PG8_BAR
#undef PG8_SCHED
}
template <class Epi, class Sched, bool A=false, bool B=false> __device__ __forceinline__ void gemm_dummy(PG8_LAS unsigned char* lds, const Gemm g, const Sched& S, const Epi& E) {}
}

constexpr bool G_ALIGN = true, G_SP2 = true;
constexpr int LDS_BYTES = 147456, LDS_MISC = 131072 + 64;


template <class T> DI T* lau(T* p) { asm volatile("" : "+s"(p)); return p; }
DI float shx(float v, int o, int lane) { return __int_as_float(__builtin_amdgcn_ds_bpermute((lane ^ o) << 2, __float_as_int(v))); }
DI float wave_sum(float v, int lane) {
#pragma unroll
    for (int o = 1; o < 64; o <<= 1) v += shx(v, o, lane);
    return v;
}


#define XB_TMO      128
#define XB_XCNT(j)  (256  + 64 * (j))
#define XB_XSUB(j)  (1280 + 64 * (j))
#define XB_XGEN(j)  (2304 + 64 * (j))
#define XB_TOP      3328
#define XB_TOPGEN   3392
#define XCD_BAR_WORDS 3456
#define XB_SPIN_CAP (1u << 21)
DI unsigned xb_ld(unsigned* p)              { return __hip_atomic_load(p, __ATOMIC_RELAXED, __HIP_MEMORY_SCOPE_AGENT); }
DI unsigned xb_add(unsigned* p, unsigned v) { return __hip_atomic_fetch_add(p, v, __ATOMIC_RELAXED, __HIP_MEMORY_SCOPE_AGENT); }
DI unsigned xb_xcc_id() { return (unsigned)__builtin_amdgcn_s_getreg((3 << 11) | 20) & 0xFu; }
#define XB_SPIN(cond, bar) do { unsigned _sp = 0; while (cond) { __builtin_amdgcn_s_sleep(1); \
    if ((++_sp & 255u) == 0u) { if (xb_ld(&(bar)[XB_TMO])) break; if (_sp > XB_SPIN_CAP) { atomicAdd(&(bar)[XB_TMO], 1u); break; } } } } while (0)
struct XcdBarrier { unsigned* bar; unsigned x; volatile LAS unsigned* st; };
DI void xcd_barrier_complete(unsigned* bar, unsigned x, unsigned& nloc, unsigned& nx) {
    const unsigned G = gridDim.x * gridDim.y * gridDim.z;
    unsigned sum, cnt, mine, sp = 0u;
    for (;;) {
        sum = 0u; cnt = 0u; mine = 0u;
#pragma unroll
        for (unsigned j = 0; j < 16; ++j) { const unsigned c = xb_ld(&bar[XB_XCNT(j)]); sum += c; cnt += (c > 0u) ? 1u : 0u; mine = (j == x) ? c : mine; }
        if (sum == G) break;
        __builtin_amdgcn_s_sleep(1);
        if ((++sp & 255u) == 0u) { if (xb_ld(&bar[XB_TMO])) break; if (sp > XB_SPIN_CAP) { atomicAdd(&bar[XB_TMO], 1u); break; } }
    }
    nloc = mine > 0u ? mine : 1u; nx = cnt > 0u ? cnt : 1u;
}
DI void xcd_barrier(const XcdBarrier& b) {
    asm volatile("s_waitcnt vmcnt(0)" ::: "memory");
    __syncthreads();
    if (threadIdx.x == 0) {
        unsigned* bar = b.bar;
        __builtin_amdgcn_s_waitcnt(0);
        unsigned nloc = b.st[0], nx = b.st[1];
        if (nloc == 0u) { xcd_barrier_complete(bar, b.x, nloc, nx); b.st[0] = nloc; b.st[1] = nx; }
        const unsigned old = xb_add(&bar[XB_XSUB(b.x)], 1u);
        const unsigned gen = old / nloc;
        if (old + 1u == (gen + 1u) * nloc) {
            __builtin_amdgcn_fence(__ATOMIC_RELEASE, "agent");
            asm volatile("s_waitcnt vmcnt(0)" ::: "memory");
            const unsigned og = xb_add(&bar[XB_TOP], 1u);
            const unsigned tg = og / nx;
            if (og + 1u == (tg + 1u) * nx) xb_add(&bar[XB_TOPGEN], 1u);
            else XB_SPIN(xb_ld(&bar[XB_TOPGEN]) == tg, bar);
            __builtin_amdgcn_fence(__ATOMIC_ACQUIRE, "agent");
            xb_add(&bar[XB_XGEN(b.x)], 1u);
            asm volatile("s_waitcnt vmcnt(0)" ::: "memory");
        } else {
            XB_SPIN(xb_ld(&bar[XB_XGEN(b.x)]) == gen, bar);
            __builtin_amdgcn_fence(__ATOMIC_ACQUIRE, "agent");
            asm volatile("s_waitcnt vmcnt(0)" ::: "memory");
        }
    }
    __syncthreads();
}

DI void transpose_item(const float* W, int K, int N, bf16_t* WT, int mode, float* scr, int item, int lane) {
    const int nblk = N / 32, kb = item / nblk, nb = item % nblk, k0 = 64 * kb, n0 = 32 * nb;
    const int drow0 = (mode == 0) ? n0 : ((n0 >> 7) * 256 + (n0 & 127) + (mode == 2 ? 128 : 0));
#pragma unroll 8
    for (int i = 0; i < 32; ++i) { const int kk = 2 * i + (lane >> 5); scr[kk * 33 + (lane & 31)] = W[(size_t)(k0 + kk) * N + n0 + (lane & 31)]; }
    LDS_WAIT(); asm volatile("" ::: "memory");
    const int cch = lane & 7;
#pragma unroll
    for (int j = 0; j < 4; ++j) { const int n = (lane >> 3) + 8 * j; const float* s = scr + (8 * cch) * 33 + n;
        u32x4 o; o.x = pk2(s[0 * 33], s[1 * 33]); o.y = pk2(s[2 * 33], s[3 * 33]); o.z = pk2(s[4 * 33], s[5 * 33]); o.w = pk2(s[6 * 33], s[7 * 33]);
        *(u32x4*)(WT + (size_t)(drow0 + n) * K + k0 + 8 * cch) = o; }
    LDS_WAIT(); asm volatile("" ::: "memory");
}

template <class PT> DI void phase_prep(const PT& p, unsigned char* lds, int gw, int NGW, int wave, int lane) {
    float* scr = (float*)(lds + wave * 16384);
    constexpr int I_G = (D_MODEL / 64) * (D_FF / 32);
    constexpr int I_D = (D_FF / 64) * (D_MODEL / 32);
    constexpr int I_IN = (D_MODEL / 64) * (PW / 32);
    constexpr int I_OUT = (D_MODEL / 64) * (D_MODEL / 32);
    constexpr int I_LAYER = 4 * I_G + 2 * I_D + I_IN + I_OUT;
    constexpr int I_MOD = DEPTH * (NMOD / 64);
    constexpr int NITEMS = I_MOD + 1 + DEPTH * I_LAYER;
    for (int it = gw; it < NITEMS; it += NGW) {
        if (it < I_MOD) {
            const int l = it / (NMOD / 64), n = (it % (NMOD / 64)) * 64 + lane;
            for (int k = lane; k < 2 * D_MODEL; k += 64) scr[k] = silu_f(p.c[k]);
            LDS_WAIT(); asm volatile("" ::: "memory");
            const float* W = p.w_mod + (size_t)l * D_MODEL * NMOD + n;
            float a0 = 0.f, a1 = 0.f;
#pragma unroll 8
            for (int k = 0; k < D_MODEL; ++k) { const float w = W[(size_t)k * NMOD]; a0 += scr[k] * w; a1 += scr[D_MODEL + k] * w; }
            const float bm = p.b_mod[l * NMOD + n];
            float* mod = (float*)(p.ws + WS_MOD);
            mod[(l * 2 + 0) * NMOD + n] = a0 + bm; mod[(l * 2 + 1) * NMOD + n] = a1 + bm;
            LDS_WAIT(); asm volatile("" ::: "memory");
            continue;
        }
        if (it == I_MOD) {
            float* lb = (float*)(p.ws + WS_LB);
            for (int i = lane; i < 512; i += 64) { const float l0 = p.lbl[i], l1 = p.lbl[512 + i]; const float mx = fmaxf(l0, l1);
                const float e0 = __expf(l0 - mx), e1 = __expf(l1 - mx); const float s0 = e0 / (e0 + e1), s1 = e1 / (e0 + e1);
                lb[i] = fminf(fmaxf(s0 - s0, 0.f), 1.0f - EPS); lb[512 + i] = fminf(fmaxf((s0 + s1) - s0, 0.f), 1.0f - EPS); }
            continue;
        }
        int r = it - I_MOD - 1; const int l = r / I_LAYER; r -= l * I_LAYER;
        bf16_t* wl = (bf16_t*)(p.ws + WS_WEIGHTS + (size_t)l * WL_SIZE);
        const size_t o_gu = (size_t)l * D_MODEL * D_FF, o_in = (size_t)l * D_MODEL * PW, o_out = (size_t)l * D_MODEL * D_MODEL;
        if (r < I_G) { transpose_item(p.f1g + o_gu, D_MODEL, D_FF, wl + WL_GU1 / 2, 1, scr, r, lane); continue; } r -= I_G;
        if (r < I_G) { transpose_item(p.f1u + o_gu, D_MODEL, D_FF, wl + WL_GU1 / 2, 2, scr, r, lane); continue; } r -= I_G;
        if (r < I_D) { transpose_item(p.f1d + o_gu, D_FF, D_MODEL, wl + WL_DN1 / 2, 0, scr, r, lane); continue; } r -= I_D;
        if (r < I_IN) { transpose_item(p.w_in + o_in, D_MODEL, PW, wl + WL_IN / 2, 0, scr, r, lane); continue; } r -= I_IN;
        if (r < I_OUT) { transpose_item(p.w_out + o_out, D_MODEL, D_MODEL, wl + WL_OUT / 2, 0, scr, r, lane); continue; } r -= I_OUT;
        if (r < I_G) { transpose_item(p.f2g + o_gu, D_MODEL, D_FF, wl + WL_GU2 / 2, 1, scr, r, lane); continue; } r -= I_G;
        if (r < I_G) { transpose_item(p.f2u + o_gu, D_MODEL, D_FF, wl + WL_GU2 / 2, 2, scr, r, lane); continue; } r -= I_G;
        transpose_item(p.f2d + o_gu, D_FF, D_MODEL, wl + WL_DN2 / 2, 0, scr, r, lane);
    }
}


template <class PT> DI void phase_prep2(const PT& p, unsigned char* ws, int gw, int NGW, int lane) {
    const float* mod = (const float*)(ws + WS_MOD);
    float* SHW = (float*)(ws + WS_SHW);
    for (int it = gw; it < DEPTH * SHW_N; it += NGW) {
        const int l = it / SHW_N, j = it % SHW_N;
        const bf16_t* wl = (const bf16_t*)(ws + WS_WEIGHTS + (size_t)l * WL_SIZE); const bf16_t* row; int shsel;
        if (j < 2 * D_FF) { row = wl + WL_GU1 / 2 + (size_t)j * D_MODEL; shsel = 0; }
        else if (j < 2 * D_FF + PW) { row = wl + WL_IN / 2 + (size_t)(j - 2 * D_FF) * D_MODEL; shsel = 3; }
        else { row = wl + WL_GU2 / 2 + (size_t)(j - 2 * D_FF - PW) * D_MODEL; shsel = 6; }
        const float* sh0 = mod + (size_t)(l * 2) * NMOD + shsel * D_MODEL; const float* sh1 = sh0 + NMOD;
        float a0 = 0.f, a1 = 0.f;
#pragma unroll
        for (int h = 0; h < 2; ++h) { const int k0 = h * 512 + 8 * lane; const u32x4 w = *(const u32x4*)(row + k0);
            const float wv[8] = {bflo(w.x), bfhi(w.x), bflo(w.y), bfhi(w.y), bflo(w.z), bfhi(w.z), bflo(w.w), bfhi(w.w)};
            const f32x4 s00 = *(const f32x4*)(sh0 + k0), s01 = *(const f32x4*)(sh0 + k0 + 4), s10 = *(const f32x4*)(sh1 + k0), s11 = *(const f32x4*)(sh1 + k0 + 4);
#pragma unroll
            for (int e = 0; e < 4; ++e) { a0 += wv[e] * s00[e] + wv[4 + e] * s01[e]; a1 += wv[e] * s10[e] + wv[4 + e] * s11[e]; } }
        a0 = wave_sum(a0, lane); a1 = wave_sum(a1, lane);
        if (lane == 0) { SHW[(size_t)(l * 2 + 0) * SHW_N + j] = a0; SHW[(size_t)(l * 2 + 1) * SHW_N + j] = a1; }
    }
    bf16_t* HB = (bf16_t*)(ws + WS_HB); float* RS = (float*)(ws + WS_RS);
    for (int m = gw; m < M_TOK; m += NGW) {
        const int b = m / SEQ;
        const f32x4* xr = (const f32x4*)(p.x + (size_t)m * D_MODEL) + lane;
        const float* sc = mod + (size_t)b * NMOD + 1 * D_MODEL;
        f32x4 v[4]; float ss = 0.f;
#pragma unroll
        for (int j = 0; j < 4; ++j) { v[j] = xr[64 * j]; ss += (v[j].x * v[j].x + v[j].y * v[j].y) + (v[j].z * v[j].z + v[j].w * v[j].w); }
        ss = wave_sum(ss, lane);
        if (lane == 0) RS[m] = ss;
        u32x2* o8 = (u32x2*)(HB + (size_t)m * D_MODEL) + lane;
#pragma unroll
        for (int j = 0; j < 4; ++j) { const f32x4 h = v[j] * (*((const f32x4*)sc + lane + 64 * j) + 1.0f);
            u32x2 w; w.x = pk2(h.x, h.y); w.y = pk2(h.z, h.w); o8[64 * j] = w; }
    }
}

DI void phase_norm(const float* X, const float* sh, const float* sc, bf16_t* HB, int gw, int NGW, int lane) {
    for (int m = gw; m < M_TOK; m += NGW) {
        const int b = m / SEQ;
        const f32x4* xr = (const f32x4*)(X + (size_t)m * D_MODEL) + lane;
        f32x4 v[4]; float s = 0.f;
#pragma unroll
        for (int j = 0; j < 4; ++j) { v[j] = xr[64 * j]; s += (v[j].x * v[j].x + v[j].y * v[j].y) + (v[j].z * v[j].z + v[j].w * v[j].w); }
        const float r = 1.0f / sqrtf(wave_sum(s, lane) * (1.0f / D_MODEL) + EPS);
        u32x2* o8 = (u32x2*)(HB + (size_t)m * D_MODEL) + lane;
#pragma unroll
        for (int j = 0; j < 4; ++j) {
            const f32x4 scv = *((const f32x4*)(sc + (size_t)b * NMOD) + lane + 64 * j), shv = *((const f32x4*)(sh + (size_t)b * NMOD) + lane + 64 * j);
            const f32x4 h = v[j] * r * (scv + 1.0f) + shv;
            u32x2 w; w.x = pk2(h.x, h.y); w.y = pk2(h.z, h.w); o8[64 * j] = w; }
    }
}

typedef short v4i16_t __attribute__((ext_vector_type(4)));
constexpr int VT_PITCH = 144;
constexpr int VT_TILE = 32 * VT_PITCH;
constexpr int ATT_LDS_PER_WAVE = 2 * VT_TILE;
DI void v_stage(LAS unsigned char* vt, const u32x4 (&v)[4], int lane) {
    LAS unsigned char* p = vt + (lane & 31) * VT_PITCH + (lane >> 5) * 16;
#pragma unroll
    for (int ks = 0; ks < 4; ++ks) *(LAS u32x4*)(p + 32 * ks) = v[ks];
}
DI bf16x8 v_frag(LAS unsigned char* vt, int dt, int ks2, int lane) {
    const int hh = lane >> 5, blk = (lane >> 4) & 1, q = (lane & 15) >> 2, p = lane & 3;
    LAS unsigned char* a = vt + (16 * ks2 + 4 * hh + q) * VT_PITCH + (32 * dt + 16 * blk + 4 * p) * 2;
    const v4i16_t lo = __builtin_amdgcn_ds_read_tr16_b64_v4i16((LAS v4i16_t*)a);
    const v4i16_t hi = __builtin_amdgcn_ds_read_tr16_b64_v4i16((LAS v4i16_t*)(a + 8 * VT_PITCH));
    bf16x8 r; r[0] = lo[0]; r[1] = lo[1]; r[2] = lo[2]; r[3] = lo[3]; r[4] = hi[0]; r[5] = hi[1]; r[6] = hi[2]; r[7] = hi[3];
    return r;
}

DI void sb_unit(const bf16_t* proj, bf16_t* Y, LAS unsigned char* vl, int b, int hd, int qt, int lane) {
    const int q = lane & 31, hh = lane >> 5;
    const size_t rowbase = (size_t)b * SEQ;
    const bf16_t* qp = proj + (rowbase + qt * 32 + q) * PW + C_QA + hd * 64 + 8 * hh;
    bf16x8 qf[4];
#pragma unroll
    for (int ks = 0; ks < 4; ++ks) qf[ks] = *(const bf16x8*)(qp + 16 * ks);
    f16x8 tf[2];
#pragma unroll
    for (int ks = 0; ks < 2; ++ks)
#pragma unroll
        for (int j = 0; j < 8; ++j) tf[ks][j] = (krow(ks, hh, j) > q) ? (_Float16)1.0f : (_Float16)0.0f;
    f32x16 o0, o1;
#pragma unroll
    for (int i = 0; i < 16; ++i) { o0[i] = 0.f; o1[i] = 0.f; }
    float carry = 0.f;
    const float SC = 0.125f * LOG2E;
    const bf16_t* kvrow = proj + (rowbase + q) * PW + hd * 64 + 8 * hh;
    bf16x8 kc[4]; u32x4 vc[4];
#pragma unroll
    for (int ks = 0; ks < 4; ++ks) { const bf16_t* r = kvrow + (size_t)(32 * qt) * PW + 16 * ks; kc[ks] = *(const bf16x8*)(r + C_KA); vc[ks] = *(const u32x4*)(r + C_VA); }
    int buf = 0;
    v_stage(vl, vc, lane);
    for (int kt = qt; kt >= 0; --kt) {
        bf16x8 kn[4]; u32x4 vn[4];
        const int ktn = kt > 0 ? kt - 1 : 0;
#pragma unroll
        for (int ks = 0; ks < 4; ++ks) { const bf16_t* r = kvrow + (size_t)(32 * ktn) * PW + 16 * ks; kn[ks] = *(const bf16x8*)(r + C_KA); vn[ks] = *(const u32x4*)(r + C_VA); }
        f32x16 S;
#pragma unroll
        for (int i = 0; i < 16; ++i) S[i] = 0.f;
#pragma unroll
        for (int ks = 0; ks < 4; ++ks) S = MFMA_BF16(kc[ks], qf[ks], S);
        const bool diag = (kt == qt);
        float lnb[16], lw[16]; float tot = 0.f;
#pragma unroll
        for (int i = 0; i < 16; ++i) {
            const float z2 = fminf(S[i] * SC, 100.f);
            const float sp = flog2(1.0f + fexp2(z2));
            const bool valid = !diag || (crow(i, hh) < q);
            lnb[i] = valid ? -sp : 0.f; lw[i] = z2 - sp; tot += lnb[i];
        }
        tot += shx(tot, 32, lane);
        f16x8 lf[2];
#pragma unroll
        for (int ks = 0; ks < 2; ++ks)
#pragma unroll
            for (int j = 0; j < 8; ++j) lf[ks][j] = (_Float16)lnb[8 * ks + j];
        f32x16 T;
#pragma unroll
        for (int i = 0; i < 16; ++i) T[i] = 0.f;
#pragma unroll
        for (int ks = 0; ks < 2; ++ks) T = MFMA_F16(tf[ks], lf[ks], T);
        unsigned pw[8];
#pragma unroll
        for (int i = 0; i < 16; i += 2) {
            const bool v0 = !diag || (crow(i, hh) < q), v1 = !diag || (crow(i + 1, hh) < q);
            const float w0 = v0 ? fexp2(lw[i] + T[i] + carry) : 0.f, w1 = v1 ? fexp2(lw[i + 1] + T[i + 1] + carry) : 0.f;
            pw[i >> 1] = pk2(w0, w1);
        }
        bf16x8 pf[2];
        pf[0] = __builtin_bit_cast(bf16x8, (u32x4){pw[0], pw[1], pw[2], pw[3]});
        pf[1] = __builtin_bit_cast(bf16x8, (u32x4){pw[4], pw[5], pw[6], pw[7]});
        LAS unsigned char* vt = vl + buf * VT_TILE;
#pragma unroll
        for (int ks = 0; ks < 2; ++ks) { o0 = MFMA_BF16(v_frag(vt, 0, ks, lane), pf[ks], o0); o1 = MFMA_BF16(v_frag(vt, 1, ks, lane), pf[ks], o1); }
        carry += tot;
        if (__all(carry < -160.f)) break;
        buf ^= 1;
        v_stage(vl + buf * VT_TILE, vn, lane);
#pragma unroll
        for (int ks = 0; ks < 4; ++ks) kc[ks] = kn[ks];
    }
    bf16_t* yp = Y + (rowbase + qt * 32 + q) * D_MODEL + hd * 64 + 4 * hh;
#pragma unroll
    for (int g = 0; g < 4; ++g) {
        u32x2 w0; w0.x = pk2(o0[4 * g], o0[4 * g + 1]); w0.y = pk2(o0[4 * g + 2], o0[4 * g + 3]);
        u32x2 w1; w1.x = pk2(o1[4 * g], o1[4 * g + 1]); w1.y = pk2(o1[4 * g + 2], o1[4 * g + 3]);
        *(u32x2*)(yp + 8 * g) = w0; *(u32x2*)(yp + 32 + 8 * g) = w1;
    }
}

DI void qkprep_token(bf16_t* proj, const float* qg, const float* kg, int m, int lane) {
    const int j = lane & 31, which = lane >> 5;
    const int pos = m % SEQ;
    const float inv_freq = exp2f(-(float)j * (13.287712379549449f / 32.0f));
    const float ang = (float)pos * inv_freq;
    double t = (double)ang * 0.15915494309189535; t -= rint(t);
    const float sn = __builtin_amdgcn_sinf((float)t), cs = __builtin_amdgcn_cosf((float)t);
    const float* g = which ? kg : qg;
    const float g1 = g[j], g2 = g[j + 32];
    const float osc = which ? 1.0f : 0.125f * LOG2E;
    bf16_t* row = proj + (size_t)m * PW + (which ? C_KD : C_QD);
#pragma unroll
    for (int hd = 0; hd < 4; ++hd) {
        const float x1 = bf2f(row[hd * 64 + j]), x2 = bf2f(row[hd * 64 + 32 + j]);
        float ss = x1 * x1 + x2 * x2;
#pragma unroll
        for (int o = 1; o < 32; o <<= 1) ss += shx(ss, o, lane);
        const float r = 1.0f / sqrtf(ss * (1.0f / 64.0f) + EPS);
        const float y1 = x1 * r * g1, y2 = x2 * r * g2;
        const float o1 = (y1 * cs - y2 * sn) * osc, o2 = (y2 * cs + y1 * sn) * osc;
        row[hd * 64 + j] = (bf16_t)(pk2(o1, 0.f) & 0xffffu); row[hd * 64 + 32 + j] = (bf16_t)(pk2(o2, 0.f) & 0xffffu);
    }
}

DI void dil_unit(const bf16_t* proj, bf16_t* pnum, float* pden, LAS unsigned char* vl, int b, int hd, int pat, int rho, int jt, float m2, int lane) {
    const int r = 1 << (2 * pat);
    const int q = lane & 31, hh = lane >> 5;
    const size_t rowbase = (size_t)b * SEQ;
    const size_t rowq = rowbase + (size_t)(32 * jt + q) * r + rho;
    const bf16_t* qp = proj + rowq * PW + C_QD + hd * 64 + 8 * hh;
    bf16x8 qf[4];
#pragma unroll
    for (int ks = 0; ks < 4; ++ks) qf[ks] = *(const bf16x8*)(qp + 16 * ks);
    f32x16 o0, o1;
#pragma unroll
    for (int i = 0; i < 16; ++i) { o0[i] = 0.f; o1[i] = 0.f; }
    float den = 0.f;
    const int kt0 = (jt - 4) > 0 ? (jt - 4) : 0;
    const bf16_t* kvrow = proj + (rowbase + (size_t)q * r + rho) * PW + hd * 64 + 8 * hh;
    const size_t tstride = (size_t)32 * r * PW;
    bf16x8 kc[4]; u32x4 vc[4];
#pragma unroll
    for (int ks = 0; ks < 4; ++ks) { const bf16_t* rr = kvrow + kt0 * tstride + 16 * ks; kc[ks] = *(const bf16x8*)(rr + C_KD); vc[ks] = *(const u32x4*)(rr + C_VD); }
    int buf = 0;
    v_stage(vl, vc, lane);
    for (int kt = kt0; kt <= jt; ++kt) {
        bf16x8 kn[4]; u32x4 vn[4];
        const int ktn = kt < jt ? kt + 1 : jt;
#pragma unroll
        for (int ks = 0; ks < 4; ++ks) { const bf16_t* rr = kvrow + ktn * tstride + 16 * ks; kn[ks] = *(const bf16x8*)(rr + C_KD); vn[ks] = *(const u32x4*)(rr + C_VD); }
        f32x16 S;
#pragma unroll
        for (int i = 0; i < 16; ++i) S[i] = 0.f;
#pragma unroll
        for (int ks = 0; ks < 4; ++ks) S = MFMA_BF16(kc[ks], qf[ks], S);
        const int dbase = 32 * (jt - kt) + q;
        unsigned pw[8];
#pragma unroll
        for (int i = 0; i < 16; i += 2) {
            const int d0 = dbase - crow(i, hh), d1 = dbase - crow(i + 1, hh);
            const float p0 = (d0 >= 0 && d0 <= 128) ? fexp2(S[i] - m2) : 0.f, p1 = (d1 >= 0 && d1 <= 128) ? fexp2(S[i + 1] - m2) : 0.f;
            den += p0 + p1; pw[i >> 1] = pk2(p0, p1);
        }
        bf16x8 pf[2];
        pf[0] = __builtin_bit_cast(bf16x8, (u32x4){pw[0], pw[1], pw[2], pw[3]});
        pf[1] = __builtin_bit_cast(bf16x8, (u32x4){pw[4], pw[5], pw[6], pw[7]});
        LAS unsigned char* vt = vl + buf * VT_TILE;
#pragma unroll
        for (int ks = 0; ks < 2; ++ks) { o0 = MFMA_BF16(v_frag(vt, 0, ks, lane), pf[ks], o0); o1 = MFMA_BF16(v_frag(vt, 1, ks, lane), pf[ks], o1); }
        buf ^= 1;
        v_stage(vl + buf * VT_TILE, vn, lane);
#pragma unroll
        for (int ks = 0; ks < 4; ++ks) kc[ks] = kn[ks];
    }
    den += shx(den, 32, lane);
    bf16_t* np = pnum + ((size_t)pat * M_TOK + rowq) * 256 + hd * 64 + 4 * hh;
#pragma unroll
    for (int g = 0; g < 4; ++g) {
        u32x2 w0; w0.x = pk2(o0[4 * g], o0[4 * g + 1]); w0.y = pk2(o0[4 * g + 2], o0[4 * g + 3]);
        u32x2 w1; w1.x = pk2(o1[4 * g], o1[4 * g + 1]); w1.y = pk2(o1[4 * g + 2], o1[4 * g + 3]);
        *(u32x2*)(np + 8 * g) = w0; *(u32x2*)(np + 32 + 8 * g) = w1;
    }
    if (hh == 0) pden[((size_t)pat * M_TOK + rowq) * 4 + hd] = den;
}

DI void dil_merge_row(const bf16_t* pnum, const float* pden, bf16_t* Y, int m, int lane) {
    float n0 = 0.f, n1 = 0.f, n2 = 0.f, n3 = 0.f, d = 0.f;
#pragma unroll
    for (int p = 0; p < 3; ++p) {
        const u32x2 v = *(const u32x2*)(pnum + ((size_t)p * M_TOK + m) * 256 + 4 * lane);
        n0 += bflo(v.x); n1 += bfhi(v.x); n2 += bflo(v.y); n3 += bfhi(v.y);
        d += pden[((size_t)p * M_TOK + m) * 4 + (lane >> 4)];
    }
    const float rd = 1.0f / d;
    u32x2 w; w.x = pk2(n0 * rd, n1 * rd); w.y = pk2(n2 * rd, n3 * rd);
    *(u32x2*)(Y + (size_t)m * D_MODEL + 256 + 4 * lane) = w;
}

constexpr int H_LG = 0;
constexpr int H_QA = 32768;
constexpr int H_KT = H_QA + 17408;
constexpr int H_QB = H_KT + 17408;
constexpr int H_VT = H_QB + 17408;
constexpr int H_KH = H_VT + 18432;
constexpr int H_RED = H_KH + 18432;
static_assert(H_RED + 1024 <= 131072, "HGRN LDS map");

DI void hgrn_front(unsigned char* lds, const bf16_t* proj, const float* lbv  , size_t R0, int hd, int tid) {
    float* LG = (float*)(lds + H_LG);
#pragma unroll
    for (int it = 0; it < 2; ++it) {
        const int c = tid + it * 512, row = c >> 4, ch = c & 15;
        const u32x4 zz = *(const u32x4*)(proj + (R0 + row) * PW + C_FH + hd * 128 + ch * 8);
        const unsigned zw[4] = {zz.x, zz.y, zz.z, zz.w};
#pragma unroll
        for (int e = 0; e < 8; ++e) {
            const float z = (e & 1) ? bfhi(zw[e >> 1]) : bflo(zw[e >> 1]);
            const float lb = lbv[ch * 8 + e];
            const float sig = frcp(1.0f + __expf(-z));
            const float f = fmaxf(lb + (1.0f - lb) * sig, 1e-30f);
            LG[row * 128 + ch * 8 + e] = __logf(f);
        }
    }
    __syncthreads();
    const int d = tid & 127, seg = tid >> 7;
    float run = 0.f;
#pragma unroll
    for (int i = 0; i < 16; ++i) { run += LG[(16 * seg + i) * 128 + d]; LG[(16 * seg + i) * 128 + d] = run; }
    __syncthreads();
    float off = 0.f;
    for (int s2 = 0; s2 < seg; ++s2) off += LG[(16 * s2 + 15) * 128 + d];
    __syncthreads();
    if (seg > 0) {
#pragma unroll
        for (int i = 0; i < 16; ++i) LG[(16 * seg + i) * 128 + d] += off;
    }
    __syncthreads();
}

DI void hgrn_load_vt(unsigned char* lds, const bf16_t* proj, size_t R0, int col0, int tid) {
    const int v = tid & 127, seg = tid >> 7;
    const bf16_t* src = proj + (R0 + 16 * seg) * PW + col0 + v;
    unsigned w[8];
#pragma unroll
    for (int i = 0; i < 8; ++i) w[i] = (unsigned)src[(size_t)(2 * i) * PW] | ((unsigned)src[(size_t)(2 * i + 1) * PW] << 16);
    u32x4* dst = (u32x4*)(lds + H_VT + (v * 72 + 16 * seg) * 2);
    dst[0] = (u32x4){w[0], w[1], w[2], w[3]}; dst[1] = (u32x4){w[4], w[5], w[6], w[7]};
}

DI void hgrn_h1_unit(unsigned char* lds, const bf16_t* proj, const float* lball, bf16_t* ST, float* DEC, int unit, int tid, int wave, int lane) {
    const int bh = unit / NCHUNK, n = unit % NCHUNK, b = bh >> 2, hd = bh & 3;
    const size_t R0 = (size_t)b * SEQ + (size_t)n * 64;
    hgrn_front(lds, proj, lball + hd * 128, R0, hd, tid);
    const float* LG = (const float*)(lds + H_LG);
    {
        const int d = tid & 127, seg = tid >> 7;
        const float glast = LG[63 * 128 + d];
        float gprev = (seg == 0) ? 0.f : LG[(16 * seg - 1) * 128 + d];
        unsigned w[8]; float kh[16];
#pragma unroll
        for (int i = 0; i < 16; ++i) { const float g = LG[(16 * seg + i) * 128 + d]; const float k = 1.0f - __expf(g - gprev); gprev = g; kh[i] = k * __expf(glast - g); }
#pragma unroll
        for (int i = 0; i < 8; ++i) w[i] = pk2(kh[2 * i], kh[2 * i + 1]);
        u32x4* dst = (u32x4*)(lds + H_KH + (d * 72 + 16 * seg) * 2);
        dst[0] = (u32x4){w[0], w[1], w[2], w[3]}; dst[1] = (u32x4){w[4], w[5], w[6], w[7]};
        if (seg == 0) DEC[((size_t)bh * NCHUNK + n) * 128 + d] = __expf(glast);
    }
    hgrn_load_vt(lds, proj, R0, C_IH + hd * 128, tid);
    __syncthreads();
    {
        const int vt = wave >> 1, dt0 = 2 * (wave & 1), l31 = lane & 31, hh = lane >> 5;
        f32x16 a0, a1;
#pragma unroll
        for (int i = 0; i < 16; ++i) { a0[i] = 0.f; a1[i] = 0.f; }
#pragma unroll
        for (int ks = 0; ks < 4; ++ks) {
            const bf16x8 af = *(const bf16x8*)(lds + H_VT + ((32 * vt + l31) * 72 + 16 * ks + 8 * hh) * 2);
            const bf16x8 b0 = *(const bf16x8*)(lds + H_KH + ((32 * dt0 + l31) * 72 + 16 * ks + 8 * hh) * 2);
            const bf16x8 b1 = *(const bf16x8*)(lds + H_KH + ((32 * (dt0 + 1) + l31) * 72 + 16 * ks + 8 * hh) * 2);
            a0 = MFMA_BF16(af, b0, a0); a1 = MFMA_BF16(af, b1, a1);
        }
        bf16_t* st = ST + ((size_t)bh * NCHUNK + n) * 16384;
#pragma unroll
        for (int i = 0; i < 16; ++i) { const int v = 32 * vt + crow(i, hh);
            st[v * 128 + 32 * dt0 + l31] = (bf16_t)(pk2(a0[i], 0.f) & 0xffffu); st[v * 128 + 32 * (dt0 + 1) + l31] = (bf16_t)(pk2(a1[i], 0.f) & 0xffffu); }
    }
    __syncthreads();
}

DI void hgrn_scan(bf16_t* ST, const float* DEC, int gtid  ) {
    const int bh = gtid >> 14, e = gtid & 16383, d = e & 127;
    bf16_t* st = ST + (size_t)bh * NCHUNK * 16384 + e;
    const float* dc = DEC + (size_t)bh * NCHUNK * 128 + d;
    float s = 0.f;
    for (int n0 = 0; n0 < NCHUNK; n0 += 8) {
        float u[8], dd[8];
#pragma unroll
        for (int i = 0; i < 8; ++i) { u[i] = bf2f(st[(size_t)(n0 + i) * 16384]); dd[i] = dc[(n0 + i) * 128]; }
#pragma unroll
        for (int i = 0; i < 8; ++i) { st[(size_t)(n0 + i) * 16384] = (bf16_t)(pk2(s, 0.f) & 0xffffu); s = dd[i] * s + u[i]; }
    }
}

DI void hgrn_h3_unit(unsigned char* lds, const bf16_t* proj, const float* lball, const bf16_t* ST, const float* hng, bf16_t* Y, int unit, int tid, int wave, int lane) {
    const int bh = unit / NCHUNK, n = unit % NCHUNK, b = bh >> 2, hd = bh & 3;
    const size_t R0 = (size_t)b * SEQ + (size_t)n * 64;
    hgrn_front(lds, proj, lball + hd * 128, R0, hd, tid);
    const float* LG = (const float*)(lds + H_LG);
    {
        const int d = tid & 127, seg = tid >> 7;
        const float gm = LG[31 * 128 + d];
        float gprev = (seg == 0) ? 0.f : LG[(16 * seg - 1) * 128 + d];
        bf16_t* QA = (bf16_t*)(lds + H_QA); bf16_t* KT = (bf16_t*)(lds + H_KT); bf16_t* QB = (bf16_t*)(lds + H_QB);
        const bf16_t* qsrc = proj + (R0 + 16 * seg) * PW + C_QH + hd * 128 + d;
#pragma unroll
        for (int i = 0; i < 16; ++i) {
            const int t = 16 * seg + i;
            const float g = LG[t * 128 + d]; const float k = 1.0f - __expf(g - gprev); gprev = g;
            const float qv = silu_f(bf2f(qsrc[(size_t)i * PW]));
            const float e1 = __expf(fminf(g - gm, 80.f)), e2 = __expf(fminf(gm - g, 80.f)), e3 = __expf(g);
            QA[t * 136 + d] = (bf16_t)(pk2(qv * e1, 0.f) & 0xffffu);
            KT[t * 136 + d] = (bf16_t)(pk2(k * e2, 0.f) & 0xffffu);
            QB[t * 136 + d] = (bf16_t)(pk2(qv * e3, 0.f) & 0xffffu);
        }
    }
    hgrn_load_vt(lds, proj, R0, C_IH + hd * 128, tid);
    __syncthreads();
    const int vt = wave >> 1, ti = wave & 1, l31 = lane & 31, hh = lane >> 5;
    f32x16 acc;
#pragma unroll
    for (int i = 0; i < 16; ++i) acc[i] = 0.f;
    {
        const bf16_t* sp = ST + ((size_t)bh * NCHUNK + n) * 16384 + (32 * vt + l31) * 128 + 8 * hh;
#pragma unroll
        for (int ks = 0; ks < 8; ++ks) {
            const bf16x8 af = *(const bf16x8*)(sp + 16 * ks);
            const bf16x8 bfr = *(const bf16x8*)(lds + H_QB + ((32 * ti + l31) * 136 + 16 * ks + 8 * hh) * 2);
            acc = MFMA_BF16(af, bfr, acc);
        }
    }
    for (int si = 0; si <= ti; ++si) {
        f32x16 Sc;
#pragma unroll
        for (int i = 0; i < 16; ++i) Sc[i] = 0.f;
#pragma unroll
        for (int ks = 0; ks < 8; ++ks) {
            const bf16x8 af = *(const bf16x8*)(lds + H_KT + ((32 * si + l31) * 136 + 16 * ks + 8 * hh) * 2);
            const bf16x8 bfr = *(const bf16x8*)(lds + H_QA + ((32 * ti + l31) * 136 + 16 * ks + 8 * hh) * 2);
            Sc = MFMA_BF16(af, bfr, Sc);
        }
        unsigned pw[8];
#pragma unroll
        for (int i = 0; i < 16; i += 2) {
            const bool v0 = (si < ti) || (crow(i, hh) <= l31), v1 = (si < ti) || (crow(i + 1, hh) <= l31);
            pw[i >> 1] = pk2(v0 ? Sc[i] : 0.f, v1 ? Sc[i + 1] : 0.f);
        }
        bf16x8 pf[2];
        pf[0] = __builtin_bit_cast(bf16x8, (u32x4){pw[0], pw[1], pw[2], pw[3]});
        pf[1] = __builtin_bit_cast(bf16x8, (u32x4){pw[4], pw[5], pw[6], pw[7]});
#pragma unroll
        for (int ks = 0; ks < 2; ++ks) {
            const unsigned char* vb = lds + H_VT + ((32 * vt + l31) * 72 + 32 * si + 16 * ks + 4 * hh) * 2;
            const u32x2 lo = *(const u32x2*)vb, hi = *(const u32x2*)(vb + 16);
            const bf16x8 af = __builtin_bit_cast(bf16x8, (u32x4){lo.x, lo.y, hi.x, hi.y});
            acc = MFMA_BF16(af, pf[ks], acc);
        }
    }
    float ss = 0.f;
#pragma unroll
    for (int i = 0; i < 16; ++i) ss += acc[i] * acc[i];
    ss += shx(ss, 32, lane);
    float* RED = (float*)(lds + H_RED);
    if (hh == 0) RED[vt * 64 + 32 * ti + l31] = ss;
    __syncthreads();
    const int t = 32 * ti + l31;
    const float tot = RED[t] + RED[64 + t] + RED[128 + t] + RED[192 + t];
    const float rs = 1.0f / sqrtf(tot * (1.0f / 128.0f) + EPS);
    const bf16_t* gp = proj + (R0 + t) * PW + C_GH + hd * 128 + 32 * vt + 4 * hh;
    bf16_t* yp = Y + (R0 + t) * D_MODEL + 512 + hd * 128 + 32 * vt + 4 * hh;
    const float* gn = hng + 32 * vt + 4 * hh;
#pragma unroll
    for (int g = 0; g < 4; ++g) {
        const u32x2 gv = *(const u32x2*)(gp + 8 * g);
        const f32x4 nn = *(const f32x4*)(gn + 8 * g);
        const float r0 = acc[4 * g] * rs * nn.x * silu_f(bflo(gv.x)), r1 = acc[4 * g + 1] * rs * nn.y * silu_f(bfhi(gv.x));
        const float r2 = acc[4 * g + 2] * rs * nn.z * silu_f(bflo(gv.y)), r3 = acc[4 * g + 3] * rs * nn.w * silu_f(bfhi(gv.y));
        u32x2 w; w.x = pk2(r0, r1); w.y = pk2(r2, r3);
        *(u32x2*)(yp + 8 * g) = w;
    }
    __syncthreads();
}

#define CTX() \
    const __attribute__((address_space(4))) Params* kp_ = (const __attribute__((address_space(4))) Params*)__builtin_amdgcn_kernarg_segment_ptr(); asm volatile("" : "+s"(kp_)); const __attribute__((address_space(4))) Params& p = *kp_; \
    int tid_ = threadIdx.x; asm volatile("" : "+v"(tid_)); const int tid = tid_, lane = tid & 63, wave = __builtin_amdgcn_readfirstlane(tid >> 6); \
    const int G = gridDim.x, bid = blockIdx.x; const int gw = wave * G + bid, NGW = G * 8; unsigned char* ws = p.ws; \
    (void)lane; (void)gw; (void)NGW; (void)ws; (void)tid;
#define WLP(l) ((const bf16_t*)(ws + WS_WEIGHTS + (size_t)(l) * WL_SIZE))
#define MLP(l) ((const float*)(ws + WS_MOD) + (size_t)(l) * 2 * NMOD)

template <class Epi> DI void run_gemm(PG8_LAS unsigned char* glds, const bf16_t* A, const bf16_t* Bt, int N, int K, const Epi E) {
    int G_ = gridDim.x, b_ = blockIdx.x; asm volatile("" : "+s"(G_), "+s"(b_));
    pg8::Gemm g{A, Bt, M_TOK, N, K}; pg8::StaticOrder S; S.init(M_TOK, N, G_, b_);
    GEMMCALL<Epi, pg8::StaticOrder, G_ALIGN, G_SP2>(glds, g, S, E);
}

__global__ void __launch_bounds__(512) fwd_kernel(Params p_unused) {
    extern __shared__ __attribute__((aligned(16))) unsigned char lds[];
    cg::grid_group grid = cg::this_grid();
    PG8_LAS unsigned char* glds = (PG8_LAS unsigned char*)lds;
    { CTX(); if (tid < 2) ((volatile LAS unsigned*)(glds + LDS_MISC))[tid] = 0u;
      if (bid == 0) { unsigned* bw = (unsigned*)(ws + WS_BAR); for (int i = tid; i < XCD_BAR_WORDS; i += 512) bw[i] = 0u; }
      { float* RS = (float*)(ws + WS_RS); for (int i = bid * 512 + tid; i < (DEPTH + 1) * 3 * M_TOK; i += G * 512) RS[i] = 0.f; } }
#ifndef SKIP_PREP
    { CTX(); phase_prep(p, lds, gw, NGW, wave, lane); }
#endif
    grid.sync();
    { CTX(); if (tid == 0) (void)xb_add((unsigned*)(ws + WS_BAR) + XB_XCNT(xb_xcc_id()), 1u); }
#define GRID_BAR() do { CTX(); XcdBarrier xb_; xb_.bar = (unsigned*)(ws + WS_BAR); xb_.x = xb_xcc_id(); xb_.st = (volatile LAS unsigned*)(glds + LDS_MISC); xcd_barrier(xb_); } while (0)
    { CTX(); phase_prep2(p, ws, gw, NGW, lane); }
    GRID_BAR();
#define RSP(l, k) ((float*)(ws + WS_RS) + (size_t)((l) * 3 + (k)) * M_TOK)
#define SHWP(l) ((const float*)(ws + WS_SHW) + (size_t)(l) * 2 * SHW_N)

#pragma unroll 1
    for (int l = 0; l < DEPTH; ++l) {
        { CTX(); run_gemm(glds, (const bf16_t*)(ws + WS_HB), WLP(l) + WL_GU1 / 2, 2 * D_FF, D_MODEL, pg8::EpiSwiGLU{D_FF, l * 3 + 0, l * 2 * SHW_N}); }
        GRID_BAR();
        { CTX(); run_gemm(glds, (const bf16_t*)(ws + WS_ACT), WLP(l) + WL_DN1 / 2, D_MODEL, D_FF, pg8::EpiRes{(l == 0) ? 1 : 0, l * 2 * NMOD + 2 * D_MODEL, l * 2 * NMOD + 4 * D_MODEL, l * 3 + 1, 0.5f}); }
        GRID_BAR();
        { CTX(); run_gemm(glds, (const bf16_t*)(ws + WS_HB), WLP(l) + WL_IN / 2, PW, D_MODEL, pg8::EpiBf16{PW, l * 3 + 1, l * 2 * SHW_N + 2 * D_FF}); }
        GRID_BAR();
#ifndef SKIP_H1
        { CTX(); for (int u = bid; u < 8 * NCHUNK; u += G) hgrn_h1_unit(lds, (const bf16_t*)(ws + WS_ACT), (const float*)(ws + WS_LB) + l * 512, (bf16_t*)(ws + WS_ST), (float*)(ws + WS_DEC), u, tid, wave, lane); }
#endif
#ifndef SKIP_QK
        { CTX(); for (int m = gw; m < M_TOK; m += NGW) qkprep_token((bf16_t*)(ws + WS_ACT), p.qng + l * 64, p.kng + l * 64, m, lane); }
#endif
#ifndef SKIP_SB
        { CTX(); for (int u = gw; u < 8 * (SEQ / 32); u += NGW) { const int bh = u / (SEQ / 32), qt = (SEQ / 32 - 1) - u % (SEQ / 32); sb_unit((const bf16_t*)(ws + WS_ACT), (bf16_t*)(ws + WS_Y), glds + wave * ATT_LDS_PER_WAVE, bh >> 2, bh & 3, qt, lane); } }
#endif
        GRID_BAR();
#ifndef SKIP_SCAN
        { CTX(); hgrn_scan((bf16_t*)(ws + WS_ST), (const float*)(ws + WS_DEC), bid * 512 + tid); }
#endif
#ifndef SKIP_DIL
        { CTX();
            float gq = fabsf(p.qng[l * 64 + lane]), gk = fabsf(p.kng[l * 64 + lane]);
#pragma unroll
            for (int o = 1; o < 64; o <<= 1) { gq = fmaxf(gq, shx(gq, o, lane)); gk = fmaxf(gk, shx(gk, o, lane)); }
            const float m2 = 8.0f * gq * gk * LOG2E;
            for (int u = gw; u < 3 * 8 * 512; u += NGW) {
                const int pat = u / 4096, rem = u % 4096, bh = rem / 512, tile = rem % 512;
                const int tpr = 512 >> (2 * pat);
                dil_unit((const bf16_t*)(ws + WS_ACT), (bf16_t*)(ws + WS_PNUM), (float*)(ws + WS_PDEN), glds + wave * ATT_LDS_PER_WAVE, bh >> 2, bh & 3, pat, tile / tpr, tile % tpr, m2, lane);
            }
        }
#endif
        GRID_BAR();
#ifndef SKIP_H3
        { CTX(); for (int u = bid; u < 8 * NCHUNK; u += G) hgrn_h3_unit(lds, (const bf16_t*)(ws + WS_ACT), (const float*)(ws + WS_LB) + l * 512, (const bf16_t*)(ws + WS_ST), p.hng + l * 128, (bf16_t*)(ws + WS_Y), u, tid, wave, lane); }
#endif
        { CTX(); for (int m = gw; m < M_TOK; m += NGW) dil_merge_row((const bf16_t*)(ws + WS_PNUM), (const float*)(ws + WS_PDEN), (bf16_t*)(ws + WS_Y), m, lane); }
        GRID_BAR();
        { CTX(); run_gemm(glds, (const bf16_t*)(ws + WS_Y), WLP(l) + WL_OUT / 2, D_MODEL, D_MODEL, pg8::EpiRes{0, l * 2 * NMOD + 5 * D_MODEL, l * 2 * NMOD + 7 * D_MODEL, l * 3 + 2, 1.0f}); }
        GRID_BAR();
        { CTX(); run_gemm(glds, (const bf16_t*)(ws + WS_HB), WLP(l) + WL_GU2 / 2, 2 * D_FF, D_MODEL, pg8::EpiSwiGLU{D_FF, l * 3 + 2, l * 2 * SHW_N + 2 * D_FF + PW}); }
        GRID_BAR();
        { CTX(); run_gemm(glds, (const bf16_t*)(ws + WS_ACT), WLP(l) + WL_DN2 / 2, D_MODEL, D_FF, pg8::EpiRes{0, l * 2 * NMOD + 8 * D_MODEL, ((l + 1 < DEPTH) ? l + 1 : l) * 2 * NMOD + 1 * D_MODEL, (l + 1) * 3 + 0, 0.5f}); }
        GRID_BAR();
    }
}

extern "C" void kernel_launch(void* const* d_in, const int* in_sizes, int n_in, void* d_out, int out_size, void* d_ws, size_t ws_size, hipStream_t stream) {
    static int grid = 0;
    if (grid == 0) {
        if (n_in != 16 || ws_size < WS_END) { fprintf(stderr, "kernel_launch: unexpected n_in %d / ws %zu\n", n_in, ws_size); grid = -1; return; }
        int dev = 0, cus = 0, per_cu = 0;
        hipGetDevice(&dev);
        hipDeviceGetAttribute(&cus, hipDeviceAttributeMultiprocessorCount, dev);
        if (hipFuncSetAttribute((const void*)fwd_kernel, hipFuncAttributeMaxDynamicSharedMemorySize, LDS_BYTES) != hipSuccess) { fprintf(stderr, "kernel_launch: hipFuncSetAttribute failed\n"); grid = -1; return; }
        if (hipOccupancyMaxActiveBlocksPerMultiprocessor(&per_cu, (const void*)fwd_kernel, 512, LDS_BYTES) != hipSuccess || per_cu < 1) { fprintf(stderr, "kernel_launch: occupancy query gave %d\n", per_cu); per_cu = 1; }
        (void)hipGetLastError();
        grid = cus * per_cu;
    }
    if (grid < 0) return;
    Params p{};
    p.x = (const float*)d_in[0]; p.c = (const float*)d_in[1]; p.w_mod = (const float*)d_in[2]; p.b_mod = (const float*)d_in[3];
    p.f1g = (const float*)d_in[4]; p.f1u = (const float*)d_in[5]; p.f1d = (const float*)d_in[6]; p.w_in = (const float*)d_in[7]; p.w_out = (const float*)d_in[8];
    p.qng = (const float*)d_in[9]; p.kng = (const float*)d_in[10]; p.hng = (const float*)d_in[11]; p.lbl = (const float*)d_in[12];
    p.f2g = (const float*)d_in[13]; p.f2u = (const float*)d_in[14]; p.f2d = (const float*)d_in[15];
    p.out = (float*)d_out; p.ws = (unsigned char*)d_ws;
    void* args[] = {&p};
    hipError_t e = hipLaunchCooperativeKernel((const void*)fwd_kernel, dim3(grid), dim3(512), args, LDS_BYTES, stream);
    if (e != hipSuccess) fprintf(stderr, "cooperative launch failed: %s (grid %d)\n", hipGetErrorString(e), grid);
}
```

```cpp
#include <hip/hip_runtime.h>
#include <hip/hip_cooperative_groups.h>
#include <cstdio>
#include <cstdint>
namespace cg = cooperative_groups;

typedef unsigned short bf16_t;
typedef short bf16x8 __attribute__((ext_vector_type(8)));
typedef _Float16 f16x8 __attribute__((ext_vector_type(8)));
typedef float f32x2 __attribute__((ext_vector_type(2)));
typedef float f32x4 __attribute__((ext_vector_type(4)));
typedef float f32x16 __attribute__((ext_vector_type(16)));
typedef unsigned u32x2 __attribute__((ext_vector_type(2)));
typedef unsigned u32x4 __attribute__((ext_vector_type(4)));
typedef __bf16 bf16x2_t __attribute__((ext_vector_type(2)));

#define DI __device__ __forceinline__
#define LAS __attribute__((address_space(3)))

constexpr int D_MODEL = 1024, BATCH = 2, SEQ = 16384, DEPTH = 2, D_FF = 2816;
constexpr int M_TOK = BATCH * SEQ;
constexpr int PW = 3584;
constexpr int C_QA = 0, C_KA = 256, C_VA = 512, C_QD = 768, C_KD = 1024, C_VD = 1280, C_QH = 1536, C_FH = 2048, C_IH = 2560, C_GH = 3072;
constexpr int NMOD = 9 * D_MODEL;
constexpr float EPS = 1e-6f;
constexpr float LOG2E = 1.4426950408889634f;
constexpr int NCHUNK = SEQ / 64;

constexpr size_t MiB = 1u << 20;
constexpr size_t W_GU = (size_t)2 * D_FF * D_MODEL * 2;
constexpr size_t W_DN = (size_t)D_MODEL * D_FF * 2;
constexpr size_t W_IN = (size_t)PW * D_MODEL * 2;
constexpr size_t W_OUT = (size_t)D_MODEL * D_MODEL * 2;
constexpr size_t WL_GU1 = 0, WL_DN1 = WL_GU1 + W_GU, WL_IN = WL_DN1 + W_DN, WL_OUT = WL_IN + W_IN, WL_GU2 = WL_OUT + W_OUT, WL_DN2 = WL_GU2 + W_GU, WL_SIZE = WL_DN2 + W_DN;
static_assert(WL_SIZE == 44040192, "weights per layer");
constexpr size_t WS_WEIGHTS = 0;
constexpr size_t WS_SMALL = 84 * MiB;
constexpr size_t WS_MOD = WS_SMALL, WS_LB = WS_SMALL + 256 * 1024, WS_BAR = WS_SMALL + 512 * 1024;
constexpr size_t WS_DEC = 85 * MiB;
constexpr size_t WS_HB = 86 * MiB;
constexpr size_t WS_PNUM = WS_HB;
constexpr size_t WS_PDEN = WS_HB + 48 * MiB;
constexpr size_t WS_ACT = 150 * MiB;
constexpr size_t WS_XB = 374 * MiB;
constexpr size_t WS_ST = 438 * MiB;
constexpr size_t WS_RS = 502 * MiB;
constexpr size_t WS_SHW = 503 * MiB;
constexpr int SHW_N = 2 * D_FF + PW + 2 * D_FF;
constexpr size_t WS_END = 504 * MiB;

DI unsigned pk2(float lo, float hi) { f32x2 v = {lo, hi}; bf16x2_t b = __builtin_convertvector(v, bf16x2_t); return __builtin_bit_cast(unsigned, b); }
DI float bf2f(bf16_t b) { return __uint_as_float((unsigned)b << 16); }
DI float bflo(unsigned u) { return __uint_as_float(u << 16); }
DI float bfhi(unsigned u) { return __uint_as_float(u & 0xffff0000u); }
DI int crow(int reg, int h) { return (reg & 3) + 8 * (reg >> 2) + 4 * h; }
DI int krow(int s, int h, int j) { return 16 * s + 8 * (j >> 2) + 4 * h + (j & 3); }
DI float fexp2(float x) { return __builtin_amdgcn_exp2f(x); }
DI float flog2(float x) { return __builtin_amdgcn_logf(x); }
DI float frcp(float x) { return __builtin_amdgcn_rcpf(x); }
DI float silu_f(float g) { return g * frcp(1.0f + fexp2(-g * LOG2E)); }
#define MFMA_BF16(a, b, c) __builtin_amdgcn_mfma_f32_32x32x16_bf16((a), (b), (c), 0, 0, 0)
#define MFMA_F16(a, b, c) __builtin_amdgcn_mfma_f32_32x32x16_f16((a), (b), (c), 0, 0, 0)
#define LDS_WAIT() asm volatile("s_waitcnt lgkmcnt(0)" ::: "memory")

struct Params {
    const float* x; const float* c; const float* w_mod; const float* b_mod;
    const float* f1g; const float* f1u; const float* f1d; const float* w_in; const float* w_out;
    const float* qng; const float* kng; const float* hng; const float* lbl;
    const float* f2g; const float* f2u; const float* f2d;
    float* out; unsigned char* ws;
};

#ifdef SKIP_GEMM
#define GEMMCALL pg8::gemm_dummy
#else
#define GEMMCALL pg8::gemm_phase
#endif
namespace pg8 {
#define PG8_LAS __attribute__((address_space(3)))
constexpr int BM = 256, BK = 64, HALF = 128, HTB = HALF * BK * 2  , STAGE_BYTES = 8 * HTB, NXCD = 8, WGM = 8;

__host__ __device__ __forceinline__ int lds_byte(int r, int c) { const int st = (r >> 4) * 2 + (c >> 5), rr = r & 15, cc = c & 31, ob = rr * 64 + cc * 2; return st * 1024 + (ob ^ (((ob >> 9) & 1) << 5)); }
__host__ __device__ __forceinline__ void stage_rc(int b, int& R, int& C) { const int st = b / 1024, sb = b % 1024, swz = sb ^ (((sb >> 9) & 1) << 5); R = (st >> 1) * 16 + swz / 64; C = (st & 1) * 32 + (swz % 64) / 2; }
__host__ __device__ __forceinline__ int perm32(int rho) { const int n = rho >> 4, i = rho & 15; return 8 * (i >> 2) + 4 * n + (i & 3); }

struct Unit { int pm, pn; };
struct Gemm { const bf16_t* A; const bf16_t* Bt; int M, N, K; };

struct StaticOrder {
    int nM, nN, nwg, G, c;
    __host__ __device__ void init(int M, int N, int G_, int c_) { nM = M / BM; nN = N / BM; nwg = nM * nN; G = G_; c = c_; }
    __host__ __device__ bool next(int i, Unit& u) const {
        const long L = (long)i * G + c; if (L >= nwg) return false;
        int wgid = (int)L; { const int q = nwg / NXCD, r = nwg % NXCD, xcd = wgid % NXCD, off = wgid / NXCD; wgid = (xcd < r ? xcd * (q + 1) : r * (q + 1) + (xcd - r) * q) + off; }
        const int nig = WGM * nN, gid = wgid / nig, fm = gid * WGM, gsz = (nM - fm) < WGM ? (nM - fm) : WGM;
        u.pm = fm + ((wgid % nig) % gsz); u.pn = (wgid % nig) / gsz; return true;
    }
    __device__ __forceinline__ void a_ready(const Unit&) const {}
    __device__ __forceinline__ void done(const Unit&) const {}
};

#define EPI_PARAMS() const __attribute__((address_space(4))) Params* kq_ = (const __attribute__((address_space(4))) Params*)__builtin_amdgcn_kernarg_segment_ptr(); asm volatile("" : "+s"(kq_)); \
    unsigned char* const ws = kq_->ws
__device__ __forceinline__ float row_rs(const float* rowss, int row) { return 1.0f / sqrtf(rowss[row] * (1.0f / D_MODEL) + EPS); }
struct EpiBf16 {
    static constexpr bool PERM = true, AFTER_DRAIN = false;
    int ldc, rs_idx, shw_off  ;
    __device__ __forceinline__ void operator()(const f32x4 (&acc)[2][2][4][2], const Unit& u, int wr, int wc, int fr, int fq) const {
        EPI_PARAMS();
        bf16_t* O = (bf16_t*)(ws + WS_ACT); const float* rowss = (const float*)(ws + WS_RS) + (size_t)rs_idx * M_TOK; const float* shw = (const float*)(ws + WS_SHW) + shw_off;
        const int row0 = u.pm * BM + wr * 64 + fr; const int col0 = u.pn * BM + wc * 32 + 8 * fq;
        const float* sp = shw + (size_t)((u.pm * BM) / SEQ) * SHW_N + col0;
        f32x4 sv[2][2];
#pragma unroll
        for (int bj = 0; bj < 2; ++bj)
#pragma unroll
            for (int n = 0; n < 2; ++n) sv[bj][n] = *(const f32x4*)(sp + bj * HALF + 4 * n);
        float rsv[2][4];
#pragma unroll
        for (int ai = 0; ai < 2; ++ai)
#pragma unroll
            for (int m = 0; m < 4; ++m) rsv[ai][m] = rowss[row0 + ai * HALF + m * 16];
#pragma unroll
        for (int ai = 0; ai < 2; ++ai)
#pragma unroll
            for (int m = 0; m < 4; ++m) { const int row = row0 + ai * HALF + m * 16; bf16_t* rowp = O + (size_t)row * ldc + col0; const float rs = 1.0f / sqrtf(rsv[ai][m] * (1.0f / D_MODEL) + EPS);
#pragma unroll
                for (int bj = 0; bj < 2; ++bj) { const f32x4 v0 = acc[ai][bj][m][0] * rs + sv[bj][0], v1 = acc[ai][bj][m][1] * rs + sv[bj][1];
                    u32x4 w; w.x = pk2(v0[0], v0[1]); w.y = pk2(v0[2], v0[3]); w.z = pk2(v1[0], v1[1]); w.w = pk2(v1[2], v1[3]);
                    *(u32x4*)(rowp + bj * HALF) = w; } }
    }
};
struct EpiSwiGLU {
    static constexpr bool PERM = true, AFTER_DRAIN = false;
    int ldc, rs_idx, shw_off;
    __device__ __forceinline__ void operator()(const f32x4 (&acc)[2][2][4][2], const Unit& u, int wr, int wc, int fr, int fq) const {
        EPI_PARAMS();
        bf16_t* O = (bf16_t*)(ws + WS_ACT); const float* rowss = (const float*)(ws + WS_RS) + (size_t)rs_idx * M_TOK; const float* shw = (const float*)(ws + WS_SHW) + shw_off;
        const int row0 = u.pm * BM + wr * 64 + fr; const int col0 = u.pn * HALF + wc * 32 + 8 * fq;
        const float* sp = shw + (size_t)((u.pm * BM) / SEQ) * SHW_N + u.pn * BM + wc * 32 + 8 * fq;
        f32x4 sv[2][2];
#pragma unroll
        for (int bj = 0; bj < 2; ++bj)
#pragma unroll
            for (int n = 0; n < 2; ++n) sv[bj][n] = *(const f32x4*)(sp + bj * HALF + 4 * n);
        float rsv[2][4];
#pragma unroll
        for (int ai = 0; ai < 2; ++ai)
#pragma unroll
            for (int m = 0; m < 4; ++m) rsv[ai][m] = rowss[row0 + ai * HALF + m * 16];
#pragma unroll
        for (int ai = 0; ai < 2; ++ai)
#pragma unroll
            for (int m = 0; m < 4; ++m) { const int row = row0 + ai * HALF + m * 16; bf16_t* rowp = O + (size_t)row * ldc + col0; const float rs = 1.0f / sqrtf(rsv[ai][m] * (1.0f / D_MODEL) + EPS);
                const f32x4 g0 = acc[ai][0][m][0] * rs + sv[0][0], g1 = acc[ai][0][m][1] * rs + sv[0][1], u0 = acc[ai][1][m][0] * rs + sv[1][0], u1 = acc[ai][1][m][1] * rs + sv[1][1];
                float r[8];
#pragma unroll
                for (int e = 0; e < 4; ++e) { r[e] = silu_f(g0[e]) * u0[e]; r[4 + e] = silu_f(g1[e]) * u1[e]; }
                u32x4 w; w.x = pk2(r[0], r[1]); w.y = pk2(r[2], r[3]); w.z = pk2(r[4], r[5]); w.w = pk2(r[6], r[7]);
                *(u32x4*)rowp = w; }
    }
};
struct EpiRes {
    static constexpr bool PERM = true, AFTER_DRAIN = false;
    int x_is_input, gate_off  , scn_off, rs_idx; float coef; int is_last;
    __device__ __forceinline__ void operator()(const f32x4 (&acc)[2][2][4][2], const Unit& u, int wr, int wc, int fr, int fq) const {
        EPI_PARAMS();
        float* Out = kq_->out; const float* X = kq_->x; bf16_t* XB = (bf16_t*)(ws + WS_XB);
        bf16_t* HB = (bf16_t*)(ws + WS_HB); float* rowss = (float*)(ws + WS_RS) + (size_t)rs_idx * M_TOK;
        const int row0 = u.pm * BM + wr * 64 + fr; const int col0 = u.pn * BM + wc * 32 + 8 * fq;
        const int b = (u.pm * BM) / SEQ;
        const float* gp = (const float*)(ws + WS_MOD) + gate_off + (size_t)b * NMOD + col0;
        const float* scp = (const float*)(ws + WS_MOD) + scn_off + (size_t)b * NMOD + col0;
        f32x4 gv[2][2], sc[2][2];
#pragma unroll
        for (int bj = 0; bj < 2; ++bj)
#pragma unroll
            for (int n = 0; n < 2; ++n) { gv[bj][n] = *(const f32x4*)(gp + bj * HALF + 4 * n) * coef; sc[bj][n] = *(const f32x4*)(scp + bj * HALF + 4 * n) + 1.0f; }
        const int lane = threadIdx.x & 63;
#pragma unroll
        for (int ai = 0; ai < 2; ++ai) {
            u32x4 xraw[4][2];
            if (!x_is_input) {
#pragma unroll
                for (int m = 0; m < 4; ++m) { const size_t ro = (size_t)(row0 + ai * HALF + m * 16) * D_MODEL + col0;
#pragma unroll
                    for (int bj = 0; bj < 2; ++bj) xraw[m][bj] = *(const u32x4*)(XB + ro + bj * HALF); }
            }
#pragma unroll
            for (int m = 0; m < 4; ++m) { const int row = row0 + ai * HALF + m * 16; const size_t ro = (size_t)row * D_MODEL + col0;
                float ssq = 0.f;
#pragma unroll
                for (int bj = 0; bj < 2; ++bj) {
                    f32x4 xn[2];
                    f32x4 xv[2];
                    if (x_is_input) { xv[0] = *(const f32x4*)(X + ro + bj * HALF); xv[1] = *(const f32x4*)(X + ro + bj * HALF + 4); }
                    else { const u32x4 xw = xraw[m][bj]; xv[0] = (f32x4){bflo(xw.x), bfhi(xw.x), bflo(xw.y), bfhi(xw.y)}; xv[1] = (f32x4){bflo(xw.z), bfhi(xw.z), bflo(xw.w), bfhi(xw.w)}; }
#pragma unroll
                    for (int n = 0; n < 2; ++n) xn[n] = xv[n] + gv[bj][n] * acc[ai][bj][m][n];
                    if (is_last) { *(f32x4*)(Out + ro + bj * HALF) = xn[0]; *(f32x4*)(Out + ro + bj * HALF + 4) = xn[1]; }
                    else { u32x4 xo; xo.x = pk2(xn[0][0], xn[0][1]); xo.y = pk2(xn[0][2], xn[0][3]); xo.z = pk2(xn[1][0], xn[1][1]); xo.w = pk2(xn[1][2], xn[1][3]); *(u32x4*)(XB + ro + bj * HALF) = xo; }
                    ssq += (xn[0][0] * xn[0][0] + xn[0][1] * xn[0][1]) + (xn[0][2] * xn[0][2] + xn[0][3] * xn[0][3]) + (xn[1][0] * xn[1][0] + xn[1][1] * xn[1][1]) + (xn[1][2] * xn[1][2] + xn[1][3] * xn[1][3]);
                    const f32x4 h0 = xn[0] * sc[bj][0], h1 = xn[1] * sc[bj][1];
                    u32x4 w; w.x = pk2(h0[0], h0[1]); w.y = pk2(h0[2], h0[3]); w.z = pk2(h1[0], h1[1]); w.w = pk2(h1[2], h1[3]);
                    *(u32x4*)(HB + ro + bj * HALF) = w;
                }
                ssq += __int_as_float(__builtin_amdgcn_ds_bpermute((lane ^ 16) << 2, __float_as_int(ssq)));
                ssq += __int_as_float(__builtin_amdgcn_ds_bpermute((lane ^ 32) << 2, __float_as_int(ssq)));
                if (fq == 0) atomicAdd(rowss + row, ssq);
            }
        }
    }
};

template <class Epi, class Sched, bool ALIGN_EPI = false, bool SP2 = false>
__device__ __forceinline__ void gemm_phase(PG8_LAS unsigned char* lds, const Gemm g, const Sched& S, const Epi& E) {
    int tid_ = threadIdx.x; asm volatile("" : "+v"(tid_));
    const int tid = tid_, wid = __builtin_amdgcn_readfirstlane(tid >> 6), lane = tid & 63, wr = wid >> 2, wc = wid & 3, fr = lane & 15, fq = lane >> 4;
    const int K = g.K, nt = K / BK;
    unsigned voffA[2], voffB[2];
#pragma unroll
    for (int i = 0; i < 2; ++i) { int R, C; stage_rc(tid * 16 + i * 8192, R, C); const int Rb = Epi::PERM ? ((R & ~31) + perm32(R & 31)) : R;
        voffA[i] = (unsigned)(R * K + C) * 2u; voffB[i] = (unsigned)(Rb * K + C) * 2u; }
    const size_t kstep = (size_t)(BK * 2);
    const size_t hstep = (size_t)HALF * K * 2;
    const size_t tstep = 2 * hstep;
    const unsigned ldsw = (unsigned)wid * 1024u;
    const int aoff = lds_byte(wr * 64 + fr, fq * 8), boff = lds_byte(wc * 32 + fr, fq * 8);
#define PG8_SA(b, h) (((b) * 2 + (h)) * HTB)
#define PG8_SB(b, h) ((4 + (b) * 2 + (h)) * HTB)
#define PG8_STAGE(bufoff, gbase, voff) do { _Pragma("unroll") for (int _i = 0; _i < 2; ++_i) \
        __builtin_amdgcn_global_load_lds((const unsigned*)((const char*)(gbase) + (voff)[_i]), (PG8_LAS unsigned*)(lds + (bufoff) + ldsw + _i * 8192), 16, 0, 0); } while (0)
#define PG8_LDA(dst, b, h) do { _Pragma("unroll") for (int m = 0; m < 4; ++m) _Pragma("unroll") for (int k = 0; k < 2; ++k) dst[m][k] = *(const PG8_LAS bf16x8*)(lds + PG8_SA(b, h) + aoff + m * 2048 + k * 1024); } while (0)
#define PG8_LDB(dst, b, h) do { _Pragma("unroll") for (int n = 0; n < 2; ++n) _Pragma("unroll") for (int k = 0; k < 2; ++k) dst[n][k] = *(const PG8_LAS bf16x8*)(lds + PG8_SB(b, h) + boff + n * 2048 + k * 1024); } while (0)
#define PG8_MMA(ai, bj, At, Bt) do { __builtin_amdgcn_s_setprio(1); _Pragma("unroll") for (int m = 0; m < 4; ++m) _Pragma("unroll") for (int n = 0; n < 2; ++n) _Pragma("unroll") for (int k = 0; k < 2; ++k) \
        acc[ai][bj][m][n] = __builtin_amdgcn_mfma_f32_16x16x32_bf16(Bt[n][k], At[m][k], acc[ai][bj][m][n], 0, 0, 0); __builtin_amdgcn_s_setprio(0); } while (0)
#define PG8_WAIT_V(n) asm volatile("s_waitcnt vmcnt(" #n ")" ::: "memory")
#define PG8_WAIT_L(n) asm volatile("s_waitcnt lgkmcnt(" #n ")" ::: "memory")
#define PG8_BAR __builtin_amdgcn_s_barrier()
#define PG8_SCHED __builtin_amdgcn_sched_barrier(0)
    Unit cur, nxt; int ui = 0;
    if (!S.next(0, cur)) return;
    f32x4 acc[2][2][4][2];
#pragma unroll
    for (int a = 0; a < 2; ++a)
#pragma unroll
        for (int b = 0; b < 2; ++b)
#pragma unroll
            for (int m = 0; m < 4; ++m)
#pragma unroll
                for (int n = 0; n < 2; ++n) acc[a][b][m][n] = (f32x4){0.f, 0.f, 0.f, 0.f};
    bf16x8 At[4][2], B0[2][2], B1[2][2];
    const char* cA = (const char*)g.A + (size_t)cur.pm * tstep; const char* cB = (const char*)g.Bt + (size_t)cur.pn * tstep;
    S.a_ready(cur);
    if constexpr (SP2) {
        PG8_STAGE(PG8_SB(0, 0), cB, voffB); PG8_STAGE(PG8_SB(0, 1), cB + hstep, voffB); PG8_STAGE(PG8_SA(0, 0), cA, voffA); PG8_STAGE(PG8_SA(0, 1), cA + hstep, voffA);
        if (wr == 1) PG8_BAR;
        PG8_WAIT_V(2); PG8_BAR;
        PG8_STAGE(PG8_SB(1, 0), cB + kstep, voffB); PG8_STAGE(PG8_SA(1, 0), cA + kstep, voffA); PG8_STAGE(PG8_SB(1, 1), cB + hstep + kstep, voffB);
        PG8_WAIT_V(6); PG8_BAR;
    } else {
        PG8_STAGE(PG8_SB(0, 0), cB, voffB); PG8_STAGE(PG8_SA(0, 0), cA, voffA); PG8_STAGE(PG8_SB(0, 1), cB + hstep, voffB); PG8_STAGE(PG8_SA(0, 1), cA + hstep, voffA);
        if (wr == 1) PG8_BAR;
        PG8_WAIT_V(4); PG8_BAR;
        PG8_STAGE(PG8_SB(1, 0), cB + kstep, voffB); PG8_STAGE(PG8_SA(1, 0), cA + kstep, voffA); PG8_STAGE(PG8_SB(1, 1), cB + hstep + kstep, voffB);
        PG8_WAIT_V(6); PG8_BAR;
    }
    for (;;) {
        const bool has_next = S.next(ui + 1, nxt);
        const char* nA = has_next ? (const char*)g.A + (size_t)nxt.pm * tstep : cA; const char* nB = has_next ? (const char*)g.Bt + (size_t)nxt.pn * tstep : cB;
        for (int t = 0; t < nt; t += 2) {
            const bool last = (t == nt - 2);
            const char* a1 = cA + (size_t)(t + 1) * kstep;
            const char* a2 = last ? nA : cA + (size_t)(t + 2) * kstep; const char* b2 = last ? nB : cB + (size_t)(t + 2) * kstep;
            const char* a3 = a2 + kstep; const char* b3 = b2 + kstep;
            if (last && has_next) S.a_ready(nxt);
            if constexpr (SP2) {
            PG8_LDB(B0, 0, 0); PG8_LDB(B1, 0, 1); PG8_SCHED; PG8_LDA(At, 0, 0); PG8_STAGE(PG8_SA(1, 1), a1 + hstep, voffA);
            PG8_WAIT_V(8); PG8_WAIT_L(0); PG8_BAR; PG8_MMA(0, 0, At, B0); PG8_MMA(0, 1, At, B1); PG8_BAR; PG8_SCHED;
            PG8_LDA(At, 0, 1); PG8_STAGE(PG8_SB(0, 0), b2, voffB); PG8_STAGE(PG8_SB(0, 1), b2 + hstep, voffB); PG8_STAGE(PG8_SA(0, 0), a2, voffA);
            PG8_WAIT_V(8); PG8_WAIT_L(0); PG8_BAR; PG8_MMA(1, 0, At, B0); PG8_MMA(1, 1, At, B1); PG8_BAR; PG8_SCHED;
            PG8_LDB(B0, 1, 0); PG8_LDB(B1, 1, 1); PG8_SCHED; PG8_LDA(At, 1, 0); PG8_STAGE(PG8_SA(0, 1), a2 + hstep, voffA);
            PG8_WAIT_V(8); PG8_WAIT_L(0); PG8_BAR; PG8_MMA(0, 0, At, B0); PG8_MMA(0, 1, At, B1); PG8_BAR; PG8_SCHED;
            PG8_LDA(At, 1, 1); PG8_STAGE(PG8_SB(1, 0), b3, voffB); PG8_STAGE(PG8_SB(1, 1), b3 + hstep, voffB); PG8_STAGE(PG8_SA(1, 0), a3, voffA);
            PG8_WAIT_V(8); PG8_WAIT_L(0); PG8_BAR; PG8_MMA(1, 0, At, B0); PG8_MMA(1, 1, At, B1); PG8_BAR; PG8_SCHED;
            } else {
            PG8_LDB(B0, 0, 0); PG8_SCHED; PG8_LDA(At, 0, 0); PG8_STAGE(PG8_SA(1, 1), a1 + hstep, voffA);
            PG8_WAIT_L(8); PG8_BAR; PG8_WAIT_L(0); PG8_MMA(0, 0, At, B0); PG8_BAR; PG8_SCHED;
            PG8_LDB(B1, 0, 1); PG8_STAGE(PG8_SB(0, 0), b2, voffB);
            PG8_BAR; PG8_WAIT_L(0); PG8_MMA(0, 1, At, B1); PG8_BAR;
            PG8_LDA(At, 0, 1); PG8_STAGE(PG8_SA(0, 0), a2, voffA);
            PG8_BAR; PG8_WAIT_L(0); PG8_MMA(1, 0, At, B0); PG8_BAR; PG8_SCHED;
            PG8_STAGE(PG8_SB(0, 1), b2 + hstep, voffB);
            PG8_WAIT_V(6); PG8_BAR; PG8_MMA(1, 1, At, B1); PG8_BAR;
            PG8_LDB(B0, 1, 0); PG8_SCHED; PG8_LDA(At, 1, 0); PG8_STAGE(PG8_SA(0, 1), a2 + hstep, voffA);
            PG8_WAIT_L(8); PG8_BAR; PG8_WAIT_L(0); PG8_MMA(0, 0, At, B0); PG8_BAR; PG8_SCHED;
            PG8_LDB(B1, 1, 1); PG8_STAGE(PG8_SB(1, 0), b3, voffB);
            PG8_BAR; PG8_WAIT_L(0); PG8_MMA(0, 1, At, B1); PG8_BAR;
            PG8_LDA(At, 1, 1); PG8_STAGE(PG8_SA(1, 0), a3, voffA);
            PG8_BAR; PG8_WAIT_L(0); PG8_MMA(1, 0, At, B0); PG8_BAR; PG8_SCHED;
            PG8_STAGE(PG8_SB(1, 1), b3 + hstep, voffB);
            PG8_WAIT_V(6); PG8_BAR; PG8_MMA(1, 1, At, B1); PG8_BAR;
            }
        }
        if constexpr (ALIGN_EPI) { if (wr == 0) PG8_BAR; }
        if constexpr (!Epi::AFTER_DRAIN) { E(acc, cur, wr, wc, fr, fq); S.done(cur); }
        if (!has_next) break;
#pragma unroll
        for (int a = 0; a < 2; ++a)
#pragma unroll
            for (int b = 0; b < 2; ++b)
#pragma unroll
                for (int m = 0; m < 4; ++m)
#pragma unroll
                    for (int n = 0; n < 2; ++n) acc[a][b][m][n] = (f32x4){0.f, 0.f, 0.f, 0.f};
        cur = nxt; cA = nA; cB = nB; ++ui;
        if constexpr (ALIGN_EPI) { if (wr == 1) PG8_BAR; }
    }
    PG8_WAIT_V(0);
    if constexpr (!ALIGN_EPI) { if (wr == 0) PG8_BAR; }
    PG8_BAR;
#undef PG8_SA
#undef PG8_SB
#undef PG8_STAGE
#undef PG8_LDA
#undef PG8_LDB
#undef PG8_MMA
#undef PG8_WAIT_V
#undef PG8_WAIT_L
#undef PG8_BAR
#undef PG8_SCHED
}
template <class Epi, class Sched, bool A=false, bool B=false> __device__ __forceinline__ void gemm_dummy(PG8_LAS unsigned char* lds, const Gemm g, const Sched& S, const Epi& E) {}
}

constexpr bool G_ALIGN = true, G_SP2 = true;
constexpr int LDS_BYTES = 147456, LDS_MISC = 131072 + 64;


template <class T> DI T* lau(T* p) { asm volatile("" : "+s"(p)); return p; }
DI float shx(float v, int o, int lane) { return __int_as_float(__builtin_amdgcn_ds_bpermute((lane ^ o) << 2, __float_as_int(v))); }
DI float wave_sum(float v, int lane) {
#pragma unroll
    for (int o = 1; o < 64; o <<= 1) v += shx(v, o, lane);
    return v;
}


#define XB_TMO      128
#define XB_XCNT(j)  (256  + 64 * (j))
#define XB_XSUB(j)  (1280 + 64 * (j))
#define XB_XGEN(j)  (2304 + 64 * (j))
#define XB_TOP      3328
#define XB_TOPGEN   3392
#define XCD_BAR_WORDS 3456
#define XB_SPIN_CAP (1u << 21)
DI unsigned xb_ld(unsigned* p)              { return __hip_atomic_load(p, __ATOMIC_RELAXED, __HIP_MEMORY_SCOPE_AGENT); }
DI unsigned xb_add(unsigned* p, unsigned v) { return __hip_atomic_fetch_add(p, v, __ATOMIC_RELAXED, __HIP_MEMORY_SCOPE_AGENT); }
DI unsigned xb_xcc_id() { return (unsigned)__builtin_amdgcn_s_getreg((3 << 11) | 20) & 0xFu; }
#define XB_SPIN(cond, bar) do { unsigned _sp = 0; while (cond) { __builtin_amdgcn_s_sleep(1); \
    if ((++_sp & 255u) == 0u) { if (xb_ld(&(bar)[XB_TMO])) break; if (_sp > XB_SPIN_CAP) { atomicAdd(&(bar)[XB_TMO], 1u); break; } } } } while (0)
struct XcdBarrier { unsigned* bar; unsigned x; volatile LAS unsigned* st; };
DI void xcd_barrier_complete(unsigned* bar, unsigned x, unsigned& nloc, unsigned& nx) {
    const unsigned G = gridDim.x * gridDim.y * gridDim.z;
    unsigned sum, cnt, mine, sp = 0u;
    for (;;) {
        sum = 0u; cnt = 0u; mine = 0u;
#pragma unroll
        for (unsigned j = 0; j < 16; ++j) { const unsigned c = xb_ld(&bar[XB_XCNT(j)]); sum += c; cnt += (c > 0u) ? 1u : 0u; mine = (j == x) ? c : mine; }
        if (sum == G) break;
        __builtin_amdgcn_s_sleep(1);
        if ((++sp & 255u) == 0u) { if (xb_ld(&bar[XB_TMO])) break; if (sp > XB_SPIN_CAP) { atomicAdd(&bar[XB_TMO], 1u); break; } }
    }
    nloc = mine > 0u ? mine : 1u; nx = cnt > 0u ? cnt : 1u;
}
DI void xcd_barrier(const XcdBarrier& b) {
    asm volatile("s_waitcnt vmcnt(0)" ::: "memory");
    __syncthreads();
    if (threadIdx.x == 0) {
        unsigned* bar = b.bar;
        __builtin_amdgcn_s_waitcnt(0);
        unsigned nloc = b.st[0], nx = b.st[1];
        if (nloc == 0u) { xcd_barrier_complete(bar, b.x, nloc, nx); b.st[0] = nloc; b.st[1] = nx; }
        const unsigned old = xb_add(&bar[XB_XSUB(b.x)], 1u);
        const unsigned gen = old / nloc;
        if (old + 1u == (gen + 1u) * nloc) {
            __builtin_amdgcn_fence(__ATOMIC_RELEASE, "agent");
            asm volatile("s_waitcnt vmcnt(0)" ::: "memory");
            const unsigned og = xb_add(&bar[XB_TOP], 1u);
            const unsigned tg = og / nx;
            if (og + 1u == (tg + 1u) * nx) xb_add(&bar[XB_TOPGEN], 1u);
            else XB_SPIN(xb_ld(&bar[XB_TOPGEN]) == tg, bar);
            __builtin_amdgcn_fence(__ATOMIC_ACQUIRE, "agent");
            xb_add(&bar[XB_XGEN(b.x)], 1u);
            asm volatile("s_waitcnt vmcnt(0)" ::: "memory");
        } else {
            XB_SPIN(xb_ld(&bar[XB_XGEN(b.x)]) == gen, bar);
            __builtin_amdgcn_fence(__ATOMIC_ACQUIRE, "agent");
            asm volatile("s_waitcnt vmcnt(0)" ::: "memory");
        }
    }
    __syncthreads();
}

DI void transpose_item(const float* W, int K, int N, bf16_t* WT, int mode, float* scr, int item, int lane) {
    const int nblk = N / 32, kb = item / nblk, nb = item % nblk, k0 = 64 * kb, n0 = 32 * nb;
    const int drow0 = (mode == 0) ? n0 : ((n0 >> 7) * 256 + (n0 & 127) + (mode == 2 ? 128 : 0));
    { const int kr = lane >> 3, c4 = lane & 7; f32x4 v[8];
#pragma unroll
      for (int i = 0; i < 8; ++i) v[i] = *(const f32x4*)(W + (size_t)(k0 + 8 * i + kr) * N + n0 + 4 * c4);
#pragma unroll
      for (int i = 0; i < 8; ++i) { float* d = scr + (8 * i + kr) * 33 + 4 * c4; d[0] = v[i].x; d[1] = v[i].y; d[2] = v[i].z; d[3] = v[i].w; } }
    LDS_WAIT(); asm volatile("" ::: "memory");
    const int cch = lane & 7;
#pragma unroll
    for (int j = 0; j < 4; ++j) { const int n = (lane >> 3) + 8 * j; const float* s = scr + (8 * cch) * 33 + n;
        u32x4 o; o.x = pk2(s[0 * 33], s[1 * 33]); o.y = pk2(s[2 * 33], s[3 * 33]); o.z = pk2(s[4 * 33], s[5 * 33]); o.w = pk2(s[6 * 33], s[7 * 33]);
        *(u32x4*)(WT + (size_t)(drow0 + n) * K + k0 + 8 * cch) = o; }
    LDS_WAIT(); asm volatile("" ::: "memory");
}

template <class PT> DI void phase_prep(const PT& p, unsigned char* lds, int gw, int NGW, int wave, int lane) {
    float* scr = (float*)(lds + wave * 16384);
    constexpr int I_G = (D_MODEL / 64) * (D_FF / 32);
    constexpr int I_D = (D_FF / 64) * (D_MODEL / 32);
    constexpr int I_IN = (D_MODEL / 64) * (PW / 32);
    constexpr int I_OUT = (D_MODEL / 64) * (D_MODEL / 32);
    constexpr int I_LAYER = 4 * I_G + 2 * I_D + I_IN + I_OUT;
    constexpr int I_MOD = 0;
    constexpr int NITEMS = I_MOD + 1 + DEPTH * I_LAYER;
    {
        float* sc = (float*)lds; float* red = (float*)(lds + 8192);
        const int tid = wave * 64 + lane;
        for (int k = tid; k < 2 * D_MODEL; k += 512) sc[k] = silu_f(p.c[k]);
        __syncthreads();
        const int G = NGW / 8, bid = gw % G;
        for (int u = bid; u < DEPTH * (NMOD / 32); u += G) {
            const int l = u / (NMOD / 32), n = (u % (NMOD / 32)) * 32 + (lane & 31), kp = wave * 2 + (lane >> 5);
            const float* W = p.w_mod + (size_t)l * D_MODEL * NMOD + (size_t)(kp * 64) * NMOD + n;
            float a0 = 0.f, a1 = 0.f;
#pragma unroll 16
            for (int k = 0; k < 64; ++k) { const float w = W[(size_t)k * NMOD]; a0 += sc[kp * 64 + k] * w; a1 += sc[D_MODEL + kp * 64 + k] * w; }
            red[(kp * 2 + 0) * 32 + (lane & 31)] = a0; red[(kp * 2 + 1) * 32 + (lane & 31)] = a1;
            __syncthreads();
            if (tid < 64) { const int col = tid & 31, b = tid >> 5; float sum = 0.f;
#pragma unroll
                for (int j = 0; j < 16; ++j) sum += red[(j * 2 + b) * 32 + col];
                const int nn = (u % (NMOD / 32)) * 32 + col;
                ((float*)(p.ws + WS_MOD))[(l * 2 + b) * NMOD + nn] = sum + p.b_mod[l * NMOD + nn]; }
            __syncthreads();
        }
    }
    for (int it = gw; it < NITEMS; it += NGW) {
        if (it == I_MOD) {
            float* lb = (float*)(p.ws + WS_LB);
            for (int i = lane; i < 512; i += 64) { const float l0 = p.lbl[i], l1 = p.lbl[512 + i]; const float mx = fmaxf(l0, l1);
                const float e0 = __expf(l0 - mx), e1 = __expf(l1 - mx); const float s0 = e0 / (e0 + e1), s1 = e1 / (e0 + e1);
                lb[i] = fminf(fmaxf(s0 - s0, 0.f), 1.0f - EPS); lb[512 + i] = fminf(fmaxf((s0 + s1) - s0, 0.f), 1.0f - EPS); }
            continue;
        }
        int r = it - I_MOD - 1; const int l = r / I_LAYER; r -= l * I_LAYER;
        bf16_t* wl = (bf16_t*)(p.ws + WS_WEIGHTS + (size_t)l * WL_SIZE);
        const size_t o_gu = (size_t)l * D_MODEL * D_FF, o_in = (size_t)l * D_MODEL * PW, o_out = (size_t)l * D_MODEL * D_MODEL;
        if (r < I_G) { transpose_item(p.f1g + o_gu, D_MODEL, D_FF, wl + WL_GU1 / 2, 1, scr, r, lane); continue; } r -= I_G;
        if (r < I_G) { transpose_item(p.f1u + o_gu, D_MODEL, D_FF, wl + WL_GU1 / 2, 2, scr, r, lane); continue; } r -= I_G;
        if (r < I_D) { transpose_item(p.f1d + o_gu, D_FF, D_MODEL, wl + WL_DN1 / 2, 0, scr, r, lane); continue; } r -= I_D;
        if (r < I_IN) { transpose_item(p.w_in + o_in, D_MODEL, PW, wl + WL_IN / 2, 0, scr, r, lane); continue; } r -= I_IN;
        if (r < I_OUT) { transpose_item(p.w_out + o_out, D_MODEL, D_MODEL, wl + WL_OUT / 2, 0, scr, r, lane); continue; } r -= I_OUT;
        if (r < I_G) { transpose_item(p.f2g + o_gu, D_MODEL, D_FF, wl + WL_GU2 / 2, 1, scr, r, lane); continue; } r -= I_G;
        if (r < I_G) { transpose_item(p.f2u + o_gu, D_MODEL, D_FF, wl + WL_GU2 / 2, 2, scr, r, lane); continue; } r -= I_G;
        transpose_item(p.f2d + o_gu, D_FF, D_MODEL, wl + WL_DN2 / 2, 0, scr, r, lane);
    }
}


template <class PT> DI void phase_prep2(const PT& p, unsigned char* ws, int gw, int NGW, int lane) {
    const float* mod = (const float*)(ws + WS_MOD);
    float* SHW = (float*)(ws + WS_SHW);
    for (int it0 = gw; it0 < DEPTH * SHW_N; it0 += 4 * NGW) {
        u32x4 w[4][2]; const float* shp[4]; int idx[4]; bool ok[4];
#pragma unroll
        for (int k = 0; k < 4; ++k) {
            const int it = it0 + k * NGW; ok[k] = it < DEPTH * SHW_N; const int itc = ok[k] ? it : it0;
            const int l = itc / SHW_N, j = itc % SHW_N;
            const bf16_t* wl = (const bf16_t*)(ws + WS_WEIGHTS + (size_t)l * WL_SIZE); const bf16_t* row; int shsel;
            if (j < 2 * D_FF) { row = wl + WL_GU1 / 2 + (size_t)j * D_MODEL; shsel = 0; }
            else if (j < 2 * D_FF + PW) { row = wl + WL_IN / 2 + (size_t)(j - 2 * D_FF) * D_MODEL; shsel = 3; }
            else { row = wl + WL_GU2 / 2 + (size_t)(j - 2 * D_FF - PW) * D_MODEL; shsel = 6; }
            shp[k] = mod + (size_t)(l * 2) * NMOD + shsel * D_MODEL; idx[k] = l * 2 * SHW_N + j;
            w[k][0] = *(const u32x4*)(row + 8 * lane); w[k][1] = *(const u32x4*)(row + 512 + 8 * lane);
        }
        float r0[4], r1[4];
#pragma unroll
        for (int k = 0; k < 4; ++k) {
            float a0 = 0.f, a1 = 0.f;
#pragma unroll
            for (int h = 0; h < 2; ++h) { const int k0 = h * 512 + 8 * lane; const u32x4 ww = w[k][h];
                const float wv[8] = {bflo(ww.x), bfhi(ww.x), bflo(ww.y), bfhi(ww.y), bflo(ww.z), bfhi(ww.z), bflo(ww.w), bfhi(ww.w)};
                const float* sh0 = shp[k]; const float* sh1 = sh0 + NMOD;
                const f32x4 s00 = *(const f32x4*)(sh0 + k0), s01 = *(const f32x4*)(sh0 + k0 + 4), s10 = *(const f32x4*)(sh1 + k0), s11 = *(const f32x4*)(sh1 + k0 + 4);
#pragma unroll
                for (int e = 0; e < 4; ++e) { a0 += wv[e] * s00[e] + wv[4 + e] * s01[e]; a1 += wv[e] * s10[e] + wv[4 + e] * s11[e]; } }
            r0[k] = wave_sum(a0, lane); r1[k] = wave_sum(a1, lane);
        }
#pragma unroll
        for (int k = 0; k < 4; ++k) if (ok[k] && lane == 0) { SHW[idx[k]] = r0[k]; SHW[idx[k] + SHW_N] = r1[k]; }
    }
    bf16_t* HB = (bf16_t*)(ws + WS_HB); float* RS = (float*)(ws + WS_RS);
    for (int m0 = gw; m0 < M_TOK; m0 += 4 * NGW) {
        f32x4 v[4][4]; bool ok[4];
#pragma unroll
        for (int k = 0; k < 4; ++k) { const int m = m0 + k * NGW; ok[k] = m < M_TOK; const int mc = ok[k] ? m : m0;
            const f32x4* xr = (const f32x4*)(p.x + (size_t)mc * D_MODEL) + lane;
#pragma unroll
            for (int j = 0; j < 4; ++j) v[k][j] = xr[64 * j]; }
#pragma unroll
        for (int k = 0; k < 4; ++k) {
            const int m = m0 + k * NGW;
            if (ok[k]) {
                const int b = m / SEQ; const float* sc = mod + (size_t)b * NMOD + 1 * D_MODEL;
                float ss = 0.f;
#pragma unroll
                for (int j = 0; j < 4; ++j) ss += (v[k][j].x * v[k][j].x + v[k][j].y * v[k][j].y) + (v[k][j].z * v[k][j].z + v[k][j].w * v[k][j].w);
                ss = wave_sum(ss, lane);
                if (lane == 0) RS[m] = ss;
                u32x2* o8 = (u32x2*)(HB + (size_t)m * D_MODEL) + lane;
#pragma unroll
                for (int j = 0; j < 4; ++j) { const f32x4 h = v[k][j] * (*((const f32x4*)sc + lane + 64 * j) + 1.0f);
                    u32x2 wq; wq.x = pk2(h.x, h.y); wq.y = pk2(h.z, h.w); o8[64 * j] = wq; }
            }
        }
    }
}

DI void phase_norm(const float* X, const float* sh, const float* sc, bf16_t* HB, int gw, int NGW, int lane) {
    for (int m = gw; m < M_TOK; m += NGW) {
        const int b = m / SEQ;
        const f32x4* xr = (const f32x4*)(X + (size_t)m * D_MODEL) + lane;
        f32x4 v[4]; float s = 0.f;
#pragma unroll
        for (int j = 0; j < 4; ++j) { v[j] = xr[64 * j]; s += (v[j].x * v[j].x + v[j].y * v[j].y) + (v[j].z * v[j].z + v[j].w * v[j].w); }
        const float r = 1.0f / sqrtf(wave_sum(s, lane) * (1.0f / D_MODEL) + EPS);
        u32x2* o8 = (u32x2*)(HB + (size_t)m * D_MODEL) + lane;
#pragma unroll
        for (int j = 0; j < 4; ++j) {
            const f32x4 scv = *((const f32x4*)(sc + (size_t)b * NMOD) + lane + 64 * j), shv = *((const f32x4*)(sh + (size_t)b * NMOD) + lane + 64 * j);
            const f32x4 h = v[j] * r * (scv + 1.0f) + shv;
            u32x2 w; w.x = pk2(h.x, h.y); w.y = pk2(h.z, h.w); o8[64 * j] = w; }
    }
}

typedef short v4i16_t __attribute__((ext_vector_type(4)));
constexpr int VT_PITCH = 144;
constexpr int VT_TILE = 32 * VT_PITCH;
constexpr int ATT_LDS_PER_WAVE = 2 * VT_TILE;
DI bf16x8 v_frag(LAS unsigned char* vt, int dt, int ks2, int lane) {
    const int hh = lane >> 5, blk = (lane >> 4) & 1, q = (lane & 15) >> 2, p = lane & 3;
    LAS unsigned char* a = vt + (16 * ks2 + 4 * hh + q) * VT_PITCH + (32 * dt + 16 * blk + 4 * p) * 2;
    const v4i16_t lo = __builtin_amdgcn_ds_read_tr16_b64_v4i16((LAS v4i16_t*)a);
    const v4i16_t hi = __builtin_amdgcn_ds_read_tr16_b64_v4i16((LAS v4i16_t*)(a + 8 * VT_PITCH));
    bf16x8 r; r[0] = lo[0]; r[1] = lo[1]; r[2] = lo[2]; r[3] = lo[3]; r[4] = hi[0]; r[5] = hi[1]; r[6] = hi[2]; r[7] = hi[3];
    return r;
}
DI bf16x8 k_frag(LAS unsigned char* kt, int ks, int lane) { return *(LAS bf16x8*)(kt + (lane & 31) * VT_PITCH + (16 * ks + 8 * (lane >> 5)) * 2); }
template <int OFF> DI void gload16(u32x4& dst, const void* p) { dst = *(const u32x4*)((const char*)p + OFF); }
template <int CK, int CV> DI void kv_issue(u32x4 (&k)[4], u32x4 (&v)[4], const bf16_t* p, size_t rstep) {
    gload16<CK * 2>(k[0], p); gload16<CV * 2>(v[0], p); gload16<CK * 2>(k[1], p + rstep); gload16<CV * 2>(v[1], p + rstep);
    gload16<CK * 2>(k[2], p + 2 * rstep); gload16<CV * 2>(v[2], p + 2 * rstep); gload16<CK * 2>(k[3], p + 3 * rstep); gload16<CV * 2>(v[3], p + 3 * rstep);
    asm volatile("" ::: "memory");
}
DI void kv_stage(LAS unsigned char* kl, LAS unsigned char* vl, const u32x4 (&k)[4], const u32x4 (&v)[4], int lane) {
    const int o = (lane >> 3) * VT_PITCH + (lane & 7) * 16;
#pragma unroll
    for (int i = 0; i < 4; ++i) { *(LAS u32x4*)(kl + o + 8 * i * VT_PITCH) = k[i]; *(LAS u32x4*)(vl + o + 8 * i * VT_PITCH) = v[i]; }
}
#define KV_WAIT(N, k, v) do { } while (0)

constexpr float SB_EXIT = -64.0f;
struct SbState { f32x16 o0, o1; float carry; };
DI bool sb_tile(SbState& st, const bf16x8 (&qf)[4], const f16x8 (&tf)[2], LAS unsigned char* kl, LAS unsigned char* vt, bool diag, int lane) {
    const int q = lane & 31, hh = lane >> 5;
    const float SC = 0.125f * LOG2E;
    bf16x8 kf[4], vf[2][2];
#pragma unroll
    for (int ks = 0; ks < 4; ++ks) kf[ks] = k_frag(kl, ks, lane);
#pragma unroll
    for (int ks = 0; ks < 2; ++ks) { vf[0][ks] = v_frag(vt, 0, ks, lane); vf[1][ks] = v_frag(vt, 1, ks, lane); }
    asm volatile("" ::: "memory");
    f32x16 S;
#pragma unroll
    for (int i = 0; i < 16; ++i) S[i] = 0.f;
#pragma unroll
    for (int ks = 0; ks < 4; ++ks) S = MFMA_BF16(kf[ks], qf[ks], S);
    float lnb[16], lw[16]; float tot = 0.f;
#pragma unroll
    for (int i = 0; i < 16; ++i) {
        const float z2 = fminf(S[i] * SC, 100.f);
        const float sp = flog2(1.0f + fexp2(z2));
        const bool valid = !diag || (crow(i, hh) < q);
        lnb[i] = valid ? -sp : 0.f; lw[i] = z2 - sp; tot += lnb[i];
    }
    tot += shx(tot, 32, lane);
    f16x8 lf[2];
#pragma unroll
    for (int ks = 0; ks < 2; ++ks)
#pragma unroll
        for (int j = 0; j < 8; ++j) lf[ks][j] = (_Float16)lnb[8 * ks + j];
    f32x16 T;
#pragma unroll
    for (int i = 0; i < 16; ++i) T[i] = 0.f;
#pragma unroll
    for (int ks = 0; ks < 2; ++ks) T = MFMA_F16(tf[ks], lf[ks], T);
    unsigned pw[8];
#pragma unroll
    for (int i = 0; i < 16; i += 2) {
        const bool v0 = !diag || (crow(i, hh) < q), v1 = !diag || (crow(i + 1, hh) < q);
        const float w0 = v0 ? fexp2(lw[i] + T[i] + st.carry) : 0.f, w1 = v1 ? fexp2(lw[i + 1] + T[i + 1] + st.carry) : 0.f;
        pw[i >> 1] = pk2(w0, w1);
    }
    bf16x8 pf[2];
    pf[0] = __builtin_bit_cast(bf16x8, (u32x4){pw[0], pw[1], pw[2], pw[3]});
    pf[1] = __builtin_bit_cast(bf16x8, (u32x4){pw[4], pw[5], pw[6], pw[7]});
#pragma unroll
    for (int ks = 0; ks < 2; ++ks) { st.o0 = MFMA_BF16(vf[0][ks], pf[ks], st.o0); st.o1 = MFMA_BF16(vf[1][ks], pf[ks], st.o1); }
    st.carry += tot;
    return __all(st.carry < SB_EXIT) != 0;
}
DI void sb_unit(const bf16_t* proj, bf16_t* Y, LAS unsigned char* wl, int b, int hd, int qt, int lane) {
    const int q = lane & 31, hh = lane >> 5;
    const size_t rowbase = (size_t)b * SEQ;
    LAS unsigned char* kl = wl; LAS unsigned char* vl = wl + VT_TILE;
    const bf16_t* qp = proj + (rowbase + qt * 32 + q) * PW + C_QA + hd * 64 + 8 * hh;
    bf16x8 qf[4];
#pragma unroll
    for (int ks = 0; ks < 4; ++ks) qf[ks] = *(const bf16x8*)(qp + 16 * ks);
    f16x8 tf[2];
#pragma unroll
    for (int ks = 0; ks < 2; ++ks)
#pragma unroll
        for (int j = 0; j < 8; ++j) tf[ks][j] = (krow(ks, hh, j) > q) ? (_Float16)1.0f : (_Float16)0.0f;
    SbState st;
#pragma unroll
    for (int i = 0; i < 16; ++i) { st.o0[i] = 0.f; st.o1[i] = 0.f; }
    st.carry = 0.f;
    const bf16_t* lbase = proj + (rowbase + (lane >> 3)) * PW + hd * 64 + (lane & 7) * 8;
    const size_t tstride = (size_t)32 * PW, rstep = (size_t)8 * PW;
    u32x4 KX[4], VX[4], KY[4], VY[4];
    kv_issue<C_KA, C_VA>(KX, VX, lbase + (size_t)qt * tstride, rstep);
    kv_issue<C_KA, C_VA>(KY, VY, lbase + (size_t)(qt > 0 ? qt - 1 : 0) * tstride, rstep);
    KV_WAIT(8, KX, VX);
    kv_stage(kl, vl, KX, VX, lane);
    int kt = qt;
#define SB_STEP(N1, N2) { \
        kv_issue<C_KA, C_VA>(K##N2, V##N2, lbase + (size_t)(kt > 1 ? kt - 2 : 0) * tstride, rstep); \
        int ln_ = lane; asm volatile("" : "+v"(ln_)); \
        const bool done_ = sb_tile(st, qf, tf, kl, vl, kt == qt, ln_); \
        KV_WAIT(8, K##N1, V##N1); \
        if (done_ || kt == 0) { KV_WAIT(0, K##N2, V##N2); break; } \
        kv_stage(kl, vl, K##N1, V##N1, ln_); --kt; }
    for (;;) {
        SB_STEP(Y, X)
        SB_STEP(X, Y)
    }
#undef SB_STEP
    bf16_t* yp = Y + (rowbase + qt * 32 + q) * D_MODEL + hd * 64 + 4 * hh;
#pragma unroll
    for (int g = 0; g < 4; ++g) {
        u32x2 w0; w0.x = pk2(st.o0[4 * g], st.o0[4 * g + 1]); w0.y = pk2(st.o0[4 * g + 2], st.o0[4 * g + 3]);
        u32x2 w1; w1.x = pk2(st.o1[4 * g], st.o1[4 * g + 1]); w1.y = pk2(st.o1[4 * g + 2], st.o1[4 * g + 3]);
        *(u32x2*)(yp + 8 * g) = w0; *(u32x2*)(yp + 32 + 8 * g) = w1;
    }
}

template <int NT> DI void qkprep_tokens(bf16_t* proj, const float* qg, const float* kg, const int (&m)[NT], int lane) {
    const int which = lane >> 5, hd = (lane >> 3) & 3, jj = lane & 7;
    const float* g = which ? kg : qg;
    const f32x4 g1 = *(const f32x4*)(g + 4 * jj), g2 = *(const f32x4*)(g + 32 + 4 * jj);
    const float osc = which ? 1.0f : 0.125f * LOG2E;
    float inv_freq[4];
#pragma unroll
    for (int e = 0; e < 4; ++e) inv_freq[e] = exp2f(-(float)(4 * jj + e) * (13.287712379549449f / 32.0f));
    u32x2 a[NT], c[NT]; bf16_t* row[NT];
#pragma unroll
    for (int k = 0; k < NT; ++k) { row[k] = proj + (size_t)m[k] * PW + (which ? C_KD : C_QD) + hd * 64 + 4 * jj; a[k] = *(const u32x2*)row[k]; c[k] = *(const u32x2*)(row[k] + 32); }
#pragma unroll
    for (int k = 0; k < NT; ++k) {
        const float x1[4] = {bflo(a[k].x), bfhi(a[k].x), bflo(a[k].y), bfhi(a[k].y)}, x2[4] = {bflo(c[k].x), bfhi(c[k].x), bflo(c[k].y), bfhi(c[k].y)};
        float ss = 0.f;
#pragma unroll
        for (int e = 0; e < 4; ++e) ss += x1[e] * x1[e] + x2[e] * x2[e];
        ss += shx(ss, 1, lane); ss += shx(ss, 2, lane); ss += shx(ss, 4, lane);
        const float r = 1.0f / sqrtf(ss * (1.0f / 64.0f) + EPS) ;
        const float pos = (float)(m[k] % SEQ);
        float o1[4], o2[4];
#pragma unroll
        for (int e = 0; e < 4; ++e) {
            const float ang = pos * inv_freq[e];
            double t = (double)ang * 0.15915494309189535; t -= rint(t);
            const float sn = __builtin_amdgcn_sinf((float)t), cs = __builtin_amdgcn_cosf((float)t);
            const float y1 = x1[e] * r * g1[e], y2 = x2[e] * r * g2[e];
            o1[e] = (y1 * cs - y2 * sn) * osc; o2[e] = (y2 * cs + y1 * sn) * osc;
        }
        u32x2 w1; w1.x = pk2(o1[0], o1[1]); w1.y = pk2(o1[2], o1[3]);
        u32x2 w2; w2.x = pk2(o2[0], o2[1]); w2.y = pk2(o2[2], o2[3]);
        *(u32x2*)row[k] = w1; *(u32x2*)(row[k] + 32) = w2;
    }
}

struct DilState { f32x16 o0, o1; float den; };
DI void dil_scores(DilState& st, unsigned (&pw)[8], const bf16x8 (&kf)[4], const bf16x8 (&qf)[4], int dbase, float m2, int hh) {
    f32x16 S;
#pragma unroll
    for (int i = 0; i < 16; ++i) S[i] = 0.f;
#pragma unroll
    for (int ks = 0; ks < 4; ++ks) S = MFMA_BF16(kf[ks], qf[ks], S);
#pragma unroll
    for (int i = 0; i < 16; i += 2) {
        const int d0 = dbase - crow(i, hh), d1 = dbase - crow(i + 1, hh);
        const float p0 = (d0 >= 0 && d0 <= 128) ? fexp2(S[i] - m2) : 0.f, p1 = (d1 >= 0 && d1 <= 128) ? fexp2(S[i + 1] - m2) : 0.f;
        st.den += p0 + p1; pw[i >> 1] = pk2(p0, p1);
    }
}
DI void dil_tile2(DilState& sa, DilState& sb, const bf16x8 (&qa)[4], const bf16x8 (&qb)[4], LAS unsigned char* kl, LAS unsigned char* vt, int dba, int dbb, bool doa, bool dob, float m2, int lane) {
    const int hh = lane >> 5;
    bf16x8 kf[4];
#pragma unroll
    for (int ks = 0; ks < 4; ++ks) kf[ks] = k_frag(kl, ks, lane);
    unsigned pa[8], pb[8];
#pragma unroll
    for (int i = 0; i < 8; ++i) { pa[i] = 0u; pb[i] = 0u; }
    if (doa) dil_scores(sa, pa, kf, qa, dba, m2, hh);
    if (dob) dil_scores(sb, pb, kf, qb, dbb, m2, hh);
    bf16x8 vf[2][2];
#pragma unroll
    for (int ks = 0; ks < 2; ++ks) { vf[0][ks] = v_frag(vt, 0, ks, lane); vf[1][ks] = v_frag(vt, 1, ks, lane); }
    if (doa) {
        const bf16x8 p0 = __builtin_bit_cast(bf16x8, (u32x4){pa[0], pa[1], pa[2], pa[3]}), p1 = __builtin_bit_cast(bf16x8, (u32x4){pa[4], pa[5], pa[6], pa[7]});
        sa.o0 = MFMA_BF16(vf[0][0], p0, sa.o0); sa.o1 = MFMA_BF16(vf[1][0], p0, sa.o1); sa.o0 = MFMA_BF16(vf[0][1], p1, sa.o0); sa.o1 = MFMA_BF16(vf[1][1], p1, sa.o1);
    }
    if (dob) {
        const bf16x8 p0 = __builtin_bit_cast(bf16x8, (u32x4){pb[0], pb[1], pb[2], pb[3]}), p1 = __builtin_bit_cast(bf16x8, (u32x4){pb[4], pb[5], pb[6], pb[7]});
        sb.o0 = MFMA_BF16(vf[0][0], p0, sb.o0); sb.o1 = MFMA_BF16(vf[1][0], p0, sb.o1); sb.o0 = MFMA_BF16(vf[0][1], p1, sb.o0); sb.o1 = MFMA_BF16(vf[1][1], p1, sb.o1);
    }
}
DI void dil_store(const DilState& st, bf16_t* pnum, float* pden, int pat, size_t rowq, int hd, int hh, int lane) {
    float den = st.den; den += shx(den, 32, lane);
    bf16_t* np = pnum + ((size_t)pat * M_TOK + rowq) * 256 + hd * 64 + 4 * hh;
#pragma unroll
    for (int g = 0; g < 4; ++g) {
        u32x2 w0; w0.x = pk2(st.o0[4 * g], st.o0[4 * g + 1]); w0.y = pk2(st.o0[4 * g + 2], st.o0[4 * g + 3]);
        u32x2 w1; w1.x = pk2(st.o1[4 * g], st.o1[4 * g + 1]); w1.y = pk2(st.o1[4 * g + 2], st.o1[4 * g + 3]);
        *(u32x2*)(np + 8 * g) = w0; *(u32x2*)(np + 32 + 8 * g) = w1;
    }
    if (hh == 0) pden[((size_t)pat * M_TOK + rowq) * 4 + hd] = den;
}
DI void dil_unit(const bf16_t* proj, bf16_t* pnum, float* pden, LAS unsigned char* wl, int b, int hd, int pat, int rho, int jt2, float m2, int lane) {
    const int r = 1 << (2 * pat);
    const int q = lane & 31, hh = lane >> 5;
    const size_t rowbase = (size_t)b * SEQ;
    LAS unsigned char* kl = wl; LAS unsigned char* vl = wl + VT_TILE;
    const int ja = 2 * jt2, jb = ja + 1;
    const size_t rowqa = rowbase + (size_t)(32 * ja + q) * r + rho, rowqb = rowbase + (size_t)(32 * jb + q) * r + rho;
    bf16x8 qa[4], qb[4];
    { const bf16_t* pa_ = proj + rowqa * PW + C_QD + hd * 64 + 8 * hh; const bf16_t* pb_ = proj + rowqb * PW + C_QD + hd * 64 + 8 * hh;
#pragma unroll
      for (int ks = 0; ks < 4; ++ks) { qa[ks] = *(const bf16x8*)(pa_ + 16 * ks); qb[ks] = *(const bf16x8*)(pb_ + 16 * ks); } }
    DilState sa, sb;
#pragma unroll
    for (int i = 0; i < 16; ++i) { sa.o0[i] = 0.f; sa.o1[i] = 0.f; sb.o0[i] = 0.f; sb.o1[i] = 0.f; }
    sa.den = 0.f; sb.den = 0.f;
    const int kt0 = (ja - 4) > 0 ? (ja - 4) : 0, jt = jb;
    const bf16_t* lbase = proj + (rowbase + (size_t)(lane >> 3) * r + rho) * PW + hd * 64 + (lane & 7) * 8;
    const size_t tstride = (size_t)32 * r * PW, rstep = (size_t)8 * r * PW;
    u32x4 KX[4], VX[4], KY[4], VY[4];
    kv_issue<C_KD, C_VD>(KX, VX, lbase + (size_t)kt0 * tstride, rstep);
    kv_issue<C_KD, C_VD>(KY, VY, lbase + (size_t)(kt0 + 1 < jt ? kt0 + 1 : jt) * tstride, rstep);
    KV_WAIT(8, KX, VX);
    kv_stage(kl, vl, KX, VX, lane);
    int kt = kt0;
#define DIL_STEP(N1, N2) { \
        kv_issue<C_KD, C_VD>(K##N2, V##N2, lbase + (size_t)(kt + 2 < jt ? kt + 2 : jt) * tstride, rstep); \
        int ln_ = lane; asm volatile("" : "+v"(ln_)); \
        dil_tile2(sa, sb, qa, qb, kl, vl, 32 * (ja - kt) + (ln_ & 31), 32 * (jb - kt) + (ln_ & 31), kt <= ja, kt >= ja - 3, m2, ln_); \
        KV_WAIT(8, K##N1, V##N1); \
        if (kt == jt) { KV_WAIT(0, K##N2, V##N2); break; } \
        kv_stage(kl, vl, K##N1, V##N1, ln_); ++kt; }
    for (;;) {
        DIL_STEP(Y, X)
        DIL_STEP(X, Y)
    }
#undef DIL_STEP
    dil_store(sa, pnum, pden, pat, rowqa, hd, hh, lane);
    dil_store(sb, pnum, pden, pat, rowqb, hd, hh, lane);
}

template <int NR> DI void dil_merge_rows(const bf16_t* pnum, const float* pden, bf16_t* Y, const int (&m)[NR], int lane) {
    u32x2 v[NR][3]; float dd[NR][3];
#pragma unroll
    for (int k = 0; k < NR; ++k)
#pragma unroll
        for (int p = 0; p < 3; ++p) { v[k][p] = *(const u32x2*)(pnum + ((size_t)p * M_TOK + m[k]) * 256 + 4 * lane); dd[k][p] = pden[((size_t)p * M_TOK + m[k]) * 4 + (lane >> 4)]; }
#pragma unroll
    for (int k = 0; k < NR; ++k) {
        const float rd = 1.0f / (dd[k][0] + dd[k][1] + dd[k][2]);
        const float n0 = bflo(v[k][0].x) + bflo(v[k][1].x) + bflo(v[k][2].x), n1 = bfhi(v[k][0].x) + bfhi(v[k][1].x) + bfhi(v[k][2].x);
        const float n2 = bflo(v[k][0].y) + bflo(v[k][1].y) + bflo(v[k][2].y), n3 = bfhi(v[k][0].y) + bfhi(v[k][1].y) + bfhi(v[k][2].y);
        u32x2 w; w.x = pk2(n0 * rd, n1 * rd); w.y = pk2(n2 * rd, n3 * rd);
        *(u32x2*)(Y + (size_t)m[k] * D_MODEL + 256 + 4 * lane) = w;
    }
}

constexpr int H_TOT = 0;
constexpr int H_QA = 4096;
constexpr int H_KT = H_QA + 17408;
constexpr int H_QB = H_KT + 17408;
constexpr int H_VT = H_QB + 17408;
constexpr int H_KH = H_VT + 18432;
constexpr int H_RED = H_KH + 18432;
static_assert(H_RED + 1024 <= 131072, "HGRN LDS map");

DI void hgrn_gate16(const unsigned short (&zr)[16], float lb, float (&pfx)[16], float (&kk)[16]) {
    float run = 0.f;
#pragma unroll
    for (int i = 0; i < 16; ++i) {
        const float z = bf2f(zr[i]);
        const float sig = frcp(1.0f + __expf(-z));
        const float f = fmaxf(lb + (1.0f - lb) * sig, 1e-30f);
        run += __logf(f); pfx[i] = run; kk[i] = 1.0f - f;
    }
}
DI void hgrn_store_vt(unsigned char* lds, int off, const unsigned short (&vr)[16], int v, int seg) {
    u32x4* dst = (u32x4*)(lds + off + (v * 72 + 16 * seg) * 2);
    dst[0] = (u32x4){(unsigned)vr[0] | ((unsigned)vr[1] << 16), (unsigned)vr[2] | ((unsigned)vr[3] << 16), (unsigned)vr[4] | ((unsigned)vr[5] << 16), (unsigned)vr[6] | ((unsigned)vr[7] << 16)};
    dst[1] = (u32x4){(unsigned)vr[8] | ((unsigned)vr[9] << 16), (unsigned)vr[10] | ((unsigned)vr[11] << 16), (unsigned)vr[12] | ((unsigned)vr[13] << 16), (unsigned)vr[14] | ((unsigned)vr[15] << 16)};
}

DI void hgrn_h1_unit(unsigned char* lds, const bf16_t* proj, const float* lball, bf16_t* ST, float* DEC, int unit, int tid, int wave, int lane) {
    const int bh = unit / NCHUNK, n = unit % NCHUNK, b = bh >> 2, hd = bh & 3;
    const size_t R0 = (size_t)b * SEQ + (size_t)n * 64;
    const int d = tid & 127, seg = tid >> 7;
    const bf16_t* src = proj + (R0 + 16 * seg) * PW + hd * 128 + d;
    unsigned short zr[16], vr[16];
#pragma unroll
    for (int i = 0; i < 16; ++i) { zr[i] = src[(size_t)i * PW + C_FH]; vr[i] = src[(size_t)i * PW + C_IH]; }
    float pfx[16], kk[16];
    hgrn_gate16(zr, lball[hd * 128 + d], pfx, kk);
    float* TOT = (float*)(lds + H_TOT);
    TOT[seg * 128 + d] = pfx[15];
    __syncthreads();
    float off = 0.f, glast = 0.f;
#pragma unroll
    for (int s2 = 0; s2 < 4; ++s2) { const float t = TOT[s2 * 128 + d]; glast += t; if (s2 < seg) off += t; }
    {
        unsigned w[8];
#pragma unroll
        for (int i = 0; i < 8; ++i) w[i] = pk2(kk[2 * i] * __expf(glast - (off + pfx[2 * i])), kk[2 * i + 1] * __expf(glast - (off + pfx[2 * i + 1])));
        u32x4* dst = (u32x4*)(lds + H_KH + (d * 72 + 16 * seg) * 2);
        dst[0] = (u32x4){w[0], w[1], w[2], w[3]}; dst[1] = (u32x4){w[4], w[5], w[6], w[7]};
        if (seg == 0) DEC[((size_t)bh * NCHUNK + n) * 128 + d] = __expf(glast);
    }
    hgrn_store_vt(lds, H_VT, vr, d, seg);
    __syncthreads();
    {
        const int dtile = wave >> 1, vt0 = 2 * (wave & 1), l31 = lane & 31, hh = lane >> 5;
        f32x16 a0, a1;
#pragma unroll
        for (int i = 0; i < 16; ++i) { a0[i] = 0.f; a1[i] = 0.f; }
#pragma unroll
        for (int ks = 0; ks < 4; ++ks) {
            const bf16x8 af = *(const bf16x8*)(lds + H_KH + ((32 * dtile + l31) * 72 + 16 * ks + 8 * hh) * 2);
            const bf16x8 b0 = *(const bf16x8*)(lds + H_VT + ((32 * vt0 + l31) * 72 + 16 * ks + 8 * hh) * 2);
            const bf16x8 b1 = *(const bf16x8*)(lds + H_VT + ((32 * (vt0 + 1) + l31) * 72 + 16 * ks + 8 * hh) * 2);
            a0 = MFMA_BF16(af, b0, a0); a1 = MFMA_BF16(af, b1, a1);
        }
        bf16_t* st = ST + ((size_t)bh * NCHUNK + n) * 16384 + 32 * dtile + 4 * hh;
#pragma unroll
        for (int g = 0; g < 4; ++g) {
            u32x2 w0; w0.x = pk2(a0[4 * g], a0[4 * g + 1]); w0.y = pk2(a0[4 * g + 2], a0[4 * g + 3]);
            u32x2 w1; w1.x = pk2(a1[4 * g], a1[4 * g + 1]); w1.y = pk2(a1[4 * g + 2], a1[4 * g + 3]);
            *(u32x2*)(st + (32 * vt0 + l31) * 128 + 8 * g) = w0; *(u32x2*)(st + (32 * (vt0 + 1) + l31) * 128 + 8 * g) = w1;
        }
    }
}

DI void hgrn_scan(bf16_t* ST, const float* DEC, int gtid  ) {
    const int bh = gtid >> 14, e = gtid & 16383, d = e & 127;
    bf16_t* st = ST + (size_t)bh * NCHUNK * 16384 + e;
    const float* dc = DEC + (size_t)bh * NCHUNK * 128 + d;
    float s = 0.f;
    for (int n0 = 0; n0 < NCHUNK; n0 += 32) {
        unsigned short u[32]; float dd[32];
#pragma unroll
        for (int i = 0; i < 32; ++i) { u[i] = st[(size_t)(n0 + i) * 16384]; dd[i] = dc[(n0 + i) * 128]; }
#pragma unroll
        for (int i = 0; i < 32; ++i) { st[(size_t)(n0 + i) * 16384] = (bf16_t)(pk2(s, 0.f) & 0xffffu); s = dd[i] * s + bf2f(u[i]); }
    }
}

DI void hgrn_h3_unit(unsigned char* lds, const bf16_t* proj, const float* lball, const bf16_t* ST, const float* hng, bf16_t* Y, int unit, int tid, int wave, int lane) {
    const int bh = unit / NCHUNK, n = unit % NCHUNK, b = bh >> 2, hd = bh & 3;
    const size_t R0 = (size_t)b * SEQ + (size_t)n * 64;
    const int d = tid & 127, seg = tid >> 7;
    const int vt = wave >> 1, ti = wave & 1, l31 = lane & 31, hh = lane >> 5;
    const bf16_t* src = proj + (R0 + 16 * seg) * PW + hd * 128 + d;
    unsigned short zr[16], qr[16], vr[16];
#pragma unroll
    for (int i = 0; i < 16; ++i) { zr[i] = src[(size_t)i * PW + C_FH]; qr[i] = src[(size_t)i * PW + C_QH]; vr[i] = src[(size_t)i * PW + C_IH]; }
    bf16x8 stf[8];
    { const bf16_t* sp = ST + ((size_t)bh * NCHUNK + n) * 16384 + (32 * vt + l31) * 128 + 8 * hh;
#pragma unroll
      for (int ks = 0; ks < 8; ++ks) stf[ks] = *(const bf16x8*)(sp + 16 * ks); }
    const int t = 32 * ti + l31;
    u32x2 gv[4]; f32x4 nn[4];
    { const bf16_t* gp = proj + (R0 + t) * PW + C_GH + hd * 128 + 32 * vt + 4 * hh; const float* gn = hng + 32 * vt + 4 * hh;
#pragma unroll
      for (int g = 0; g < 4; ++g) { gv[g] = *(const u32x2*)(gp + 8 * g); nn[g] = *(const f32x4*)(gn + 8 * g); } }
    float pfx[16], kk[16];
    hgrn_gate16(zr, lball[hd * 128 + d], pfx, kk);
    float* TOT = (float*)(lds + H_TOT);
    TOT[seg * 128 + d] = pfx[15];
    __syncthreads();
    {
        float off = 0.f;
#pragma unroll
        for (int s2 = 0; s2 < 3; ++s2) { const float tt = TOT[s2 * 128 + d]; if (s2 < seg) off += tt; }
        const float gm = TOT[d] + TOT[128 + d];
        bf16_t* QA = (bf16_t*)(lds + H_QA); bf16_t* KT = (bf16_t*)(lds + H_KT); bf16_t* QB = (bf16_t*)(lds + H_QB);
#pragma unroll
        for (int i = 0; i < 16; ++i) {
            const int tk = 16 * seg + i;
            const float g = off + pfx[i];
            const float qv = silu_f(bf2f(qr[i]));
            const float e1 = __expf(fminf(g - gm, 80.f)), e2 = __expf(fminf(gm - g, 80.f)), e3 = __expf(g);
            QA[tk * 136 + d] = (bf16_t)(pk2(qv * e1, 0.f) & 0xffffu);
            KT[tk * 136 + d] = (bf16_t)(pk2(kk[i] * e2, 0.f) & 0xffffu);
            QB[tk * 136 + d] = (bf16_t)(pk2(qv * e3, 0.f) & 0xffffu);
        }
    }
    hgrn_store_vt(lds, H_VT, vr, d, seg);
    __syncthreads();
    f32x16 acc;
#pragma unroll
    for (int i = 0; i < 16; ++i) acc[i] = 0.f;
#pragma unroll
    for (int ks = 0; ks < 8; ++ks) {
        const bf16x8 bfr = *(const bf16x8*)(lds + H_QB + ((32 * ti + l31) * 136 + 16 * ks + 8 * hh) * 2);
        acc = MFMA_BF16(stf[ks], bfr, acc);
    }
    for (int si = 0; si <= ti; ++si) {
        f32x16 Sc;
#pragma unroll
        for (int i = 0; i < 16; ++i) Sc[i] = 0.f;
#pragma unroll
        for (int ks = 0; ks < 8; ++ks) {
            const bf16x8 af = *(const bf16x8*)(lds + H_KT + ((32 * si + l31) * 136 + 16 * ks + 8 * hh) * 2);
            const bf16x8 bfr = *(const bf16x8*)(lds + H_QA + ((32 * ti + l31) * 136 + 16 * ks + 8 * hh) * 2);
            Sc = MFMA_BF16(af, bfr, Sc);
        }
        unsigned pw[8];
#pragma unroll
        for (int i = 0; i < 16; i += 2) {
            const bool v0 = (si < ti) || (crow(i, hh) <= l31), v1 = (si < ti) || (crow(i + 1, hh) <= l31);
            pw[i >> 1] = pk2(v0 ? Sc[i] : 0.f, v1 ? Sc[i + 1] : 0.f);
        }
        bf16x8 pf[2];
        pf[0] = __builtin_bit_cast(bf16x8, (u32x4){pw[0], pw[1], pw[2], pw[3]});
        pf[1] = __builtin_bit_cast(bf16x8, (u32x4){pw[4], pw[5], pw[6], pw[7]});
#pragma unroll
        for (int ks = 0; ks < 2; ++ks) {
            const unsigned char* vb = lds + H_VT + ((32 * vt + l31) * 72 + 32 * si + 16 * ks + 4 * hh) * 2;
            const u32x2 lo = *(const u32x2*)vb, hi = *(const u32x2*)(vb + 16);
            const bf16x8 af = __builtin_bit_cast(bf16x8, (u32x4){lo.x, lo.y, hi.x, hi.y});
            acc = MFMA_BF16(af, pf[ks], acc);
        }
    }
    float ss = 0.f;
#pragma unroll
    for (int i = 0; i < 16; ++i) ss += acc[i] * acc[i];
    ss += shx(ss, 32, lane);
    float* RED = (float*)(lds + H_RED);
    if (hh == 0) RED[vt * 64 + t] = ss;
    __syncthreads();
    const float tot = RED[t] + RED[64 + t] + RED[128 + t] + RED[192 + t];
    const float rs = 1.0f / sqrtf(tot * (1.0f / 128.0f) + EPS);
    bf16_t* yp = Y + (R0 + t) * D_MODEL + 512 + hd * 128 + 32 * vt + 4 * hh;
#pragma unroll
    for (int g = 0; g < 4; ++g) {
        const float r0 = acc[4 * g] * rs * nn[g].x * silu_f(bflo(gv[g].x)), r1 = acc[4 * g + 1] * rs * nn[g].y * silu_f(bfhi(gv[g].x));
        const float r2 = acc[4 * g + 2] * rs * nn[g].z * silu_f(bflo(gv[g].y)), r3 = acc[4 * g + 3] * rs * nn[g].w * silu_f(bfhi(gv[g].y));
        u32x2 w; w.x = pk2(r0, r1); w.y = pk2(r2, r3);
        *(u32x2*)(yp + 8 * g) = w;
    }
}


DI void hgrn_gate8x2(const unsigned (&zr)[8], float lb0, float lb1, float (&pfx)[2][8], float (&kk)[2][8]) {
    float run0 = 0.f, run1 = 0.f;
#pragma unroll
    for (int i = 0; i < 8; ++i) {
        const float z0 = bflo(zr[i]), z1 = bfhi(zr[i]);
        const float f0 = fmaxf(lb0 + (1.0f - lb0) * frcp(1.0f + __expf(-z0)), 1e-30f), f1 = fmaxf(lb1 + (1.0f - lb1) * frcp(1.0f + __expf(-z1)), 1e-30f);
        run0 += __logf(f0); run1 += __logf(f1); pfx[0][i] = run0; pfx[1][i] = run1; kk[0][i] = 1.0f - f0; kk[1][i] = 1.0f - f1;
    }
}
DI void hgrn_store_vt2(unsigned char* lds, int off, const unsigned (&vr)[8], int d0, int seg) {
    u32x4 a, b;
    a.x = (vr[0] & 0xffffu) | (vr[1] << 16); a.y = (vr[2] & 0xffffu) | (vr[3] << 16); a.z = (vr[4] & 0xffffu) | (vr[5] << 16); a.w = (vr[6] & 0xffffu) | (vr[7] << 16);
    b.x = (vr[0] >> 16) | (vr[1] & 0xffff0000u); b.y = (vr[2] >> 16) | (vr[3] & 0xffff0000u); b.z = (vr[4] >> 16) | (vr[5] & 0xffff0000u); b.w = (vr[6] >> 16) | (vr[7] & 0xffff0000u);
    *(u32x4*)(lds + off + (d0 * 72 + 8 * seg) * 2) = a; *(u32x4*)(lds + off + ((d0 + 1) * 72 + 8 * seg) * 2) = b;
}

DI void hgrn_h1_phase(unsigned char* lds, const bf16_t* proj, const float* lball, bf16_t* ST, float* DEC, int bid, int G, int tid, int wave, int lane) {
    const int d0 = 2 * (tid & 63), seg = tid >> 6;
    const int NU = 8 * NCHUNK;
    if (bid >= NU) return;
    unsigned zr[8], vr[8];
    {   const int bh = bid / NCHUNK, n = bid % NCHUNK; const size_t R0 = (size_t)(bh >> 2) * SEQ + (size_t)n * 64;
        const bf16_t* src = proj + (R0 + 8 * seg) * PW + (bh & 3) * 128 + d0;
#pragma unroll
        for (int i = 0; i < 8; ++i) { zr[i] = *(const unsigned*)(src + (size_t)i * PW + C_FH); vr[i] = *(const unsigned*)(src + (size_t)i * PW + C_IH); }
        asm volatile("" ::: "memory"); }
    float* TOT = (float*)(lds + H_TOT);
    for (int unit = bid; unit < NU; unit += G) {
        const int bh = unit / NCHUNK, n = unit % NCHUNK, hd = bh & 3;
        float pfx[2][8], kk[2][8];
        hgrn_gate8x2(zr, lball[hd * 128 + d0], lball[hd * 128 + d0 + 1], pfx, kk);
        *(f32x2*)(TOT + seg * 128 + d0) = (f32x2){pfx[0][7], pfx[1][7]};
        __syncthreads();
        float off[2] = {0.f, 0.f}, glast[2] = {0.f, 0.f};
#pragma unroll
        for (int s2 = 0; s2 < 8; ++s2) { const f32x2 t = *(const f32x2*)(TOT + s2 * 128 + d0); glast[0] += t.x; glast[1] += t.y; if (s2 < seg) { off[0] += t.x; off[1] += t.y; } }
#pragma unroll
        for (int c = 0; c < 2; ++c) {
            unsigned w[4];
#pragma unroll
            for (int i = 0; i < 4; ++i) w[i] = pk2(kk[c][2 * i] * __expf(glast[c] - (off[c] + pfx[c][2 * i])), kk[c][2 * i + 1] * __expf(glast[c] - (off[c] + pfx[c][2 * i + 1])));
            *(u32x4*)(lds + H_KH + ((d0 + c) * 72 + 8 * seg) * 2) = (u32x4){w[0], w[1], w[2], w[3]};
        }
        if (seg == 0) *(f32x2*)(DEC + ((size_t)bh * NCHUNK + n) * 128 + d0) = (f32x2){__expf(glast[0]), __expf(glast[1])};
        hgrn_store_vt2(lds, H_VT, vr, d0, seg);
        {
            const int un = (unit + G < NU) ? unit + G : unit; const int bh2 = un / NCHUNK, n2 = un % NCHUNK; const size_t R2 = (size_t)(bh2 >> 2) * SEQ + (size_t)n2 * 64;
            const bf16_t* src = proj + (R2 + 8 * seg) * PW + (bh2 & 3) * 128 + d0;
#pragma unroll
            for (int i = 0; i < 8; ++i) { zr[i] = *(const unsigned*)(src + (size_t)i * PW + C_FH); vr[i] = *(const unsigned*)(src + (size_t)i * PW + C_IH); }
            asm volatile("" ::: "memory"); }
        __syncthreads();
        {
            const int dtile = wave >> 1, vt0 = 2 * (wave & 1), l31 = lane & 31, hh = lane >> 5;
            f32x16 a0, a1;
#pragma unroll
            for (int i = 0; i < 16; ++i) { a0[i] = 0.f; a1[i] = 0.f; }
            bf16x8 af[4], b0[4], b1[4];
#pragma unroll
            for (int ks = 0; ks < 4; ++ks) {
                af[ks] = *(const bf16x8*)(lds + H_KH + ((32 * dtile + l31) * 72 + 16 * ks + 8 * hh) * 2);
                b0[ks] = *(const bf16x8*)(lds + H_VT + ((32 * vt0 + l31) * 72 + 16 * ks + 8 * hh) * 2);
                b1[ks] = *(const bf16x8*)(lds + H_VT + ((32 * (vt0 + 1) + l31) * 72 + 16 * ks + 8 * hh) * 2);
            }
            asm volatile("" ::: "memory");
#pragma unroll
            for (int ks = 0; ks < 4; ++ks) { a0 = MFMA_BF16(af[ks], b0[ks], a0); a1 = MFMA_BF16(af[ks], b1[ks], a1); }
            bf16_t* st = ST + ((size_t)bh * NCHUNK + n) * 16384 + 32 * dtile + 4 * hh;
#pragma unroll
            for (int g = 0; g < 4; ++g) {
                u32x2 w0; w0.x = pk2(a0[4 * g], a0[4 * g + 1]); w0.y = pk2(a0[4 * g + 2], a0[4 * g + 3]);
                u32x2 w1; w1.x = pk2(a1[4 * g], a1[4 * g + 1]); w1.y = pk2(a1[4 * g + 2], a1[4 * g + 3]);
                *(u32x2*)(st + (32 * vt0 + l31) * 128 + 8 * g) = w0; *(u32x2*)(st + (32 * (vt0 + 1) + l31) * 128 + 8 * g) = w1;
            }
        }
    }
    __syncthreads();
}

DI void hgrn_h3_phase(unsigned char* lds, const bf16_t* proj, const float* lball, const bf16_t* ST, const float* hng, bf16_t* Y, int bid, int G, int tid, int wave, int lane) {
    const int d0 = 2 * (tid & 63), seg = tid >> 6;
    const int vt = wave >> 1, ti = wave & 1, l31 = lane & 31, hh = lane >> 5;
    const int t = 32 * ti + l31;
    const int NU = 8 * NCHUNK;
    if (bid >= NU) return;
    unsigned zr[8], qr[8], vr[8]; bf16x8 stf[8]; u32x2 gv[4];
    f32x4 nn[4];
    { const float* gn = hng + 32 * vt + 4 * hh;
#pragma unroll
      for (int g = 0; g < 4; ++g) nn[g] = *(const f32x4*)(gn + 8 * g); }
#define H3_LOAD_RAW(U) { const int bh_ = (U) / NCHUNK, n_ = (U) % NCHUNK; const size_t R_ = (size_t)(bh_ >> 2) * SEQ + (size_t)n_ * 64; \
        const bf16_t* src_ = proj + (R_ + 8 * seg) * PW + (bh_ & 3) * 128 + d0; \
        _Pragma("unroll") for (int i = 0; i < 8; ++i) { zr[i] = *(const unsigned*)(src_ + (size_t)i * PW + C_FH); qr[i] = *(const unsigned*)(src_ + (size_t)i * PW + C_QH); vr[i] = *(const unsigned*)(src_ + (size_t)i * PW + C_IH); } \
        asm volatile("" ::: "memory"); }
#define H3_LOAD_ST(U) { const int bh_ = (U) / NCHUNK, n_ = (U) % NCHUNK; const bf16_t* sp_ = ST + ((size_t)bh_ * NCHUNK + n_) * 16384 + (32 * vt + l31) * 128 + 8 * hh; \
        _Pragma("unroll") for (int ks = 0; ks < 8; ++ks) stf[ks] = *(const bf16x8*)(sp_ + 16 * ks); \
        asm volatile("" ::: "memory"); }
#define H3_LOAD_GATE(U) { const int bh_ = (U) / NCHUNK, n_ = (U) % NCHUNK; const size_t R_ = (size_t)(bh_ >> 2) * SEQ + (size_t)n_ * 64; \
        const bf16_t* gp_ = proj + (R_ + t) * PW + C_GH + (bh_ & 3) * 128 + 32 * vt + 4 * hh; \
        _Pragma("unroll") for (int g = 0; g < 4; ++g) gv[g] = *(const u32x2*)(gp_ + 8 * g); \
        asm volatile("" ::: "memory"); }
    H3_LOAD_RAW(bid) H3_LOAD_ST(bid) H3_LOAD_GATE(bid)
    float* TOT = (float*)(lds + H_TOT);
    for (int unit = bid; unit < NU; unit += G) {
        const int bh = unit / NCHUNK, n = unit % NCHUNK, b = bh >> 2, hd = bh & 3;
        const size_t R0 = (size_t)b * SEQ + (size_t)n * 64;
        const int un = (unit + G < NU) ? unit + G : unit;
        float pfx[2][8], kk[2][8];
        hgrn_gate8x2(zr, lball[hd * 128 + d0], lball[hd * 128 + d0 + 1], pfx, kk);
        *(f32x2*)(TOT + seg * 128 + d0) = (f32x2){pfx[0][7], pfx[1][7]};
        __syncthreads();
        {
            float off[2] = {0.f, 0.f}, gm[2] = {0.f, 0.f};
#pragma unroll
            for (int s2 = 0; s2 < 7; ++s2) { const f32x2 tt = *(const f32x2*)(TOT + s2 * 128 + d0); if (s2 < seg) { off[0] += tt.x; off[1] += tt.y; } if (s2 < 4) { gm[0] += tt.x; gm[1] += tt.y; } }
            const float egm[2] = {__expf(gm[0]), __expf(gm[1])};
            unsigned* QA = (unsigned*)(lds + H_QA); unsigned* KT = (unsigned*)(lds + H_KT); unsigned* QB = (unsigned*)(lds + H_QB);
#pragma unroll
            for (int i = 0; i < 8; ++i) {
                const int tk = 8 * seg + i;
                float qa[2], kt[2], qb[2];
#pragma unroll
                for (int c = 0; c < 2; ++c) {
                    const float g = off[c] + pfx[c][i];
                    const float qv = silu_f(c ? bfhi(qr[i]) : bflo(qr[i]));
                    const float e1 = __expf(fminf(fmaxf(g - gm[c], -80.f), 80.f)), e2 = frcp(e1), e3 = e1 * egm[c];
                    qa[c] = qv * e1; kt[c] = kk[c][i] * e2; qb[c] = qv * e3;
                }
                QA[(tk * 136 + d0) >> 1] = pk2(qa[0], qa[1]); KT[(tk * 136 + d0) >> 1] = pk2(kt[0], kt[1]); QB[(tk * 136 + d0) >> 1] = pk2(qb[0], qb[1]);
            }
        }
        hgrn_store_vt2(lds, H_VT, vr, d0, seg);
        H3_LOAD_RAW(un)
        __syncthreads();
        f32x16 acc;
#pragma unroll
        for (int i = 0; i < 16; ++i) acc[i] = 0.f;
        bf16x8 qbf[8], qaf[8];
#pragma unroll
        for (int ks = 0; ks < 8; ++ks) { qbf[ks] = *(const bf16x8*)(lds + H_QB + ((32 * ti + l31) * 136 + 16 * ks + 8 * hh) * 2); qaf[ks] = *(const bf16x8*)(lds + H_QA + ((32 * ti + l31) * 136 + 16 * ks + 8 * hh) * 2); }
        asm volatile("" ::: "memory");
#pragma unroll
        for (int ks = 0; ks < 8; ++ks) acc = MFMA_BF16(stf[ks], qbf[ks], acc);
        H3_LOAD_ST(un)
        for (int si = 0; si <= ti; ++si) {
            f32x16 Sc;
#pragma unroll
            for (int i = 0; i < 16; ++i) Sc[i] = 0.f;
            bf16x8 ktf[8];
#pragma unroll
            for (int ks = 0; ks < 8; ++ks) ktf[ks] = *(const bf16x8*)(lds + H_KT + ((32 * si + l31) * 136 + 16 * ks + 8 * hh) * 2);
            asm volatile("" ::: "memory");
#pragma unroll
            for (int ks = 0; ks < 8; ++ks) Sc = MFMA_BF16(ktf[ks], qaf[ks], Sc);
            unsigned pw[8];
#pragma unroll
            for (int i = 0; i < 16; i += 2) {
                const bool v0 = (si < ti) || (crow(i, hh) <= l31), v1 = (si < ti) || (crow(i + 1, hh) <= l31);
                pw[i >> 1] = pk2(v0 ? Sc[i] : 0.f, v1 ? Sc[i + 1] : 0.f);
            }
            bf16x8 pf[2];
            pf[0] = __builtin_bit_cast(bf16x8, (u32x4){pw[0], pw[1], pw[2], pw[3]});
            pf[1] = __builtin_bit_cast(bf16x8, (u32x4){pw[4], pw[5], pw[6], pw[7]});
#pragma unroll
            for (int ks = 0; ks < 2; ++ks) {
                const unsigned char* vb = lds + H_VT + ((32 * vt + l31) * 72 + 32 * si + 16 * ks + 4 * hh) * 2;
                const u32x2 lo = *(const u32x2*)vb, hi = *(const u32x2*)(vb + 16);
                const bf16x8 af = __builtin_bit_cast(bf16x8, (u32x4){lo.x, lo.y, hi.x, hi.y});
                acc = MFMA_BF16(af, pf[ks], acc);
            }
        }
        float ss = 0.f;
#pragma unroll
        for (int i = 0; i < 16; ++i) ss += acc[i] * acc[i];
        ss += shx(ss, 32, lane);
        float* RED = (float*)(lds + H_RED);
        if (hh == 0) RED[vt * 64 + t] = ss;
        __syncthreads();
        const float tot = RED[t] + RED[64 + t] + RED[128 + t] + RED[192 + t];
        const float rs = 1.0f / sqrtf(tot * (1.0f / 128.0f) + EPS);
        bf16_t* yp = Y + (R0 + t) * D_MODEL + 512 + hd * 128 + 32 * vt + 4 * hh;
        u32x2 wout[4];
#pragma unroll
        for (int g = 0; g < 4; ++g) {
            const float r0 = acc[4 * g] * rs * nn[g].x * silu_f(bflo(gv[g].x)), r1 = acc[4 * g + 1] * rs * nn[g].y * silu_f(bfhi(gv[g].x));
            const float r2 = acc[4 * g + 2] * rs * nn[g].z * silu_f(bflo(gv[g].y)), r3 = acc[4 * g + 3] * rs * nn[g].w * silu_f(bfhi(gv[g].y));
            wout[g].x = pk2(r0, r1); wout[g].y = pk2(r2, r3);
        }
        H3_LOAD_GATE(un)
#pragma unroll
        for (int g = 0; g < 4; ++g) *(u32x2*)(yp + 8 * g) = wout[g];
    }
#undef H3_LOAD_RAW
#undef H3_LOAD_ST
#undef H3_LOAD_GATE
}

#define CTX() \
    const __attribute__((address_space(4))) Params* kp_ = (const __attribute__((address_space(4))) Params*)__builtin_amdgcn_kernarg_segment_ptr(); asm volatile("" : "+s"(kp_)); const __attribute__((address_space(4))) Params& p = *kp_; \
    int tid_ = threadIdx.x; asm volatile("" : "+v"(tid_)); const int tid = tid_, lane = tid & 63, wave = __builtin_amdgcn_readfirstlane(tid >> 6); \
    const int G = gridDim.x, bid = blockIdx.x; const int gw = wave * G + bid, NGW = G * 8; unsigned char* ws = p.ws; \
    (void)lane; (void)gw; (void)NGW; (void)ws; (void)tid;
#define WLP(l) ((const bf16_t*)(ws + WS_WEIGHTS + (size_t)(l) * WL_SIZE))
#define MLP(l) ((const float*)(ws + WS_MOD) + (size_t)(l) * 2 * NMOD)

template <class Epi> DI void run_gemm(PG8_LAS unsigned char* glds, const bf16_t* A, const bf16_t* Bt, int N, int K, const Epi E) {
    int G_ = gridDim.x, b_ = blockIdx.x; asm volatile("" : "+s"(G_), "+s"(b_));
    pg8::Gemm g{A, Bt, M_TOK, N, K}; pg8::StaticOrder S; S.init(M_TOK, N, G_, b_);
    GEMMCALL<Epi, pg8::StaticOrder, G_ALIGN, G_SP2>(glds, g, S, E);
}

#ifdef PROBE_MASK
#define STAMP() do { if (threadIdx.x == 0) { ((volatile LAS unsigned long long*)(glds + 131072 + 256))[ts_n] = __builtin_amdgcn_s_memrealtime(); } ++ts_n; } while (0)
#else
#define STAMP() do { } while (0)
#endif
__global__ void __launch_bounds__(512) fwd_kernel(Params p_unused) {
    extern __shared__ __attribute__((aligned(16))) unsigned char lds[];
    cg::grid_group grid = cg::this_grid();
    PG8_LAS unsigned char* glds = (PG8_LAS unsigned char*)lds;
    int ts_n = 0; (void)ts_n; STAMP();
    { CTX(); if (tid < 2) ((volatile LAS unsigned*)(glds + LDS_MISC))[tid] = 0u;
      if (bid == 0) { unsigned* bw = (unsigned*)(ws + WS_BAR); for (int i = tid; i < XCD_BAR_WORDS + 256; i += 512) bw[i] = 0u; }
      { float* RS = (float*)(ws + WS_RS); for (int i = bid * 512 + tid; i < (DEPTH + 1) * 3 * M_TOK; i += G * 512) RS[i] = 0.f; } }
#ifndef SKIP_PREP
    { CTX(); phase_prep(p, lds, gw, NGW, wave, lane); }
#endif
    grid.sync();
    STAMP();
    { CTX(); if (tid == 0) (void)xb_add((unsigned*)(ws + WS_BAR) + XB_XCNT(xb_xcc_id()), 1u); }
#define GRID_BAR() do { CTX(); XcdBarrier xb_; xb_.bar = (unsigned*)(ws + WS_BAR); xb_.x = xb_xcc_id(); xb_.st = (volatile LAS unsigned*)(glds + LDS_MISC); xcd_barrier(xb_); STAMP(); } while (0)
    { CTX(); phase_prep2(p, ws, gw, NGW, lane); }
    GRID_BAR();
#define RSP(l, k) ((float*)(ws + WS_RS) + (size_t)((l) * 3 + (k)) * M_TOK)
#define SHWP(l) ((const float*)(ws + WS_SHW) + (size_t)(l) * 2 * SHW_N)

#pragma unroll 1
    for (int l = 0; l < DEPTH; ++l) {
        { CTX(); run_gemm(glds, (const bf16_t*)(ws + WS_HB), WLP(l) + WL_GU1 / 2, 2 * D_FF, D_MODEL, pg8::EpiSwiGLU{D_FF, l * 3 + 0, l * 2 * SHW_N}); }
        GRID_BAR();
        { CTX(); run_gemm(glds, (const bf16_t*)(ws + WS_ACT), WLP(l) + WL_DN1 / 2, D_MODEL, D_FF, pg8::EpiRes{(l == 0) ? 1 : 0, l * 2 * NMOD + 2 * D_MODEL, l * 2 * NMOD + 4 * D_MODEL, l * 3 + 1, 0.5f, 0}); }
        GRID_BAR();
        { CTX(); run_gemm(glds, (const bf16_t*)(ws + WS_HB), WLP(l) + WL_IN / 2, PW, D_MODEL, pg8::EpiBf16{PW, l * 3 + 1, l * 2 * SHW_N + 2 * D_FF}); }
        GRID_BAR();
#ifndef SKIP_H1
        { CTX(); if (tid == 0) ((volatile LAS unsigned*)(glds + LDS_MISC))[4] = 0u;
          hgrn_h1_phase(lds, (const bf16_t*)(ws + WS_ACT), (const float*)(ws + WS_LB) + l * 512, (bf16_t*)(ws + WS_ST), (float*)(ws + WS_DEC), bid, G, tid, wave, lane); }
#endif
        STAMP();
#ifndef SKIP_QK
        { CTX(); for (int m = gw; m < M_TOK; m += 4 * NGW) { if (m + 3 * NGW < M_TOK) { const int mm[4] = {m, m + NGW, m + 2 * NGW, m + 3 * NGW}; qkprep_tokens<4>((bf16_t*)(ws + WS_ACT), p.qng + l * 64, p.kng + l * 64, mm, lane); }
            else for (int m1 = m; m1 < M_TOK; m1 += NGW) { const int mm[1] = {m1}; qkprep_tokens<1>((bf16_t*)(ws + WS_ACT), p.qng + l * 64, p.kng + l * 64, mm, lane); } } }
#endif
        STAMP();
#ifndef SKIP_SB
        { CTX();
          for (;;) { unsigned jj = 0; if (lane == 0) jj = __hip_atomic_fetch_add((LAS unsigned*)(glds + LDS_MISC) + 4, 1u, __ATOMIC_RELAXED, __HIP_MEMORY_SCOPE_WORKGROUP);
            const int vb = (G % 8 == 0) ? (bid % 8) * (G / 8) + bid / 8 : bid;
            const int u = vb + G * __builtin_amdgcn_readfirstlane((int)jj); if (u >= 8 * (SEQ / 32)) break;
            const int bh = u / (SEQ / 32), qt = (SEQ / 32 - 1) - u % (SEQ / 32); sb_unit((const bf16_t*)(ws + WS_ACT), (bf16_t*)p.out, glds + wave * ATT_LDS_PER_WAVE, bh >> 2, bh & 3, qt, lane); } }
#endif
        GRID_BAR();
#ifndef SKIP_SCAN
        { CTX(); for (int g = bid * 512 + tid; g < 8 * 16384; g += G * 512) hgrn_scan((bf16_t*)(ws + WS_ST), (const float*)(ws + WS_DEC), g); }
#endif
        STAMP();
#ifndef SKIP_DIL
        { CTX();
            float gq = fabsf(p.qng[l * 64 + lane]), gk = fabsf(p.kng[l * 64 + lane]);
#pragma unroll
            for (int o = 1; o < 64; o <<= 1) { gq = fmaxf(gq, shx(gq, o, lane)); gk = fmaxf(gk, shx(gk, o, lane)); }
            const float m2 = 8.0f * gq * gk * LOG2E;
            const int vb = (G % 8 == 0) ? (bid % 8) * (G / 8) + bid / 8 : bid;
            for (int u = wave * G + vb; u < 3 * 8 * 256; u += NGW) {
                const int pat = u / 2048, rem = u % 2048, bh = rem / 256, pr = rem % 256;
                const int ppr = 256 >> (2 * pat);
                dil_unit((const bf16_t*)(ws + WS_ACT), (bf16_t*)(ws + WS_PNUM), (float*)(ws + WS_PDEN), glds + wave * ATT_LDS_PER_WAVE, bh >> 2, bh & 3, pat, pr / ppr, pr % ppr, m2, lane);
            }
        }
#endif
        GRID_BAR();
#ifndef SKIP_H3
        { CTX(); hgrn_h3_phase(lds, (const bf16_t*)(ws + WS_ACT), (const float*)(ws + WS_LB) + l * 512, (const bf16_t*)(ws + WS_ST), p.hng + l * 128, (bf16_t*)p.out, bid, G, tid, wave, lane); }
#endif
        STAMP();
        { CTX(); for (int m = gw; m < M_TOK; m += 4 * NGW) { if (m + 3 * NGW < M_TOK) { const int mm[4] = {m, m + NGW, m + 2 * NGW, m + 3 * NGW}; dil_merge_rows<4>((const bf16_t*)(ws + WS_PNUM), (const float*)(ws + WS_PDEN), (bf16_t*)p.out, mm, lane); }
            else for (int m1 = m; m1 < M_TOK; m1 += NGW) { const int mm[1] = {m1}; dil_merge_rows<1>((const bf16_t*)(ws + WS_PNUM), (const float*)(ws + WS_PDEN), (bf16_t*)p.out, mm, lane); } } }
        GRID_BAR();
        { CTX(); run_gemm(glds, (const bf16_t*)p.out, WLP(l) + WL_OUT / 2, D_MODEL, D_MODEL, pg8::EpiRes{0, l * 2 * NMOD + 5 * D_MODEL, l * 2 * NMOD + 7 * D_MODEL, l * 3 + 2, 1.0f, 0}); }
        GRID_BAR();
        { CTX(); run_gemm(glds, (const bf16_t*)(ws + WS_HB), WLP(l) + WL_GU2 / 2, 2 * D_FF, D_MODEL, pg8::EpiSwiGLU{D_FF, l * 3 + 2, l * 2 * SHW_N + 2 * D_FF + PW}); }
        GRID_BAR();
        { CTX(); run_gemm(glds, (const bf16_t*)(ws + WS_ACT), WLP(l) + WL_DN2 / 2, D_MODEL, D_FF, pg8::EpiRes{0, l * 2 * NMOD + 8 * D_MODEL, ((l + 1 < DEPTH) ? l + 1 : l) * 2 * NMOD + 1 * D_MODEL, (l + 1) * 3 + 0, 0.5f, (l + 1 == DEPTH) ? 1 : 0}); }
        GRID_BAR();
    }
#ifdef PROBE_MASK
    if (blockIdx.x == 0 && threadIdx.x == 0) {
        volatile LAS unsigned long long* ts = (volatile LAS unsigned long long*)(glds + 131072 + 256);
        unsigned long long sum = 0;
        for (int i = 0; i + 1 < ts_n; ++i) if ((PROBE_MASK >> i) & 1ull) sum += ts[i + 1] - ts[i];
        const unsigned long long target = __builtin_amdgcn_s_memrealtime() + 4ull * sum;
        while (__builtin_amdgcn_s_memrealtime() < target) __builtin_amdgcn_s_sleep(8);
    }
#endif
}

extern "C" void kernel_launch(void* const* d_in, const int* in_sizes, int n_in, void* d_out, int out_size, void* d_ws, size_t ws_size, hipStream_t stream) {
    static int grid = 0;
    if (grid == 0) {
        if (n_in != 16 || ws_size < WS_END) { fprintf(stderr, "kernel_launch: unexpected n_in %d / ws %zu\n", n_in, ws_size); grid = -1; return; }
        int dev = 0, cus = 0, per_cu = 0;
        hipGetDevice(&dev);
        hipDeviceGetAttribute(&cus, hipDeviceAttributeMultiprocessorCount, dev);
        if (hipFuncSetAttribute((const void*)fwd_kernel, hipFuncAttributeMaxDynamicSharedMemorySize, LDS_BYTES) != hipSuccess) { fprintf(stderr, "kernel_launch: hipFuncSetAttribute failed\n"); grid = -1; return; }
        if (hipOccupancyMaxActiveBlocksPerMultiprocessor(&per_cu, (const void*)fwd_kernel, 512, LDS_BYTES) != hipSuccess || per_cu < 1) { fprintf(stderr, "kernel_launch: occupancy query gave %d\n", per_cu); per_cu = 1; }
        (void)hipGetLastError();
        grid = cus * per_cu;
    }
    if (grid < 0) return;
    Params p{};
    p.x = (const float*)d_in[0]; p.c = (const float*)d_in[1]; p.w_mod = (const float*)d_in[2]; p.b_mod = (const float*)d_in[3];
    p.f1g = (const float*)d_in[4]; p.f1u = (const float*)d_in[5]; p.f1d = (const float*)d_in[6]; p.w_in = (const float*)d_in[7]; p.w_out = (const float*)d_in[8];
    p.qng = (const float*)d_in[9]; p.kng = (const float*)d_in[10]; p.hng = (const float*)d_in[11]; p.lbl = (const float*)d_in[12];
    p.f2g = (const float*)d_in[13]; p.f2u = (const float*)d_in[14]; p.f2d = (const float*)d_in[15];
    p.out = (float*)d_out; p.ws = (unsigned char*)d_ws;
    void* args[] = {&p};
    hipError_t e = hipLaunchCooperativeKernel((const void*)fwd_kernel, dim3(grid), dim3(512), args, LDS_BYTES, stream);
    if (e != hipSuccess) fprintf(stderr, "cooperative launch failed: %s (grid %d)\n", hipGetErrorString(e), grid);
}
```

```cpp
#include <hip/hip_runtime.h>
#include <hip/hip_cooperative_groups.h>
#include <cstdio>
#include <cstdint>
namespace cg = cooperative_groups;

typedef unsigned short bf16_t;
typedef short bf16x8 __attribute__((ext_vector_type(8)));
typedef _Float16 f16x8 __attribute__((ext_vector_type(8)));
typedef float f32x2 __attribute__((ext_vector_type(2)));
typedef float f32x4 __attribute__((ext_vector_type(4)));
typedef float f32x16 __attribute__((ext_vector_type(16)));
typedef unsigned u32x2 __attribute__((ext_vector_type(2)));
typedef unsigned u32x4 __attribute__((ext_vector_type(4)));
typedef __bf16 bf16x2_t __attribute__((ext_vector_type(2)));

#define DI __device__ __forceinline__
#define LAS __attribute__((address_space(3)))

constexpr int D_MODEL = 1024, BATCH = 2, SEQ = 16384, DEPTH = 2, D_FF = 2816;
constexpr int M_TOK = BATCH * SEQ;
constexpr int PW = 3584;
constexpr int C_QA = 0, C_KA = 256, C_VA = 512, C_QD = 768, C_KD = 1024, C_VD = 1280, C_QH = 1536, C_FH = 2048, C_IH = 2560, C_GH = 3072;
constexpr int NMOD = 9 * D_MODEL;
constexpr float EPS = 1e-6f;
constexpr float LOG2E = 1.4426950408889634f;
constexpr int NCHUNK = SEQ / 64;

constexpr size_t MiB = 1u << 20;
constexpr size_t W_GU = (size_t)2 * D_FF * D_MODEL * 2;
constexpr size_t W_DN = (size_t)D_MODEL * D_FF * 2;
constexpr size_t W_IN = (size_t)PW * D_MODEL * 2;
constexpr size_t W_OUT = (size_t)D_MODEL * D_MODEL * 2;
constexpr size_t WL_GU1 = 0, WL_DN1 = WL_GU1 + W_GU, WL_IN = WL_DN1 + W_DN, WL_OUT = WL_IN + W_IN, WL_GU2 = WL_OUT + W_OUT, WL_DN2 = WL_GU2 + W_GU, WL_SIZE = WL_DN2 + W_DN;
static_assert(WL_SIZE == 44040192, "weights per layer");
constexpr size_t WS_WEIGHTS = 0;
constexpr size_t WS_SMALL = 84 * MiB;
constexpr size_t WS_MOD = WS_SMALL, WS_LB = WS_SMALL + 256 * 1024, WS_BAR = WS_SMALL + 512 * 1024;
constexpr size_t WS_DEC = 85 * MiB;
constexpr size_t WS_HB = 86 * MiB;
constexpr size_t WS_PNUM = WS_HB;
constexpr size_t WS_PDEN = WS_HB + 48 * MiB;
constexpr size_t WS_ACT = 150 * MiB;
constexpr size_t WS_XB = 374 * MiB;
constexpr size_t WS_ST = 438 * MiB;
constexpr size_t WS_RS = 502 * MiB;
constexpr size_t WS_SHW = 503 * MiB;
constexpr int SHW_N = 2 * D_FF + PW + 2 * D_FF;
constexpr size_t WS_END = 504 * MiB;

DI unsigned pk2(float lo, float hi) { f32x2 v = {lo, hi}; bf16x2_t b = __builtin_convertvector(v, bf16x2_t); return __builtin_bit_cast(unsigned, b); }
DI float bf2f(bf16_t b) { return __uint_as_float((unsigned)b << 16); }
DI float bflo(unsigned u) { return __uint_as_float(u << 16); }
DI float bfhi(unsigned u) { return __uint_as_float(u & 0xffff0000u); }
DI int crow(int reg, int h) { return (reg & 3) + 8 * (reg >> 2) + 4 * h; }
DI int krow(int s, int h, int j) { return 16 * s + 8 * (j >> 2) + 4 * h + (j & 3); }
DI float fexp2(float x) { return __builtin_amdgcn_exp2f(x); }
DI float flog2(float x) { return __builtin_amdgcn_logf(x); }
DI float frcp(float x) { return __builtin_amdgcn_rcpf(x); }
DI float silu_f(float g) { return g * frcp(1.0f + fexp2(-g * LOG2E)); }
#define MFMA_BF16(a, b, c) __builtin_amdgcn_mfma_f32_32x32x16_bf16((a), (b), (c), 0, 0, 0)
#define MFMA_F16(a, b, c) __builtin_amdgcn_mfma_f32_32x32x16_f16((a), (b), (c), 0, 0, 0)
#define LDS_WAIT() asm volatile("s_waitcnt lgkmcnt(0)" ::: "memory")

struct Params {
    const float* x; const float* c; const float* w_mod; const float* b_mod;
    const float* f1g; const float* f1u; const float* f1d; const float* w_in; const float* w_out;
    const float* qng; const float* kng; const float* hng; const float* lbl;
    const float* f2g; const float* f2u; const float* f2d;
    float* out; unsigned char* ws;
};

#ifdef SKIP_GEMM
#define GEMMCALL pg8::gemm_dummy
#else
#define GEMMCALL pg8::gemm_phase
#endif
namespace pg8 {
#define PG8_LAS __attribute__((address_space(3)))
constexpr int BM = 256, BK = 64, HALF = 128, HTB = HALF * BK * 2  , STAGE_BYTES = 8 * HTB, NXCD = 8, WGM = 8;

__host__ __device__ __forceinline__ int lds_byte(int r, int c) { const int st = (r >> 4) * 2 + (c >> 5), rr = r & 15, cc = c & 31, ob = rr * 64 + cc * 2; return st * 1024 + (ob ^ (((ob >> 9) & 1) << 5)); }
__host__ __device__ __forceinline__ void stage_rc(int b, int& R, int& C) { const int st = b / 1024, sb = b % 1024, swz = sb ^ (((sb >> 9) & 1) << 5); R = (st >> 1) * 16 + swz / 64; C = (st & 1) * 32 + (swz % 64) / 2; }
__host__ __device__ __forceinline__ int perm32(int rho) { const int n = rho >> 4, i = rho & 15; return 8 * (i >> 2) + 4 * n + (i & 3); }

struct Unit { int pm, pn; };
struct Gemm { const bf16_t* A; const bf16_t* Bt; int M, N, K; };

struct StaticOrder {
    int nM, nN, nwg, G, c;
    __host__ __device__ void init(int M, int N, int G_, int c_) { nM = M / BM; nN = N / BM; nwg = nM * nN; G = G_; c = c_; }
    __host__ __device__ bool next(int i, Unit& u) const {
        const long L = (long)i * G + c; if (L >= nwg) return false;
        int wgid = (int)L; { const int q = nwg / NXCD, r = nwg % NXCD, xcd = wgid % NXCD, off = wgid / NXCD; wgid = (xcd < r ? xcd * (q + 1) : r * (q + 1) + (xcd - r) * q) + off; }
        const int nig = WGM * nN, gid = wgid / nig, fm = gid * WGM, gsz = (nM - fm) < WGM ? (nM - fm) : WGM;
        u.pm = fm + ((wgid % nig) % gsz); u.pn = (wgid % nig) / gsz; return true;
    }
    __device__ __forceinline__ void a_ready(const Unit&) const {}
    __device__ __forceinline__ void done(const Unit&) const {}
};

#define EPI_PARAMS() const __attribute__((address_space(4))) Params* kq_ = (const __attribute__((address_space(4))) Params*)__builtin_amdgcn_kernarg_segment_ptr(); asm volatile("" : "+s"(kq_)); \
    unsigned char* const ws = kq_->ws
__device__ __forceinline__ float row_rs(const float* rowss, int row) { return 1.0f / sqrtf(rowss[row] * (1.0f / D_MODEL) + EPS); }
struct EpiBf16 {
    static constexpr bool PERM = true, AFTER_DRAIN = false;
    int ldc, rs_idx, shw_off  ;
    __device__ __forceinline__ void operator()(const f32x4 (&acc)[2][2][4][2], const Unit& u, int wr, int wc, int fr, int fq) const {
        EPI_PARAMS();
        bf16_t* O = (bf16_t*)(ws + WS_ACT); const float* rowss = (const float*)(ws + WS_RS) + (size_t)rs_idx * M_TOK; const float* shw = (const float*)(ws + WS_SHW) + shw_off;
        const int row0 = u.pm * BM + wr * 64 + fr; const int col0 = u.pn * BM + wc * 32 + 8 * fq;
        const float* sp = shw + (size_t)((u.pm * BM) / SEQ) * SHW_N + col0;
        f32x4 sv[2][2];
#pragma unroll
        for (int bj = 0; bj < 2; ++bj)
#pragma unroll
            for (int n = 0; n < 2; ++n) sv[bj][n] = *(const f32x4*)(sp + bj * HALF + 4 * n);
        float rsv[2][4];
#pragma unroll
        for (int ai = 0; ai < 2; ++ai)
#pragma unroll
            for (int m = 0; m < 4; ++m) rsv[ai][m] = rowss[row0 + ai * HALF + m * 16];
#pragma unroll
        for (int ai = 0; ai < 2; ++ai)
#pragma unroll
            for (int m = 0; m < 4; ++m) { const int row = row0 + ai * HALF + m * 16; bf16_t* rowp = O + (size_t)row * ldc + col0; const float rs = 1.0f / sqrtf(rsv[ai][m] * (1.0f / D_MODEL) + EPS);
#pragma unroll
                for (int bj = 0; bj < 2; ++bj) { const f32x4 v0 = acc[ai][bj][m][0] * rs + sv[bj][0], v1 = acc[ai][bj][m][1] * rs + sv[bj][1];
                    u32x4 w; w.x = pk2(v0[0], v0[1]); w.y = pk2(v0[2], v0[3]); w.z = pk2(v1[0], v1[1]); w.w = pk2(v1[2], v1[3]);
                    *(u32x4*)(rowp + bj * HALF) = w; } }
    }
};
struct EpiSwiGLU {
    static constexpr bool PERM = true, AFTER_DRAIN = false;
    int ldc, rs_idx, shw_off;
    __device__ __forceinline__ void operator()(const f32x4 (&acc)[2][2][4][2], const Unit& u, int wr, int wc, int fr, int fq) const {
        EPI_PARAMS();
        bf16_t* O = (bf16_t*)(ws + WS_ACT); const float* rowss = (const float*)(ws + WS_RS) + (size_t)rs_idx * M_TOK; const float* shw = (const float*)(ws + WS_SHW) + shw_off;
        const int row0 = u.pm * BM + wr * 64 + fr; const int col0 = u.pn * HALF + wc * 32 + 8 * fq;
        const float* sp = shw + (size_t)((u.pm * BM) / SEQ) * SHW_N + u.pn * BM + wc * 32 + 8 * fq;
        f32x4 sv[2][2];
#pragma unroll
        for (int bj = 0; bj < 2; ++bj)
#pragma unroll
            for (int n = 0; n < 2; ++n) sv[bj][n] = *(const f32x4*)(sp + bj * HALF + 4 * n);
        float rsv[2][4];
#pragma unroll
        for (int ai = 0; ai < 2; ++ai)
#pragma unroll
            for (int m = 0; m < 4; ++m) rsv[ai][m] = rowss[row0 + ai * HALF + m * 16];
#pragma unroll
        for (int ai = 0; ai < 2; ++ai)
#pragma unroll
            for (int m = 0; m < 4; ++m) { const int row = row0 + ai * HALF + m * 16; bf16_t* rowp = O + (size_t)row * ldc + col0; const float rs = 1.0f / sqrtf(rsv[ai][m] * (1.0f / D_MODEL) + EPS);
                const f32x4 g0 = acc[ai][0][m][0] * rs + sv[0][0], g1 = acc[ai][0][m][1] * rs + sv[0][1], u0 = acc[ai][1][m][0] * rs + sv[1][0], u1 = acc[ai][1][m][1] * rs + sv[1][1];
                float r[8];
#pragma unroll
                for (int e = 0; e < 4; ++e) { r[e] = silu_f(g0[e]) * u0[e]; r[4 + e] = silu_f(g1[e]) * u1[e]; }
                u32x4 w; w.x = pk2(r[0], r[1]); w.y = pk2(r[2], r[3]); w.z = pk2(r[4], r[5]); w.w = pk2(r[6], r[7]);
                *(u32x4*)rowp = w; }
    }
};
struct EpiRes {
    static constexpr bool PERM = true, AFTER_DRAIN = false;
    int x_is_input, gate_off  , scn_off, rs_idx; float coef; int is_last;
    __device__ __forceinline__ void operator()(const f32x4 (&acc)[2][2][4][2], const Unit& u, int wr, int wc, int fr, int fq) const {
        EPI_PARAMS();
        float* Out = kq_->out; const float* X = kq_->x; bf16_t* XB = (bf16_t*)(ws + WS_XB);
        bf16_t* HB = (bf16_t*)(ws + WS_HB); float* rowss = (float*)(ws + WS_RS) + (size_t)rs_idx * M_TOK;
        const int row0 = u.pm * BM + wr * 64 + fr; const int col0 = u.pn * BM + wc * 32 + 8 * fq;
        const int b = (u.pm * BM) / SEQ;
        const float* gp = (const float*)(ws + WS_MOD) + gate_off + (size_t)b * NMOD + col0;
        const float* scp = (const float*)(ws + WS_MOD) + scn_off + (size_t)b * NMOD + col0;
        f32x4 gv[2][2], sc[2][2];
#pragma unroll
        for (int bj = 0; bj < 2; ++bj)
#pragma unroll
            for (int n = 0; n < 2; ++n) { gv[bj][n] = *(const f32x4*)(gp + bj * HALF + 4 * n) * coef; sc[bj][n] = *(const f32x4*)(scp + bj * HALF + 4 * n) + 1.0f; }
        const int lane = threadIdx.x & 63;
#pragma unroll
        for (int ai = 0; ai < 2; ++ai) {
            u32x4 xraw[4][2];
            if (!x_is_input) {
#pragma unroll
                for (int m = 0; m < 4; ++m) { const size_t ro = (size_t)(row0 + ai * HALF + m * 16) * D_MODEL + col0;
#pragma unroll
                    for (int bj = 0; bj < 2; ++bj) xraw[m][bj] = *(const u32x4*)(XB + ro + bj * HALF); }
            }
#pragma unroll
            for (int m = 0; m < 4; ++m) { const int row = row0 + ai * HALF + m * 16; const size_t ro = (size_t)row * D_MODEL + col0;
                float ssq = 0.f;
#pragma unroll
                for (int bj = 0; bj < 2; ++bj) {
                    f32x4 xn[2];
                    f32x4 xv[2];
                    if (x_is_input) { xv[0] = *(const f32x4*)(X + ro + bj * HALF); xv[1] = *(const f32x4*)(X + ro + bj * HALF + 4); }
                    else { const u32x4 xw = xraw[m][bj]; xv[0] = (f32x4){bflo(xw.x), bfhi(xw.x), bflo(xw.y), bfhi(xw.y)}; xv[1] = (f32x4){bflo(xw.z), bfhi(xw.z), bflo(xw.w), bfhi(xw.w)}; }
#pragma unroll
                    for (int n = 0; n < 2; ++n) xn[n] = xv[n] + gv[bj][n] * acc[ai][bj][m][n];
                    if (is_last) { *(f32x4*)(Out + ro + bj * HALF) = xn[0]; *(f32x4*)(Out + ro + bj * HALF + 4) = xn[1]; }
                    else { u32x4 xo; xo.x = pk2(xn[0][0], xn[0][1]); xo.y = pk2(xn[0][2], xn[0][3]); xo.z = pk2(xn[1][0], xn[1][1]); xo.w = pk2(xn[1][2], xn[1][3]); *(u32x4*)(XB + ro + bj * HALF) = xo; }
                    ssq += (xn[0][0] * xn[0][0] + xn[0][1] * xn[0][1]) + (xn[0][2] * xn[0][2] + xn[0][3] * xn[0][3]) + (xn[1][0] * xn[1][0] + xn[1][1] * xn[1][1]) + (xn[1][2] * xn[1][2] + xn[1][3] * xn[1][3]);
                    const f32x4 h0 = xn[0] * sc[bj][0], h1 = xn[1] * sc[bj][1];
                    u32x4 w; w.x = pk2(h0[0], h0[1]); w.y = pk2(h0[2], h0[3]); w.z = pk2(h1[0], h1[1]); w.w = pk2(h1[2], h1[3]);
                    *(u32x4*)(HB + ro + bj * HALF) = w;
                }
                ssq += __int_as_float(__builtin_amdgcn_ds_bpermute((lane ^ 16) << 2, __float_as_int(ssq)));
                ssq += __int_as_float(__builtin_amdgcn_ds_bpermute((lane ^ 32) << 2, __float_as_int(ssq)));
                if (fq == 0) atomicAdd(rowss + row, ssq);
            }
        }
    }
};

template <class Epi, class Sched, bool ALIGN_EPI = false, bool SP2 = false>
__device__ __forceinline__ void gemm_phase(PG8_LAS unsigned char* lds, const Gemm g, const Sched& S, const Epi& E) {
    int tid_ = threadIdx.x; asm volatile("" : "+v"(tid_));
    const int tid = tid_, wid = __builtin_amdgcn_readfirstlane(tid >> 6), lane = tid & 63, wr = wid >> 2, wc = wid & 3, fr = lane & 15, fq = lane >> 4;
    const int K = g.K, nt = K / BK;
    unsigned voffA[2], voffB[2];
#pragma unroll
    for (int i = 0; i < 2; ++i) { int R, C; stage_rc(tid * 16 + i * 8192, R, C); const int Rb = Epi::PERM ? ((R & ~31) + perm32(R & 31)) : R;
        voffA[i] = (unsigned)(R * K + C) * 2u; voffB[i] = (unsigned)(Rb * K + C) * 2u; }
    const size_t kstep = (size_t)(BK * 2);
    const size_t hstep = (size_t)HALF * K * 2;
    const size_t tstep = 2 * hstep;
    const unsigned ldsw = (unsigned)wid * 1024u;
    const int aoff = lds_byte(wr * 64 + fr, fq * 8), boff = lds_byte(wc * 32 + fr, fq * 8);
#define PG8_SA(b, h) (((b) * 2 + (h)) * HTB)
#define PG8_SB(b, h) ((4 + (b) * 2 + (h)) * HTB)
#define PG8_STAGE(bufoff, gbase, voff) do { _Pragma("unroll") for (int _i = 0; _i < 2; ++_i) \
        __builtin_amdgcn_global_load_lds((const unsigned*)((const char*)(gbase) + (voff)[_i]), (PG8_LAS unsigned*)(lds + (bufoff) + ldsw + _i * 8192), 16, 0, 0); } while (0)
#define PG8_LDA(dst, b, h) do { _Pragma("unroll") for (int m = 0; m < 4; ++m) _Pragma("unroll") for (int k = 0; k < 2; ++k) dst[m][k] = *(const PG8_LAS bf16x8*)(lds + PG8_SA(b, h) + aoff + m * 2048 + k * 1024); } while (0)
#define PG8_LDB(dst, b, h) do { _Pragma("unroll") for (int n = 0; n < 2; ++n) _Pragma("unroll") for (int k = 0; k < 2; ++k) dst[n][k] = *(const PG8_LAS bf16x8*)(lds + PG8_SB(b, h) + boff + n * 2048 + k * 1024); } while (0)
#define PG8_MMA(ai, bj, At, Bt) do { __builtin_amdgcn_s_setprio(1); _Pragma("unroll") for (int m = 0; m < 4; ++m) _Pragma("unroll") for (int n = 0; n < 2; ++n) _Pragma("unroll") for (int k = 0; k < 2; ++k) \
        acc[ai][bj][m][n] = __builtin_amdgcn_mfma_f32_16x16x32_bf16(Bt[n][k], At[m][k], acc[ai][bj][m][n], 0, 0, 0); __builtin_amdgcn_s_setprio(0); } while (0)
#define PG8_WAIT_V(n) asm volatile("s_waitcnt vmcnt(" #n ")" ::: "memory")
#define PG8_WAIT_L(n) asm volatile("s_waitcnt lgkmcnt(" #n ")" ::: "memory")
#define PG8_BAR __builtin_amdgcn_s_barrier()
#define PG8_SCHED __builtin_amdgcn_sched_barrier(0)
    Unit cur, nxt; int ui = 0;
    if (!S.next(0, cur)) return;
    f32x4 acc[2][2][4][2];
#pragma unroll
    for (int a = 0; a < 2; ++a)
#pragma unroll
        for (int b = 0; b < 2; ++b)
#pragma unroll
            for (int m = 0; m < 4; ++m)
#pragma unroll
                for (int n = 0; n < 2; ++n) acc[a][b][m][n] = (f32x4){0.f, 0.f, 0.f, 0.f};
    bf16x8 At[4][2], B0[2][2], B1[2][2];
    const char* cA = (const char*)g.A + (size_t)cur.pm * tstep; const char* cB = (const char*)g.Bt + (size_t)cur.pn * tstep;
    S.a_ready(cur);
    if constexpr (SP2) {
        PG8_STAGE(PG8_SB(0, 0), cB, voffB); PG8_STAGE(PG8_SB(0, 1), cB + hstep, voffB); PG8_STAGE(PG8_SA(0, 0), cA, voffA); PG8_STAGE(PG8_SA(0, 1), cA + hstep, voffA);
        if (wr == 1) PG8_BAR;
        PG8_WAIT_V(2); PG8_BAR;
        PG8_STAGE(PG8_SB(1, 0), cB + kstep, voffB); PG8_STAGE(PG8_SA(1, 0), cA + kstep, voffA); PG8_STAGE(PG8_SB(1, 1), cB + hstep + kstep, voffB);
        PG8_WAIT_V(6); PG8_BAR;
    } else {
        PG8_STAGE(PG8_SB(0, 0), cB, voffB); PG8_STAGE(PG8_SA(0, 0), cA, voffA); PG8_STAGE(PG8_SB(0, 1), cB + hstep, voffB); PG8_STAGE(PG8_SA(0, 1), cA + hstep, voffA);
        if (wr == 1) PG8_BAR;
        PG8_WAIT_V(4); PG8_BAR;
        PG8_STAGE(PG8_SB(1, 0), cB + kstep, voffB); PG8_STAGE(PG8_SA(1, 0), cA + kstep, voffA); PG8_STAGE(PG8_SB(1, 1), cB + hstep + kstep, voffB);
        PG8_WAIT_V(6); PG8_BAR;
    }
    for (;;) {
        const bool has_next = S.next(ui + 1, nxt);
        const char* nA = has_next ? (const char*)g.A + (size_t)nxt.pm * tstep : cA; const char* nB = has_next ? (const char*)g.Bt + (size_t)nxt.pn * tstep : cB;
        for (int t = 0; t < nt; t += 2) {
            const bool last = (t == nt - 2);
            const char* a1 = cA + (size_t)(t + 1) * kstep;
            const char* a2 = last ? nA : cA + (size_t)(t + 2) * kstep; const char* b2 = last ? nB : cB + (size_t)(t + 2) * kstep;
            const char* a3 = a2 + kstep; const char* b3 = b2 + kstep;
            if (last && has_next) S.a_ready(nxt);
            if constexpr (SP2) {
            PG8_LDB(B0, 0, 0); PG8_LDB(B1, 0, 1); PG8_SCHED; PG8_LDA(At, 0, 0); PG8_STAGE(PG8_SA(1, 1), a1 + hstep, voffA);
            PG8_WAIT_V(8); PG8_WAIT_L(0); PG8_BAR; PG8_MMA(0, 0, At, B0); PG8_MMA(0, 1, At, B1); PG8_BAR; PG8_SCHED;
            PG8_LDA(At, 0, 1); PG8_STAGE(PG8_SB(0, 0), b2, voffB); PG8_STAGE(PG8_SB(0, 1), b2 + hstep, voffB); PG8_STAGE(PG8_SA(0, 0), a2, voffA);
            PG8_WAIT_V(8); PG8_WAIT_L(0); PG8_BAR; PG8_MMA(1, 0, At, B0); PG8_MMA(1, 1, At, B1); PG8_BAR; PG8_SCHED;
            PG8_LDB(B0, 1, 0); PG8_LDB(B1, 1, 1); PG8_SCHED; PG8_LDA(At, 1, 0); PG8_STAGE(PG8_SA(0, 1), a2 + hstep, voffA);
            PG8_WAIT_V(8); PG8_WAIT_L(0); PG8_BAR; PG8_MMA(0, 0, At, B0); PG8_MMA(0, 1, At, B1); PG8_BAR; PG8_SCHED;
            PG8_LDA(At, 1, 1); PG8_STAGE(PG8_SB(1, 0), b3, voffB); PG8_STAGE(PG8_SB(1, 1), b3 + hstep, voffB); PG8_STAGE(PG8_SA(1, 0), a3, voffA);
            PG8_WAIT_V(8); PG8_WAIT_L(0); PG8_BAR; PG8_MMA(1, 0, At, B0); PG8_MMA(1, 1, At, B1); PG8_BAR; PG8_SCHED;
            } else {
            PG8_LDB(B0, 0, 0); PG8_SCHED; PG8_LDA(At, 0, 0); PG8_STAGE(PG8_SA(1, 1), a1 + hstep, voffA);
            PG8_WAIT_L(8); PG8_BAR; PG8_WAIT_L(0); PG8_MMA(0, 0, At, B0); PG8_BAR; PG8_SCHED;
            PG8_LDB(B1, 0, 1); PG8_STAGE(PG8_SB(0, 0), b2, voffB);
            PG8_BAR; PG8_WAIT_L(0); PG8_MMA(0, 1, At, B1); PG8_BAR;
            PG8_LDA(At, 0, 1); PG8_STAGE(PG8_SA(0, 0), a2, voffA);
            PG8_BAR; PG8_WAIT_L(0); PG8_MMA(1, 0, At, B0); PG8_BAR; PG8_SCHED;
            PG8_STAGE(PG8_SB(0, 1), b2 + hstep, voffB);
            PG8_WAIT_V(6); PG8_BAR; PG8_MMA(1, 1, At, B1); PG8_BAR;
            PG8_LDB(B0, 1, 0); PG8_SCHED; PG8_LDA(At, 1, 0); PG8_STAGE(PG8_SA(0, 1), a2 + hstep, voffA);
            PG8_WAIT_L(8); PG8_BAR; PG8_WAIT_L(0); PG8_MMA(0, 0, At, B0); PG8_BAR; PG8_SCHED;
            PG8_LDB(B1, 1, 1); PG8_STAGE(PG8_SB(1, 0), b3, voffB);
            PG8_BAR; PG8_WAIT_L(0); PG8_MMA(0, 1, At, B1); PG8_BAR;
            PG8_LDA(At, 1, 1); PG8_STAGE(PG8_SA(1, 0), a3, voffA);
            PG8_BAR; PG8_WAIT_L(0); PG8_MMA(1, 0, At, B0); PG8_BAR; PG8_SCHED;
            PG8_STAGE(PG8_SB(1, 1), b3 + hstep, voffB);
            PG8_WAIT_V(6); PG8_BAR; PG8_MMA(1, 1, At, B1); PG8_BAR;
            }
        }
        if constexpr (ALIGN_EPI) { if (wr == 0) PG8_BAR; }
        if constexpr (!Epi::AFTER_DRAIN) { E(acc, cur, wr, wc, fr, fq); S.done(cur); }
        if (!has_next) break;
#pragma unroll
        for (int a = 0; a < 2; ++a)
#pragma unroll
            for (int b = 0; b < 2; ++b)
#pragma unroll
                for (int m = 0; m < 4; ++m)
#pragma unroll
                    for (int n = 0; n < 2; ++n) acc[a][b][m][n] = (f32x4){0.f, 0.f, 0.f, 0.f};
        cur = nxt; cA = nA; cB = nB; ++ui;
        if constexpr (ALIGN_EPI) { if (wr == 1) PG8_BAR; }
    }
    PG8_WAIT_V(0);
    if constexpr (!ALIGN_EPI) { if (wr == 0) PG8_BAR; }
    PG8_BAR;
#undef PG8_SA
#undef PG8_SB
#undef PG8_STAGE
#undef PG8_LDA
#undef PG8_LDB
#undef PG8_MMA
#undef PG8_WAIT_V
#undef PG8_WAIT_L
#undef PG8_BAR
#undef PG8_SCHED
}
template <class Epi, class Sched, bool A=false, bool B=false> __device__ __forceinline__ void gemm_dummy(PG8_LAS unsigned char* lds, const Gemm g, const Sched& S, const Epi& E) {}
}

constexpr bool G_ALIGN = true, G_SP2 = true;
constexpr int LDS_BYTES = 147456, LDS_MISC = 131072 + 64;


template <class T> DI T* lau(T* p) { asm volatile("" : "+s"(p)); return p; }
DI float shx(float v, int o, int lane) { return __int_as_float(__builtin_amdgcn_ds_bpermute((lane ^ o) << 2, __float_as_int(v))); }
DI float wave_sum(float v, int lane) {
#pragma unroll
    for (int o = 1; o < 64; o <<= 1) v += shx(v, o, lane);
    return v;
}


#define XB_TMO      128
#define XB_XCNT(j)  (256  + 64 * (j))
#define XB_XSUB(j)  (1280 + 64 * (j))
#define XB_XGEN(j)  (2304 + 64 * (j))
#define XB_TOP      3328
#define XB_TOPGEN   3392
#define XCD_BAR_WORDS 3456
#define XB_SPIN_CAP (1u << 21)
DI unsigned xb_ld(unsigned* p)              { return __hip_atomic_load(p, __ATOMIC_RELAXED, __HIP_MEMORY_SCOPE_AGENT); }
DI unsigned xb_add(unsigned* p, unsigned v) { return __hip_atomic_fetch_add(p, v, __ATOMIC_RELAXED, __HIP_MEMORY_SCOPE_AGENT); }
DI unsigned xb_xcc_id() { return (unsigned)__builtin_amdgcn_s_getreg((3 << 11) | 20) & 0xFu; }
#define XB_SPIN(cond, bar) do { unsigned _sp = 0; while (cond) { __builtin_amdgcn_s_sleep(1); \
    if ((++_sp & 255u) == 0u) { if (xb_ld(&(bar)[XB_TMO])) break; if (_sp > XB_SPIN_CAP) { atomicAdd(&(bar)[XB_TMO], 1u); break; } } } } while (0)
struct XcdBarrier { unsigned* bar; unsigned x; volatile LAS unsigned* st; };
DI void xcd_barrier_complete(unsigned* bar, unsigned x, unsigned& nloc, unsigned& nx) {
    const unsigned G = gridDim.x * gridDim.y * gridDim.z;
    unsigned sum, cnt, mine, sp = 0u;
    for (;;) {
        sum = 0u; cnt = 0u; mine = 0u;
#pragma unroll
        for (unsigned j = 0; j < 16; ++j) { const unsigned c = xb_ld(&bar[XB_XCNT(j)]); sum += c; cnt += (c > 0u) ? 1u : 0u; mine = (j == x) ? c : mine; }
        if (sum == G) break;
        __builtin_amdgcn_s_sleep(1);
        if ((++sp & 255u) == 0u) { if (xb_ld(&bar[XB_TMO])) break; if (sp > XB_SPIN_CAP) { atomicAdd(&bar[XB_TMO], 1u); break; } }
    }
    nloc = mine > 0u ? mine : 1u; nx = cnt > 0u ? cnt : 1u;
}
DI void xcd_barrier(const XcdBarrier& b) {
    asm volatile("s_waitcnt vmcnt(0)" ::: "memory");
    __syncthreads();
    if (threadIdx.x == 0) {
        unsigned* bar = b.bar;
        __builtin_amdgcn_s_waitcnt(0);
        unsigned nloc = b.st[0], nx = b.st[1];
        if (nloc == 0u) { xcd_barrier_complete(bar, b.x, nloc, nx); b.st[0] = nloc; b.st[1] = nx; }
        const unsigned old = xb_add(&bar[XB_XSUB(b.x)], 1u);
        const unsigned gen = old / nloc;
        if (old + 1u == (gen + 1u) * nloc) {
            __builtin_amdgcn_fence(__ATOMIC_RELEASE, "agent");
            asm volatile("s_waitcnt vmcnt(0)" ::: "memory");
            const unsigned og = xb_add(&bar[XB_TOP], 1u);
            const unsigned tg = og / nx;
            if (og + 1u == (tg + 1u) * nx) xb_add(&bar[XB_TOPGEN], 1u);
            else XB_SPIN(xb_ld(&bar[XB_TOPGEN]) == tg, bar);
            __builtin_amdgcn_fence(__ATOMIC_ACQUIRE, "agent");
            xb_add(&bar[XB_XGEN(b.x)], 1u);
            asm volatile("s_waitcnt vmcnt(0)" ::: "memory");
        } else {
            XB_SPIN(xb_ld(&bar[XB_XGEN(b.x)]) == gen, bar);
            __builtin_amdgcn_fence(__ATOMIC_ACQUIRE, "agent");
            asm volatile("s_waitcnt vmcnt(0)" ::: "memory");
        }
    }
    __syncthreads();
}

DI void transpose_item(const float* W, int K, int N, bf16_t* WT, int mode, float* scr, int item, int lane) {
    const int nblk = N / 32, kb = item / nblk, nb = item % nblk, k0 = 64 * kb, n0 = 32 * nb;
    const int drow0 = (mode == 0) ? n0 : ((n0 >> 7) * 256 + (n0 & 127) + (mode == 2 ? 128 : 0));
    { const int kr = lane >> 3, c4 = lane & 7; f32x4 v[8];
#pragma unroll
      for (int i = 0; i < 8; ++i) v[i] = *(const f32x4*)(W + (size_t)(k0 + 8 * i + kr) * N + n0 + 4 * c4);
#pragma unroll
      for (int i = 0; i < 8; ++i) { float* d = scr + (8 * i + kr) * 33 + 4 * c4; d[0] = v[i].x; d[1] = v[i].y; d[2] = v[i].z; d[3] = v[i].w; } }
    LDS_WAIT(); asm volatile("" ::: "memory");
    const int cch = lane & 7;
#pragma unroll
    for (int j = 0; j < 4; ++j) { const int n = (lane >> 3) + 8 * j; const float* s = scr + (8 * cch) * 33 + n;
        u32x4 o; o.x = pk2(s[0 * 33], s[1 * 33]); o.y = pk2(s[2 * 33], s[3 * 33]); o.z = pk2(s[4 * 33], s[5 * 33]); o.w = pk2(s[6 * 33], s[7 * 33]);
        *(u32x4*)(WT + (size_t)(drow0 + n) * K + k0 + 8 * cch) = o; }
    LDS_WAIT(); asm volatile("" ::: "memory");
}

template <class PT> DI void phase_prep(const PT& p, unsigned char* lds, int gw, int NGW, int wave, int lane) {
    float* scr = (float*)(lds + wave * 16384);
    constexpr int I_G = (D_MODEL / 64) * (D_FF / 32);
    constexpr int I_D = (D_FF / 64) * (D_MODEL / 32);
    constexpr int I_IN = (D_MODEL / 64) * (PW / 32);
    constexpr int I_OUT = (D_MODEL / 64) * (D_MODEL / 32);
    constexpr int I_LAYER = 4 * I_G + 2 * I_D + I_IN + I_OUT;
    constexpr int I_MOD = 0;
    constexpr int NITEMS = I_MOD + 1 + DEPTH * I_LAYER;
    {
        float* sc = (float*)lds; float* red = (float*)(lds + 8192);
        const int tid = wave * 64 + lane;
        for (int k = tid; k < 2 * D_MODEL; k += 512) sc[k] = silu_f(p.c[k]);
        __syncthreads();
        const int G = NGW / 8, bid = gw % G;
        for (int u = bid; u < DEPTH * (NMOD / 32); u += G) {
            const int l = u / (NMOD / 32), n = (u % (NMOD / 32)) * 32 + (lane & 31), kp = wave * 2 + (lane >> 5);
            const float* W = p.w_mod + (size_t)l * D_MODEL * NMOD + (size_t)(kp * 64) * NMOD + n;
            float a0 = 0.f, a1 = 0.f;
#pragma unroll 16
            for (int k = 0; k < 64; ++k) { const float w = W[(size_t)k * NMOD]; a0 += sc[kp * 64 + k] * w; a1 += sc[D_MODEL + kp * 64 + k] * w; }
            red[(kp * 2 + 0) * 32 + (lane & 31)] = a0; red[(kp * 2 + 1) * 32 + (lane & 31)] = a1;
            __syncthreads();
            if (tid < 64) { const int col = tid & 31, b = tid >> 5; float sum = 0.f;
#pragma unroll
                for (int j = 0; j < 16; ++j) sum += red[(j * 2 + b) * 32 + col];
                const int nn = (u % (NMOD / 32)) * 32 + col;
                ((float*)(p.ws + WS_MOD))[(l * 2 + b) * NMOD + nn] = sum + p.b_mod[l * NMOD + nn]; }
            __syncthreads();
        }
    }
    for (int it = gw; it < NITEMS; it += NGW) {
        if (it == I_MOD) {
            float* lb = (float*)(p.ws + WS_LB);
            for (int i = lane; i < 512; i += 64) { const float l0 = p.lbl[i], l1 = p.lbl[512 + i]; const float mx = fmaxf(l0, l1);
                const float e0 = __expf(l0 - mx), e1 = __expf(l1 - mx); const float s0 = e0 / (e0 + e1), s1 = e1 / (e0 + e1);
                lb[i] = fminf(fmaxf(s0 - s0, 0.f), 1.0f - EPS); lb[512 + i] = fminf(fmaxf((s0 + s1) - s0, 0.f), 1.0f - EPS); }
            continue;
        }
        int r = it - I_MOD - 1; const int l = r / I_LAYER; r -= l * I_LAYER;
        bf16_t* wl = (bf16_t*)(p.ws + WS_WEIGHTS + (size_t)l * WL_SIZE);
        const size_t o_gu = (size_t)l * D_MODEL * D_FF, o_in = (size_t)l * D_MODEL * PW, o_out = (size_t)l * D_MODEL * D_MODEL;
        if (r < I_G) { transpose_item(p.f1g + o_gu, D_MODEL, D_FF, wl + WL_GU1 / 2, 1, scr, r, lane); continue; } r -= I_G;
        if (r < I_G) { transpose_item(p.f1u + o_gu, D_MODEL, D_FF, wl + WL_GU1 / 2, 2, scr, r, lane); continue; } r -= I_G;
        if (r < I_D) { transpose_item(p.f1d + o_gu, D_FF, D_MODEL, wl + WL_DN1 / 2, 0, scr, r, lane); continue; } r -= I_D;
        if (r < I_IN) { transpose_item(p.w_in + o_in, D_MODEL, PW, wl + WL_IN / 2, 0, scr, r, lane); continue; } r -= I_IN;
        if (r < I_OUT) { transpose_item(p.w_out + o_out, D_MODEL, D_MODEL, wl + WL_OUT / 2, 0, scr, r, lane); continue; } r -= I_OUT;
        if (r < I_G) { transpose_item(p.f2g + o_gu, D_MODEL, D_FF, wl + WL_GU2 / 2, 1, scr, r, lane); continue; } r -= I_G;
        if (r < I_G) { transpose_item(p.f2u + o_gu, D_MODEL, D_FF, wl + WL_GU2 / 2, 2, scr, r, lane); continue; } r -= I_G;
        transpose_item(p.f2d + o_gu, D_FF, D_MODEL, wl + WL_DN2 / 2, 0, scr, r, lane);
    }
}


template <class PT> DI void phase_prep2(const PT& p, unsigned char* ws, int gw, int NGW, int lane) {
    const float* mod = (const float*)(ws + WS_MOD);
    float* SHW = (float*)(ws + WS_SHW);
    for (int it0 = gw; it0 < DEPTH * SHW_N; it0 += 4 * NGW) {
        u32x4 w[4][2]; const float* shp[4]; int idx[4]; bool ok[4];
#pragma unroll
        for (int k = 0; k < 4; ++k) {
            const int it = it0 + k * NGW; ok[k] = it < DEPTH * SHW_N; const int itc = ok[k] ? it : it0;
            const int l = itc / SHW_N, j = itc % SHW_N;
            const bf16_t* wl = (const bf16_t*)(ws + WS_WEIGHTS + (size_t)l * WL_SIZE); const bf16_t* row; int shsel;
            if (j < 2 * D_FF) { row = wl + WL_GU1 / 2 + (size_t)j * D_MODEL; shsel = 0; }
            else if (j < 2 * D_FF + PW) { row = wl + WL_IN / 2 + (size_t)(j - 2 * D_FF) * D_MODEL; shsel = 3; }
            else { row = wl + WL_GU2 / 2 + (size_t)(j - 2 * D_FF - PW) * D_MODEL; shsel = 6; }
            shp[k] = mod + (size_t)(l * 2) * NMOD + shsel * D_MODEL; idx[k] = l * 2 * SHW_N + j;
            w[k][0] = *(const u32x4*)(row + 8 * lane); w[k][1] = *(const u32x4*)(row + 512 + 8 * lane);
        }
        float r0[4], r1[4];
#pragma unroll
        for (int k = 0; k < 4; ++k) {
            float a0 = 0.f, a1 = 0.f;
#pragma unroll
            for (int h = 0; h < 2; ++h) { const int k0 = h * 512 + 8 * lane; const u32x4 ww = w[k][h];
                const float wv[8] = {bflo(ww.x), bfhi(ww.x), bflo(ww.y), bfhi(ww.y), bflo(ww.z), bfhi(ww.z), bflo(ww.w), bfhi(ww.w)};
                const float* sh0 = shp[k]; const float* sh1 = sh0 + NMOD;
                const f32x4 s00 = *(const f32x4*)(sh0 + k0), s01 = *(const f32x4*)(sh0 + k0 + 4), s10 = *(const f32x4*)(sh1 + k0), s11 = *(const f32x4*)(sh1 + k0 + 4);
#pragma unroll
                for (int e = 0; e < 4; ++e) { a0 += wv[e] * s00[e] + wv[4 + e] * s01[e]; a1 += wv[e] * s10[e] + wv[4 + e] * s11[e]; } }
            r0[k] = wave_sum(a0, lane); r1[k] = wave_sum(a1, lane);
        }
#pragma unroll
        for (int k = 0; k < 4; ++k) if (ok[k] && lane == 0) { SHW[idx[k]] = r0[k]; SHW[idx[k] + SHW_N] = r1[k]; }
    }
    bf16_t* HB = (bf16_t*)(ws + WS_HB); float* RS = (float*)(ws + WS_RS);
    for (int m0 = gw; m0 < M_TOK; m0 += 4 * NGW) {
        f32x4 v[4][4]; bool ok[4];
#pragma unroll
        for (int k = 0; k < 4; ++k) { const int m = m0 + k * NGW; ok[k] = m < M_TOK; const int mc = ok[k] ? m : m0;
            const f32x4* xr = (const f32x4*)(p.x + (size_t)mc * D_MODEL) + lane;
#pragma unroll
            for (int j = 0; j < 4; ++j) v[k][j] = xr[64 * j]; }
#pragma unroll
        for (int k = 0; k < 4; ++k) {
            const int m = m0 + k * NGW;
            if (ok[k]) {
                const int b = m / SEQ; const float* sc = mod + (size_t)b * NMOD + 1 * D_MODEL;
                float ss = 0.f;
#pragma unroll
                for (int j = 0; j < 4; ++j) ss += (v[k][j].x * v[k][j].x + v[k][j].y * v[k][j].y) + (v[k][j].z * v[k][j].z + v[k][j].w * v[k][j].w);
                ss = wave_sum(ss, lane);
                if (lane == 0) RS[m] = ss;
                u32x2* o8 = (u32x2*)(HB + (size_t)m * D_MODEL) + lane;
#pragma unroll
                for (int j = 0; j < 4; ++j) { const f32x4 h = v[k][j] * (*((const f32x4*)sc + lane + 64 * j) + 1.0f);
                    u32x2 wq; wq.x = pk2(h.x, h.y); wq.y = pk2(h.z, h.w); o8[64 * j] = wq; }
            }
        }
    }
}

DI void phase_norm(const float* X, const float* sh, const float* sc, bf16_t* HB, int gw, int NGW, int lane) {
    for (int m = gw; m < M_TOK; m += NGW) {
        const int b = m / SEQ;
        const f32x4* xr = (const f32x4*)(X + (size_t)m * D_MODEL) + lane;
        f32x4 v[4]; float s = 0.f;
#pragma unroll
        for (int j = 0; j < 4; ++j) { v[j] = xr[64 * j]; s += (v[j].x * v[j].x + v[j].y * v[j].y) + (v[j].z * v[j].z + v[j].w * v[j].w); }
        const float r = 1.0f / sqrtf(wave_sum(s, lane) * (1.0f / D_MODEL) + EPS);
        u32x2* o8 = (u32x2*)(HB + (size_t)m * D_MODEL) + lane;
#pragma unroll
        for (int j = 0; j < 4; ++j) {
            const f32x4 scv = *((const f32x4*)(sc + (size_t)b * NMOD) + lane + 64 * j), shv = *((const f32x4*)(sh + (size_t)b * NMOD) + lane + 64 * j);
            const f32x4 h = v[j] * r * (scv + 1.0f) + shv;
            u32x2 w; w.x = pk2(h.x, h.y); w.y = pk2(h.z, h.w); o8[64 * j] = w; }
    }
}

typedef short v4i16_t __attribute__((ext_vector_type(4)));
constexpr int VT_PITCH = 144;
constexpr int VT_TILE = 32 * VT_PITCH;
constexpr int ATT_LDS_PER_WAVE = 2 * VT_TILE;
DI bf16x8 v_frag(LAS unsigned char* vt, int dt, int ks2, int lane) {
    const int hh = lane >> 5, blk = (lane >> 4) & 1, q = (lane & 15) >> 2, p = lane & 3;
    LAS unsigned char* a = vt + (16 * ks2 + 4 * hh + q) * VT_PITCH + (32 * dt + 16 * blk + 4 * p) * 2;
    const v4i16_t lo = __builtin_amdgcn_ds_read_tr16_b64_v4i16((LAS v4i16_t*)a);
    const v4i16_t hi = __builtin_amdgcn_ds_read_tr16_b64_v4i16((LAS v4i16_t*)(a + 8 * VT_PITCH));
    bf16x8 r; r[0] = lo[0]; r[1] = lo[1]; r[2] = lo[2]; r[3] = lo[3]; r[4] = hi[0]; r[5] = hi[1]; r[6] = hi[2]; r[7] = hi[3];
    return r;
}
DI bf16x8 k_frag(LAS unsigned char* kt, int ks, int lane) { return *(LAS bf16x8*)(kt + (lane & 31) * VT_PITCH + (16 * ks + 8 * (lane >> 5)) * 2); }
template <int OFF> DI void gload16(u32x4& dst, const void* p) { dst = *(const u32x4*)((const char*)p + OFF); }
template <int CK, int CV> DI void kv_issue(u32x4 (&k)[4], u32x4 (&v)[4], const bf16_t* p, size_t rstep) {
    gload16<CK * 2>(k[0], p); gload16<CV * 2>(v[0], p); gload16<CK * 2>(k[1], p + rstep); gload16<CV * 2>(v[1], p + rstep);
    gload16<CK * 2>(k[2], p + 2 * rstep); gload16<CV * 2>(v[2], p + 2 * rstep); gload16<CK * 2>(k[3], p + 3 * rstep); gload16<CV * 2>(v[3], p + 3 * rstep);
    asm volatile("" ::: "memory");
}
DI void kv_stage(LAS unsigned char* kl, LAS unsigned char* vl, const u32x4 (&k)[4], const u32x4 (&v)[4], int lane) {
    const int o = (lane >> 3) * VT_PITCH + (lane & 7) * 16;
#pragma unroll
    for (int i = 0; i < 4; ++i) { *(LAS u32x4*)(kl + o + 8 * i * VT_PITCH) = k[i]; *(LAS u32x4*)(vl + o + 8 * i * VT_PITCH) = v[i]; }
}
#define KV_WAIT(N, k, v) do { } while (0)

constexpr float SB_EXIT = -64.0f;
struct SbState { f32x16 o0, o1; float carry; };
DI bool sb_tile(SbState& st, const bf16x8 (&qf)[4], const f16x8 (&tf)[2], LAS unsigned char* kl, LAS unsigned char* vt, bool diag, int lane) {
    const int q = lane & 31, hh = lane >> 5;
    const float SC = 0.125f * LOG2E;
    bf16x8 kf[4], vf[2][2];
#pragma unroll
    for (int ks = 0; ks < 4; ++ks) kf[ks] = k_frag(kl, ks, lane);
#pragma unroll
    for (int ks = 0; ks < 2; ++ks) { vf[0][ks] = v_frag(vt, 0, ks, lane); vf[1][ks] = v_frag(vt, 1, ks, lane); }
    asm volatile("" ::: "memory");
    f32x16 S;
#pragma unroll
    for (int i = 0; i < 16; ++i) S[i] = 0.f;
#pragma unroll
    for (int ks = 0; ks < 4; ++ks) S = MFMA_BF16(kf[ks], qf[ks], S);
    float lnb[16], lw[16]; float tot = 0.f;
#pragma unroll
    for (int i = 0; i < 16; ++i) {
        const float z2 = fminf(S[i] * SC, 100.f);
        const float sp = flog2(1.0f + fexp2(z2));
        const bool valid = !diag || (crow(i, hh) < q);
        lnb[i] = valid ? -sp : 0.f; lw[i] = z2 - sp; tot += lnb[i];
    }
    tot += shx(tot, 32, lane);
    f16x8 lf[2];
#pragma unroll
    for (int ks = 0; ks < 2; ++ks)
#pragma unroll
        for (int j = 0; j < 8; ++j) lf[ks][j] = (_Float16)lnb[8 * ks + j];
    f32x16 T;
#pragma unroll
    for (int i = 0; i < 16; ++i) T[i] = 0.f;
#pragma unroll
    for (int ks = 0; ks < 2; ++ks) T = MFMA_F16(tf[ks], lf[ks], T);
    unsigned pw[8];
#pragma unroll
    for (int i = 0; i < 16; i += 2) {
        const bool v0 = !diag || (crow(i, hh) < q), v1 = !diag || (crow(i + 1, hh) < q);
        const float w0 = v0 ? fexp2(lw[i] + T[i] + st.carry) : 0.f, w1 = v1 ? fexp2(lw[i + 1] + T[i + 1] + st.carry) : 0.f;
        pw[i >> 1] = pk2(w0, w1);
    }
    bf16x8 pf[2];
    pf[0] = __builtin_bit_cast(bf16x8, (u32x4){pw[0], pw[1], pw[2], pw[3]});
    pf[1] = __builtin_bit_cast(bf16x8, (u32x4){pw[4], pw[5], pw[6], pw[7]});
#pragma unroll
    for (int ks = 0; ks < 2; ++ks) { st.o0 = MFMA_BF16(vf[0][ks], pf[ks], st.o0); st.o1 = MFMA_BF16(vf[1][ks], pf[ks], st.o1); }
    st.carry += tot;
    return __all(st.carry < SB_EXIT) != 0;
}
DI void sb_unit(const bf16_t* proj, bf16_t* Y, LAS unsigned char* wl, int b, int hd, int qt, int lane) {
    const int q = lane & 31, hh = lane >> 5;
    const size_t rowbase = (size_t)b * SEQ;
    LAS unsigned char* kl = wl; LAS unsigned char* vl = wl + VT_TILE;
    const bf16_t* qp = proj + (rowbase + qt * 32 + q) * PW + C_QA + hd * 64 + 8 * hh;
    bf16x8 qf[4];
#pragma unroll
    for (int ks = 0; ks < 4; ++ks) qf[ks] = *(const bf16x8*)(qp + 16 * ks);
    f16x8 tf[2];
#pragma unroll
    for (int ks = 0; ks < 2; ++ks)
#pragma unroll
        for (int j = 0; j < 8; ++j) tf[ks][j] = (krow(ks, hh, j) > q) ? (_Float16)1.0f : (_Float16)0.0f;
    SbState st;
#pragma unroll
    for (int i = 0; i < 16; ++i) { st.o0[i] = 0.f; st.o1[i] = 0.f; }
    st.carry = 0.f;
    const bf16_t* lbase = proj + (rowbase + (lane >> 3)) * PW + hd * 64 + (lane & 7) * 8;
    const size_t tstride = (size_t)32 * PW, rstep = (size_t)8 * PW;
    u32x4 KX[4], VX[4], KY[4], VY[4];
    kv_issue<C_KA, C_VA>(KX, VX, lbase + (size_t)qt * tstride, rstep);
    kv_issue<C_KA, C_VA>(KY, VY, lbase + (size_t)(qt > 0 ? qt - 1 : 0) * tstride, rstep);
    KV_WAIT(8, KX, VX);
    kv_stage(kl, vl, KX, VX, lane);
    int kt = qt;
#define SB_STEP(N1, N2) { \
        kv_issue<C_KA, C_VA>(K##N2, V##N2, lbase + (size_t)(kt > 1 ? kt - 2 : 0) * tstride, rstep); \
        int ln_ = lane; asm volatile("" : "+v"(ln_)); \
        const bool done_ = sb_tile(st, qf, tf, kl, vl, kt == qt, ln_); \
        KV_WAIT(8, K##N1, V##N1); \
        if (done_ || kt == 0) { KV_WAIT(0, K##N2, V##N2); break; } \
        kv_stage(kl, vl, K##N1, V##N1, ln_); --kt; }
    for (;;) {
        SB_STEP(Y, X)
        SB_STEP(X, Y)
    }
#undef SB_STEP
    bf16_t* yp = Y + (rowbase + qt * 32 + q) * D_MODEL + hd * 64 + 4 * hh;
#pragma unroll
    for (int g = 0; g < 4; ++g) {
        u32x2 w0; w0.x = pk2(st.o0[4 * g], st.o0[4 * g + 1]); w0.y = pk2(st.o0[4 * g + 2], st.o0[4 * g + 3]);
        u32x2 w1; w1.x = pk2(st.o1[4 * g], st.o1[4 * g + 1]); w1.y = pk2(st.o1[4 * g + 2], st.o1[4 * g + 3]);
        *(u32x2*)(yp + 8 * g) = w0; *(u32x2*)(yp + 32 + 8 * g) = w1;
    }
}

template <int NT> DI void qkprep_tokens(bf16_t* proj, const float* qg, const float* kg, const int (&m)[NT], int lane) {
    const int which = lane >> 5, hd = (lane >> 3) & 3, jj = lane & 7;
    const float* g = which ? kg : qg;
    const f32x4 g1 = *(const f32x4*)(g + 4 * jj), g2 = *(const f32x4*)(g + 32 + 4 * jj);
    const float osc = which ? 1.0f : 0.125f * LOG2E;
    float inv_freq[4];
#pragma unroll
    for (int e = 0; e < 4; ++e) inv_freq[e] = exp2f(-(float)(4 * jj + e) * (13.287712379549449f / 32.0f));
    u32x2 a[NT], c[NT]; bf16_t* row[NT];
#pragma unroll
    for (int k = 0; k < NT; ++k) { row[k] = proj + (size_t)m[k] * PW + (which ? C_KD : C_QD) + hd * 64 + 4 * jj; a[k] = *(const u32x2*)row[k]; c[k] = *(const u32x2*)(row[k] + 32); }
#pragma unroll
    for (int k = 0; k < NT; ++k) {
        const float x1[4] = {bflo(a[k].x), bfhi(a[k].x), bflo(a[k].y), bfhi(a[k].y)}, x2[4] = {bflo(c[k].x), bfhi(c[k].x), bflo(c[k].y), bfhi(c[k].y)};
        float ss = 0.f;
#pragma unroll
        for (int e = 0; e < 4; ++e) ss += x1[e] * x1[e] + x2[e] * x2[e];
        ss += shx(ss, 1, lane); ss += shx(ss, 2, lane); ss += shx(ss, 4, lane);
        const float r = 1.0f / sqrtf(ss * (1.0f / 64.0f) + EPS) ;
        const float pos = (float)(m[k] % SEQ);
        float o1[4], o2[4];
#pragma unroll
        for (int e = 0; e < 4; ++e) {
            const float ang = pos * inv_freq[e];
            double t = (double)ang * 0.15915494309189535; t -= rint(t);
            const float sn = __builtin_amdgcn_sinf((float)t), cs = __builtin_amdgcn_cosf((float)t);
            const float y1 = x1[e] * r * g1[e], y2 = x2[e] * r * g2[e];
            o1[e] = (y1 * cs - y2 * sn) * osc; o2[e] = (y2 * cs + y1 * sn) * osc;
        }
        u32x2 w1; w1.x = pk2(o1[0], o1[1]); w1.y = pk2(o1[2], o1[3]);
        u32x2 w2; w2.x = pk2(o2[0], o2[1]); w2.y = pk2(o2[2], o2[3]);
        *(u32x2*)row[k] = w1; *(u32x2*)(row[k] + 32) = w2;
    }
}

struct DilState { f32x16 o0, o1; float den; };
DI void dil_scores(DilState& st, unsigned (&pw)[8], const bf16x8 (&kf)[4], const bf16x8 (&qf)[4], int dbase, float m2, int hh) {
    f32x16 S;
#pragma unroll
    for (int i = 0; i < 16; ++i) S[i] = 0.f;
#pragma unroll
    for (int ks = 0; ks < 4; ++ks) S = MFMA_BF16(kf[ks], qf[ks], S);
#pragma unroll
    for (int i = 0; i < 16; i += 2) {
        const int d0 = dbase - crow(i, hh), d1 = dbase - crow(i + 1, hh);
        const float p0 = (d0 >= 0 && d0 <= 128) ? fexp2(S[i] - m2) : 0.f, p1 = (d1 >= 0 && d1 <= 128) ? fexp2(S[i + 1] - m2) : 0.f;
        st.den += p0 + p1; pw[i >> 1] = pk2(p0, p1);
    }
}
DI void dil_tile2(DilState& sa, DilState& sb, const bf16x8 (&qa)[4], const bf16x8 (&qb)[4], LAS unsigned char* kl, LAS unsigned char* vt, int dba, int dbb, bool doa, bool dob, float m2, int lane) {
    const int hh = lane >> 5;
    bf16x8 kf[4];
#pragma unroll
    for (int ks = 0; ks < 4; ++ks) kf[ks] = k_frag(kl, ks, lane);
    unsigned pa[8], pb[8];
#pragma unroll
    for (int i = 0; i < 8; ++i) { pa[i] = 0u; pb[i] = 0u; }
    if (doa) dil_scores(sa, pa, kf, qa, dba, m2, hh);
    if (dob) dil_scores(sb, pb, kf, qb, dbb, m2, hh);
    bf16x8 vf[2][2];
#pragma unroll
    for (int ks = 0; ks < 2; ++ks) { vf[0][ks] = v_frag(vt, 0, ks, lane); vf[1][ks] = v_frag(vt, 1, ks, lane); }
    if (doa) {
        const bf16x8 p0 = __builtin_bit_cast(bf16x8, (u32x4){pa[0], pa[1], pa[2], pa[3]}), p1 = __builtin_bit_cast(bf16x8, (u32x4){pa[4], pa[5], pa[6], pa[7]});
        sa.o0 = MFMA_BF16(vf[0][0], p0, sa.o0); sa.o1 = MFMA_BF16(vf[1][0], p0, sa.o1); sa.o0 = MFMA_BF16(vf[0][1], p1, sa.o0); sa.o1 = MFMA_BF16(vf[1][1], p1, sa.o1);
    }
    if (dob) {
        const bf16x8 p0 = __builtin_bit_cast(bf16x8, (u32x4){pb[0], pb[1], pb[2], pb[3]}), p1 = __builtin_bit_cast(bf16x8, (u32x4){pb[4], pb[5], pb[6], pb[7]});
        sb.o0 = MFMA_BF16(vf[0][0], p0, sb.o0); sb.o1 = MFMA_BF16(vf[1][0], p0, sb.o1); sb.o0 = MFMA_BF16(vf[0][1], p1, sb.o0); sb.o1 = MFMA_BF16(vf[1][1], p1, sb.o1);
    }
}
DI void dil_store(const DilState& st, bf16_t* pnum, float* pden, int pat, size_t rowq, int hd, int hh, int lane) {
    float den = st.den; den += shx(den, 32, lane);
    bf16_t* np = pnum + ((size_t)pat * M_TOK + rowq) * 256 + hd * 64 + 4 * hh;
#pragma unroll
    for (int g = 0; g < 4; ++g) {
        u32x2 w0; w0.x = pk2(st.o0[4 * g], st.o0[4 * g + 1]); w0.y = pk2(st.o0[4 * g + 2], st.o0[4 * g + 3]);
        u32x2 w1; w1.x = pk2(st.o1[4 * g], st.o1[4 * g + 1]); w1.y = pk2(st.o1[4 * g + 2], st.o1[4 * g + 3]);
        *(u32x2*)(np + 8 * g) = w0; *(u32x2*)(np + 32 + 8 * g) = w1;
    }
    if (hh == 0) pden[((size_t)pat * M_TOK + rowq) * 4 + hd] = den;
}
DI void dil_unit(const bf16_t* proj, bf16_t* pnum, float* pden, LAS unsigned char* wl, int b, int hd, int pat, int rho, int jt2, float m2, int lane) {
    const int r = 1 << (2 * pat);
    const int q = lane & 31, hh = lane >> 5;
    const size_t rowbase = (size_t)b * SEQ;
    LAS unsigned char* kl = wl; LAS unsigned char* vl = wl + VT_TILE;
    const int ja = 2 * jt2, jb = ja + 1;
    const size_t rowqa = rowbase + (size_t)(32 * ja + q) * r + rho, rowqb = rowbase + (size_t)(32 * jb + q) * r + rho;
    bf16x8 qa[4], qb[4];
    { const bf16_t* pa_ = proj + rowqa * PW + C_QD + hd * 64 + 8 * hh; const bf16_t* pb_ = proj + rowqb * PW + C_QD + hd * 64 + 8 * hh;
#pragma unroll
      for (int ks = 0; ks < 4; ++ks) { qa[ks] = *(const bf16x8*)(pa_ + 16 * ks); qb[ks] = *(const bf16x8*)(pb_ + 16 * ks); } }
    DilState sa, sb;
#pragma unroll
    for (int i = 0; i < 16; ++i) { sa.o0[i] = 0.f; sa.o1[i] = 0.f; sb.o0[i] = 0.f; sb.o1[i] = 0.f; }
    sa.den = 0.f; sb.den = 0.f;
    const int kt0 = (ja - 4) > 0 ? (ja - 4) : 0, jt = jb;
    const bf16_t* lbase = proj + (rowbase + (size_t)(lane >> 3) * r + rho) * PW + hd * 64 + (lane & 7) * 8;
    const size_t tstride = (size_t)32 * r * PW, rstep = (size_t)8 * r * PW;
    u32x4 KX[4], VX[4], KY[4], VY[4];
    kv_issue<C_KD, C_VD>(KX, VX, lbase + (size_t)kt0 * tstride, rstep);
    kv_issue<C_KD, C_VD>(KY, VY, lbase + (size_t)(kt0 + 1 < jt ? kt0 + 1 : jt) * tstride, rstep);
    KV_WAIT(8, KX, VX);
    kv_stage(kl, vl, KX, VX, lane);
    int kt = kt0;
#define DIL_STEP(N1, N2) { \
        kv_issue<C_KD, C_VD>(K##N2, V##N2, lbase + (size_t)(kt + 2 < jt ? kt + 2 : jt) * tstride, rstep); \
        int ln_ = lane; asm volatile("" : "+v"(ln_)); \
        dil_tile2(sa, sb, qa, qb, kl, vl, 32 * (ja - kt) + (ln_ & 31), 32 * (jb - kt) + (ln_ & 31), kt <= ja, kt >= ja - 3, m2, ln_); \
        KV_WAIT(8, K##N1, V##N1); \
        if (kt == jt) { KV_WAIT(0, K##N2, V##N2); break; } \
        kv_stage(kl, vl, K##N1, V##N1, ln_); ++kt; }
    for (;;) {
        DIL_STEP(Y, X)
        DIL_STEP(X, Y)
    }
#undef DIL_STEP
    dil_store(sa, pnum, pden, pat, rowqa, hd, hh, lane);
    dil_store(sb, pnum, pden, pat, rowqb, hd, hh, lane);
}

template <int NR> DI void dil_merge_rows(const bf16_t* pnum, const float* pden, bf16_t* Y, const int (&m)[NR], int lane) {
    u32x2 v[NR][3]; float dd[NR][3];
#pragma unroll
    for (int k = 0; k < NR; ++k)
#pragma unroll
        for (int p = 0; p < 3; ++p) { v[k][p] = *(const u32x2*)(pnum + ((size_t)p * M_TOK + m[k]) * 256 + 4 * lane); dd[k][p] = pden[((size_t)p * M_TOK + m[k]) * 4 + (lane >> 4)]; }
#pragma unroll
    for (int k = 0; k < NR; ++k) {
        const float rd = 1.0f / (dd[k][0] + dd[k][1] + dd[k][2]);
        const float n0 = bflo(v[k][0].x) + bflo(v[k][1].x) + bflo(v[k][2].x), n1 = bfhi(v[k][0].x) + bfhi(v[k][1].x) + bfhi(v[k][2].x);
        const float n2 = bflo(v[k][0].y) + bflo(v[k][1].y) + bflo(v[k][2].y), n3 = bfhi(v[k][0].y) + bfhi(v[k][1].y) + bfhi(v[k][2].y);
        u32x2 w; w.x = pk2(n0 * rd, n1 * rd); w.y = pk2(n2 * rd, n3 * rd);
        *(u32x2*)(Y + (size_t)m[k] * D_MODEL + 256 + 4 * lane) = w;
    }
}

constexpr int H_TOT = 0;
constexpr int H_QA = 4096;
constexpr int H_KT = H_QA + 17408;
constexpr int H_QB = H_KT + 17408;
constexpr int H_VT = H_QB + 17408;
constexpr int H_KH = H_VT + 18432;
constexpr int H_RED = H_KH + 18432;
static_assert(H_RED + 1024 <= 131072, "HGRN LDS map");

DI void hgrn_gate16(const unsigned short (&zr)[16], float lb, float (&pfx)[16], float (&kk)[16]) {
    float run = 0.f;
#pragma unroll
    for (int i = 0; i < 16; ++i) {
        const float z = bf2f(zr[i]);
        const float sig = frcp(1.0f + __expf(-z));
        const float f = fmaxf(lb + (1.0f - lb) * sig, 1e-30f);
        run += __logf(f); pfx[i] = run; kk[i] = 1.0f - f;
    }
}
DI void hgrn_store_vt(unsigned char* lds, int off, const unsigned short (&vr)[16], int v, int seg) {
    u32x4* dst = (u32x4*)(lds + off + (v * 72 + 16 * seg) * 2);
    dst[0] = (u32x4){(unsigned)vr[0] | ((unsigned)vr[1] << 16), (unsigned)vr[2] | ((unsigned)vr[3] << 16), (unsigned)vr[4] | ((unsigned)vr[5] << 16), (unsigned)vr[6] | ((unsigned)vr[7] << 16)};
    dst[1] = (u32x4){(unsigned)vr[8] | ((unsigned)vr[9] << 16), (unsigned)vr[10] | ((unsigned)vr[11] << 16), (unsigned)vr[12] | ((unsigned)vr[13] << 16), (unsigned)vr[14] | ((unsigned)vr[15] << 16)};
}

DI void hgrn_h1_unit(unsigned char* lds, const bf16_t* proj, const float* lball, bf16_t* ST, float* DEC, int unit, int tid, int wave, int lane) {
    const int bh = unit / NCHUNK, n = unit % NCHUNK, b = bh >> 2, hd = bh & 3;
    const size_t R0 = (size_t)b * SEQ + (size_t)n * 64;
    const int d = tid & 127, seg = tid >> 7;
    const bf16_t* src = proj + (R0 + 16 * seg) * PW + hd * 128 + d;
    unsigned short zr[16], vr[16];
#pragma unroll
    for (int i = 0; i < 16; ++i) { zr[i] = src[(size_t)i * PW + C_FH]; vr[i] = src[(size_t)i * PW + C_IH]; }
    float pfx[16], kk[16];
    hgrn_gate16(zr, lball[hd * 128 + d], pfx, kk);
    float* TOT = (float*)(lds + H_TOT);
    TOT[seg * 128 + d] = pfx[15];
    __syncthreads();
    float off = 0.f, glast = 0.f;
#pragma unroll
    for (int s2 = 0; s2 < 4; ++s2) { const float t = TOT[s2 * 128 + d]; glast += t; if (s2 < seg) off += t; }
    {
        unsigned w[8];
#pragma unroll
        for (int i = 0; i < 8; ++i) w[i] = pk2(kk[2 * i] * __expf(glast - (off + pfx[2 * i])), kk[2 * i + 1] * __expf(glast - (off + pfx[2 * i + 1])));
        u32x4* dst = (u32x4*)(lds + H_KH + (d * 72 + 16 * seg) * 2);
        dst[0] = (u32x4){w[0], w[1], w[2], w[3]}; dst[1] = (u32x4){w[4], w[5], w[6], w[7]};
        if (seg == 0) DEC[((size_t)bh * NCHUNK + n) * 128 + d] = __expf(glast);
    }
    hgrn_store_vt(lds, H_VT, vr, d, seg);
    __syncthreads();
    {
        const int dtile = wave >> 1, vt0 = 2 * (wave & 1), l31 = lane & 31, hh = lane >> 5;
        f32x16 a0, a1;
#pragma unroll
        for (int i = 0; i < 16; ++i) { a0[i] = 0.f; a1[i] = 0.f; }
#pragma unroll
        for (int ks = 0; ks < 4; ++ks) {
            const bf16x8 af = *(const bf16x8*)(lds + H_KH + ((32 * dtile + l31) * 72 + 16 * ks + 8 * hh) * 2);
            const bf16x8 b0 = *(const bf16x8*)(lds + H_VT + ((32 * vt0 + l31) * 72 + 16 * ks + 8 * hh) * 2);
            const bf16x8 b1 = *(const bf16x8*)(lds + H_VT + ((32 * (vt0 + 1) + l31) * 72 + 16 * ks + 8 * hh) * 2);
            a0 = MFMA_BF16(af, b0, a0); a1 = MFMA_BF16(af, b1, a1);
        }
        bf16_t* st = ST + ((size_t)bh * NCHUNK + n) * 16384 + 32 * dtile + 4 * hh;
#pragma unroll
        for (int g = 0; g < 4; ++g) {
            u32x2 w0; w0.x = pk2(a0[4 * g], a0[4 * g + 1]); w0.y = pk2(a0[4 * g + 2], a0[4 * g + 3]);
            u32x2 w1; w1.x = pk2(a1[4 * g], a1[4 * g + 1]); w1.y = pk2(a1[4 * g + 2], a1[4 * g + 3]);
            *(u32x2*)(st + (32 * vt0 + l31) * 128 + 8 * g) = w0; *(u32x2*)(st + (32 * (vt0 + 1) + l31) * 128 + 8 * g) = w1;
        }
    }
}

DI void hgrn_scan(bf16_t* ST, const float* DEC, int gtid  ) {
    const int bh = gtid >> 14, e = gtid & 16383, d = e & 127;
    bf16_t* st = ST + (size_t)bh * NCHUNK * 16384 + e;
    const float* dc = DEC + (size_t)bh * NCHUNK * 128 + d;
    float s = 0.f;
    for (int n0 = 0; n0 < NCHUNK; n0 += 32) {
        unsigned short u[32]; float dd[32];
#pragma unroll
        for (int i = 0; i < 32; ++i) { u[i] = st[(size_t)(n0 + i) * 16384]; dd[i] = dc[(n0 + i) * 128]; }
#pragma unroll
        for (int i = 0; i < 32; ++i) { st[(size_t)(n0 + i) * 16384] = (bf16_t)(pk2(s, 0.f) & 0xffffu); s = dd[i] * s + bf2f(u[i]); }
    }
}

DI void hgrn_h3_unit(unsigned char* lds, const bf16_t* proj, const float* lball, const bf16_t* ST, const float* hng, bf16_t* Y, int unit, int tid, int wave, int lane) {
    const int bh = unit / NCHUNK, n = unit % NCHUNK, b = bh >> 2, hd = bh & 3;
    const size_t R0 = (size_t)b * SEQ + (size_t)n * 64;
    const int d = tid & 127, seg = tid >> 7;
    const int vt = wave >> 1, ti = wave & 1, l31 = lane & 31, hh = lane >> 5;
    const bf16_t* src = proj + (R0 + 16 * seg) * PW + hd * 128 + d;
    unsigned short zr[16], qr[16], vr[16];
#pragma unroll
    for (int i = 0; i < 16; ++i) { zr[i] = src[(size_t)i * PW + C_FH]; qr[i] = src[(size_t)i * PW + C_QH]; vr[i] = src[(size_t)i * PW + C_IH]; }
    bf16x8 stf[8];
    { const bf16_t* sp = ST + ((size_t)bh * NCHUNK + n) * 16384 + (32 * vt + l31) * 128 + 8 * hh;
#pragma unroll
      for (int ks = 0; ks < 8; ++ks) stf[ks] = *(const bf16x8*)(sp + 16 * ks); }
    const int t = 32 * ti + l31;
    u32x2 gv[4]; f32x4 nn[4];
    { const bf16_t* gp = proj + (R0 + t) * PW + C_GH + hd * 128 + 32 * vt + 4 * hh; const float* gn = hng + 32 * vt + 4 * hh;
#pragma unroll
      for (int g = 0; g < 4; ++g) { gv[g] = *(const u32x2*)(gp + 8 * g); nn[g] = *(const f32x4*)(gn + 8 * g); } }
    float pfx[16], kk[16];
    hgrn_gate16(zr, lball[hd * 128 + d], pfx, kk);
    float* TOT = (float*)(lds + H_TOT);
    TOT[seg * 128 + d] = pfx[15];
    __syncthreads();
    {
        float off = 0.f;
#pragma unroll
        for (int s2 = 0; s2 < 3; ++s2) { const float tt = TOT[s2 * 128 + d]; if (s2 < seg) off += tt; }
        const float gm = TOT[d] + TOT[128 + d];
        bf16_t* QA = (bf16_t*)(lds + H_QA); bf16_t* KT = (bf16_t*)(lds + H_KT); bf16_t* QB = (bf16_t*)(lds + H_QB);
#pragma unroll
        for (int i = 0; i < 16; ++i) {
            const int tk = 16 * seg + i;
            const float g = off + pfx[i];
            const float qv = silu_f(bf2f(qr[i]));
            const float e1 = __expf(fminf(g - gm, 80.f)), e2 = __expf(fminf(gm - g, 80.f)), e3 = __expf(g);
            QA[tk * 136 + d] = (bf16_t)(pk2(qv * e1, 0.f) & 0xffffu);
            KT[tk * 136 + d] = (bf16_t)(pk2(kk[i] * e2, 0.f) & 0xffffu);
            QB[tk * 136 + d] = (bf16_t)(pk2(qv * e3, 0.f) & 0xffffu);
        }
    }
    hgrn_store_vt(lds, H_VT, vr, d, seg);
    __syncthreads();
    f32x16 acc;
#pragma unroll
    for (int i = 0; i < 16; ++i) acc[i] = 0.f;
#pragma unroll
    for (int ks = 0; ks < 8; ++ks) {
        const bf16x8 bfr = *(const bf16x8*)(lds + H_QB + ((32 * ti + l31) * 136 + 16 * ks + 8 * hh) * 2);
        acc = MFMA_BF16(stf[ks], bfr, acc);
    }
    for (int si = 0; si <= ti; ++si) {
        f32x16 Sc;
#pragma unroll
        for (int i = 0; i < 16; ++i) Sc[i] = 0.f;
#pragma unroll
        for (int ks = 0; ks < 8; ++ks) {
            const bf16x8 af = *(const bf16x8*)(lds + H_KT + ((32 * si + l31) * 136 + 16 * ks + 8 * hh) * 2);
            const bf16x8 bfr = *(const bf16x8*)(lds + H_QA + ((32 * ti + l31) * 136 + 16 * ks + 8 * hh) * 2);
            Sc = MFMA_BF16(af, bfr, Sc);
        }
        unsigned pw[8];
#pragma unroll
        for (int i = 0; i < 16; i += 2) {
            const bool v0 = (si < ti) || (crow(i, hh) <= l31), v1 = (si < ti) || (crow(i + 1, hh) <= l31);
            pw[i >> 1] = pk2(v0 ? Sc[i] : 0.f, v1 ? Sc[i + 1] : 0.f);
        }
        bf16x8 pf[2];
        pf[0] = __builtin_bit_cast(bf16x8, (u32x4){pw[0], pw[1], pw[2], pw[3]});
        pf[1] = __builtin_bit_cast(bf16x8, (u32x4){pw[4], pw[5], pw[6], pw[7]});
#pragma unroll
        for (int ks = 0; ks < 2; ++ks) {
            const unsigned char* vb = lds + H_VT + ((32 * vt + l31) * 72 + 32 * si + 16 * ks + 4 * hh) * 2;
            const u32x2 lo = *(const u32x2*)vb, hi = *(const u32x2*)(vb + 16);
            const bf16x8 af = __builtin_bit_cast(bf16x8, (u32x4){lo.x, lo.y, hi.x, hi.y});
            acc = MFMA_BF16(af, pf[ks], acc);
        }
    }
    float ss = 0.f;
#pragma unroll
    for (int i = 0; i < 16; ++i) ss += acc[i] * acc[i];
    ss += shx(ss, 32, lane);
    float* RED = (float*)(lds + H_RED);
    if (hh == 0) RED[vt * 64 + t] = ss;
    __syncthreads();
    const float tot = RED[t] + RED[64 + t] + RED[128 + t] + RED[192 + t];
    const float rs = 1.0f / sqrtf(tot * (1.0f / 128.0f) + EPS);
    bf16_t* yp = Y + (R0 + t) * D_MODEL + 512 + hd * 128 + 32 * vt + 4 * hh;
#pragma unroll
    for (int g = 0; g < 4; ++g) {
        const float r0 = acc[4 * g] * rs * nn[g].x * silu_f(bflo(gv[g].x)), r1 = acc[4 * g + 1] * rs * nn[g].y * silu_f(bfhi(gv[g].x));
        const float r2 = acc[4 * g + 2] * rs * nn[g].z * silu_f(bflo(gv[g].y)), r3 = acc[4 * g + 3] * rs * nn[g].w * silu_f(bfhi(gv[g].y));
        u32x2 w; w.x = pk2(r0, r1); w.y = pk2(r2, r3);
        *(u32x2*)(yp + 8 * g) = w;
    }
}


DI void hgrn_gate8x2(const unsigned (&zr)[8], float lb0, float lb1, float (&pfx)[2][8], float (&kk)[2][8]) {
    float run0 = 0.f, run1 = 0.f;
#pragma unroll
    for (int i = 0; i < 8; ++i) {
        const float z0 = bflo(zr[i]), z1 = bfhi(zr[i]);
        const float f0 = fmaxf(lb0 + (1.0f - lb0) * frcp(1.0f + __expf(-z0)), 1e-30f), f1 = fmaxf(lb1 + (1.0f - lb1) * frcp(1.0f + __expf(-z1)), 1e-30f);
        run0 += __logf(f0); run1 += __logf(f1); pfx[0][i] = run0; pfx[1][i] = run1; kk[0][i] = 1.0f - f0; kk[1][i] = 1.0f - f1;
    }
}
DI void hgrn_store_vt2(unsigned char* lds, int off, const unsigned (&vr)[8], int d0, int seg) {
    u32x4 a, b;
    a.x = (vr[0] & 0xffffu) | (vr[1] << 16); a.y = (vr[2] & 0xffffu) | (vr[3] << 16); a.z = (vr[4] & 0xffffu) | (vr[5] << 16); a.w = (vr[6] & 0xffffu) | (vr[7] << 16);
    b.x = (vr[0] >> 16) | (vr[1] & 0xffff0000u); b.y = (vr[2] >> 16) | (vr[3] & 0xffff0000u); b.z = (vr[4] >> 16) | (vr[5] & 0xffff0000u); b.w = (vr[6] >> 16) | (vr[7] & 0xffff0000u);
    *(u32x4*)(lds + off + (d0 * 72 + 8 * seg) * 2) = a; *(u32x4*)(lds + off + ((d0 + 1) * 72 + 8 * seg) * 2) = b;
}

DI void hgrn_h1_phase(unsigned char* lds, const bf16_t* proj, const float* lball, bf16_t* ST, float* DEC, int bid, int G, int tid, int wave, int lane) {
    const int d0 = 2 * (tid & 63), seg = tid >> 6;
    const int NU = 8 * NCHUNK;
    if (bid >= NU) return;
    unsigned zr[8], vr[8];
    {   const int bh = bid / NCHUNK, n = bid % NCHUNK; const size_t R0 = (size_t)(bh >> 2) * SEQ + (size_t)n * 64;
        const bf16_t* src = proj + (R0 + 8 * seg) * PW + (bh & 3) * 128 + d0;
#pragma unroll
        for (int i = 0; i < 8; ++i) { zr[i] = *(const unsigned*)(src + (size_t)i * PW + C_FH); vr[i] = *(const unsigned*)(src + (size_t)i * PW + C_IH); }
        asm volatile("" ::: "memory"); }
    float* TOT = (float*)(lds + H_TOT);
    for (int unit = bid; unit < NU; unit += G) {
        const int bh = unit / NCHUNK, n = unit % NCHUNK, hd = bh & 3;
        float pfx[2][8], kk[2][8];
        hgrn_gate8x2(zr, lball[hd * 128 + d0], lball[hd * 128 + d0 + 1], pfx, kk);
        *(f32x2*)(TOT + seg * 128 + d0) = (f32x2){pfx[0][7], pfx[1][7]};
        __syncthreads();
        float off[2] = {0.f, 0.f}, glast[2] = {0.f, 0.f};
#pragma unroll
        for (int s2 = 0; s2 < 8; ++s2) { const f32x2 t = *(const f32x2*)(TOT + s2 * 128 + d0); glast[0] += t.x; glast[1] += t.y; if (s2 < seg) { off[0] += t.x; off[1] += t.y; } }
#pragma unroll
        for (int c = 0; c < 2; ++c) {
            unsigned w[4];
#pragma unroll
            for (int i = 0; i < 4; ++i) w[i] = pk2(kk[c][2 * i] * __expf(glast[c] - (off[c] + pfx[c][2 * i])), kk[c][2 * i + 1] * __expf(glast[c] - (off[c] + pfx[c][2 * i + 1])));
            *(u32x4*)(lds + H_KH + ((d0 + c) * 72 + 8 * seg) * 2) = (u32x4){w[0], w[1], w[2], w[3]};
        }
        if (seg == 0) *(f32x2*)(DEC + ((size_t)bh * NCHUNK + n) * 128 + d0) = (f32x2){__expf(glast[0]), __expf(glast[1])};
        hgrn_store_vt2(lds, H_VT, vr, d0, seg);
        {
            const int un = (unit + G < NU) ? unit + G : unit; const int bh2 = un / NCHUNK, n2 = un % NCHUNK; const size_t R2 = (size_t)(bh2 >> 2) * SEQ + (size_t)n2 * 64;
            const bf16_t* src = proj + (R2 + 8 * seg) * PW + (bh2 & 3) * 128 + d0;
#pragma unroll
            for (int i = 0; i < 8; ++i) { zr[i] = *(const unsigned*)(src + (size_t)i * PW + C_FH); vr[i] = *(const unsigned*)(src + (size_t)i * PW + C_IH); }
            asm volatile("" ::: "memory"); }
        __syncthreads();
        {
            const int dtile = wave >> 1, vt0 = 2 * (wave & 1), l31 = lane & 31, hh = lane >> 5;
            f32x16 a0, a1;
#pragma unroll
            for (int i = 0; i < 16; ++i) { a0[i] = 0.f; a1[i] = 0.f; }
#pragma unroll
            for (int ks = 0; ks < 4; ++ks) {
                const bf16x8 af = *(const bf16x8*)(lds + H_KH + ((32 * dtile + l31) * 72 + 16 * ks + 8 * hh) * 2);
                const bf16x8 b0 = *(const bf16x8*)(lds + H_VT + ((32 * vt0 + l31) * 72 + 16 * ks + 8 * hh) * 2);
                const bf16x8 b1 = *(const bf16x8*)(lds + H_VT + ((32 * (vt0 + 1) + l31) * 72 + 16 * ks + 8 * hh) * 2);
                a0 = MFMA_BF16(af, b0, a0); a1 = MFMA_BF16(af, b1, a1);
            }
            bf16_t* st = ST + ((size_t)bh * NCHUNK + n) * 16384 + 32 * dtile + 4 * hh;
#pragma unroll
            for (int g = 0; g < 4; ++g) {
                u32x2 w0; w0.x = pk2(a0[4 * g], a0[4 * g + 1]); w0.y = pk2(a0[4 * g + 2], a0[4 * g + 3]);
                u32x2 w1; w1.x = pk2(a1[4 * g], a1[4 * g + 1]); w1.y = pk2(a1[4 * g + 2], a1[4 * g + 3]);
                *(u32x2*)(st + (32 * vt0 + l31) * 128 + 8 * g) = w0; *(u32x2*)(st + (32 * (vt0 + 1) + l31) * 128 + 8 * g) = w1;
            }
        }
    }
    __syncthreads();
}

DI void hgrn_h3_phase(unsigned char* lds, const bf16_t* proj, const float* lball, const bf16_t* ST, const float* hng, bf16_t* Y, int bid, int G, int tid, int wave, int lane) {
    const int d0 = 2 * (tid & 63), seg = tid >> 6;
    const int vt = wave >> 1, ti = wave & 1, l31 = lane & 31, hh = lane >> 5;
    const int t = 32 * ti + l31;
    const int NU = 8 * NCHUNK;
    if (bid >= NU) return;
    unsigned zr[8], qr[8], vr[8]; bf16x8 stf[8]; u32x2 gv[4];
    f32x4 nn[4];
    { const float* gn = hng + 32 * vt + 4 * hh;
#pragma unroll
      for (int g = 0; g < 4; ++g) nn[g] = *(const f32x4*)(gn + 8 * g); }
#define H3_LOAD_RAW(U) { const int bh_ = (U) / NCHUNK, n_ = (U) % NCHUNK; const size_t R_ = (size_t)(bh_ >> 2) * SEQ + (size_t)n_ * 64; \
        const bf16_t* src_ = proj + (R_ + 8 * seg) * PW + (bh_ & 3) * 128 + d0; \
        _Pragma("unroll") for (int i = 0; i < 8; ++i) { zr[i] = *(const unsigned*)(src_ + (size_t)i * PW + C_FH); qr[i] = *(const unsigned*)(src_ + (size_t)i * PW + C_QH); vr[i] = *(const unsigned*)(src_ + (size_t)i * PW + C_IH); } \
        asm volatile("" ::: "memory"); }
#define H3_LOAD_ST(U) { const int bh_ = (U) / NCHUNK, n_ = (U) % NCHUNK; const bf16_t* sp_ = ST + ((size_t)bh_ * NCHUNK + n_) * 16384 + (32 * vt + l31) * 128 + 8 * hh; \
        _Pragma("unroll") for (int ks = 0; ks < 8; ++ks) stf[ks] = *(const bf16x8*)(sp_ + 16 * ks); \
        asm volatile("" ::: "memory"); }
#define H3_LOAD_GATE(U) { const int bh_ = (U) / NCHUNK, n_ = (U) % NCHUNK; const size_t R_ = (size_t)(bh_ >> 2) * SEQ + (size_t)n_ * 64; \
        const bf16_t* gp_ = proj + (R_ + t) * PW + C_GH + (bh_ & 3) * 128 + 32 * vt + 4 * hh; \
        _Pragma("unroll") for (int g = 0; g < 4; ++g) gv[g] = *(const u32x2*)(gp_ + 8 * g); \
        asm volatile("" ::: "memory"); }
    H3_LOAD_RAW(bid) H3_LOAD_ST(bid) H3_LOAD_GATE(bid)
    float* TOT = (float*)(lds + H_TOT);
    for (int unit = bid; unit < NU; unit += G) {
        const int bh = unit / NCHUNK, n = unit % NCHUNK, b = bh >> 2, hd = bh & 3;
        const size_t R0 = (size_t)b * SEQ + (size_t)n * 64;
        const int un = (unit + G < NU) ? unit + G : unit;
        float pfx[2][8], kk[2][8];
        hgrn_gate8x2(zr, lball[hd * 128 + d0], lball[hd * 128 + d0 + 1], pfx, kk);
        *(f32x2*)(TOT + seg * 128 + d0) = (f32x2){pfx[0][7], pfx[1][7]};
        __syncthreads();
        {
            float off[2] = {0.f, 0.f}, gm[2] = {0.f, 0.f};
#pragma unroll
            for (int s2 = 0; s2 < 7; ++s2) { const f32x2 tt = *(const f32x2*)(TOT + s2 * 128 + d0); if (s2 < seg) { off[0] += tt.x; off[1] += tt.y; } if (s2 < 4) { gm[0] += tt.x; gm[1] += tt.y; } }
            const float egm[2] = {__expf(gm[0]), __expf(gm[1])};
            unsigned* QA = (unsigned*)(lds + H_QA); unsigned* KT = (unsigned*)(lds + H_KT); unsigned* QB = (unsigned*)(lds + H_QB);
#pragma unroll
            for (int i = 0; i < 8; ++i) {
                const int tk = 8 * seg + i;
                float qa[2], kt[2], qb[2];
#pragma unroll
                for (int c = 0; c < 2; ++c) {
                    const float g = off[c] + pfx[c][i];
                    const float qv = silu_f(c ? bfhi(qr[i]) : bflo(qr[i]));
                    const float e1 = __expf(fminf(fmaxf(g - gm[c], -80.f), 80.f)), e2 = frcp(e1), e3 = e1 * egm[c];
                    qa[c] = qv * e1; kt[c] = kk[c][i] * e2; qb[c] = qv * e3;
                }
                QA[(tk * 136 + d0) >> 1] = pk2(qa[0], qa[1]); KT[(tk * 136 + d0) >> 1] = pk2(kt[0], kt[1]); QB[(tk * 136 + d0) >> 1] = pk2(qb[0], qb[1]);
            }
        }
        hgrn_store_vt2(lds, H_VT, vr, d0, seg);
        H3_LOAD_RAW(un)
        __syncthreads();
        f32x16 acc;
#pragma unroll
        for (int i = 0; i < 16; ++i) acc[i] = 0.f;
#pragma unroll
        for (int ks = 0; ks < 8; ++ks) {
            const bf16x8 bfr = *(const bf16x8*)(lds + H_QB + ((32 * ti + l31) * 136 + 16 * ks + 8 * hh) * 2);
            acc = MFMA_BF16(stf[ks], bfr, acc);
        }
        H3_LOAD_ST(un)
        for (int si = 0; si <= ti; ++si) {
            f32x16 Sc;
#pragma unroll
            for (int i = 0; i < 16; ++i) Sc[i] = 0.f;
#pragma unroll
            for (int ks = 0; ks < 8; ++ks) {
                const bf16x8 af = *(const bf16x8*)(lds + H_KT + ((32 * si + l31) * 136 + 16 * ks + 8 * hh) * 2);
                const bf16x8 bfr = *(const bf16x8*)(lds + H_QA + ((32 * ti + l31) * 136 + 16 * ks + 8 * hh) * 2);
                Sc = MFMA_BF16(af, bfr, Sc);
            }
            unsigned pw[8];
#pragma unroll
            for (int i = 0; i < 16; i += 2) {
                const bool v0 = (si < ti) || (crow(i, hh) <= l31), v1 = (si < ti) || (crow(i + 1, hh) <= l31);
                pw[i >> 1] = pk2(v0 ? Sc[i] : 0.f, v1 ? Sc[i + 1] : 0.f);
            }
            bf16x8 pf[2];
            pf[0] = __builtin_bit_cast(bf16x8, (u32x4){pw[0], pw[1], pw[2], pw[3]});
            pf[1] = __builtin_bit_cast(bf16x8, (u32x4){pw[4], pw[5], pw[6], pw[7]});
#pragma unroll
            for (int ks = 0; ks < 2; ++ks) {
                const unsigned char* vb = lds + H_VT + ((32 * vt + l31) * 72 + 32 * si + 16 * ks + 4 * hh) * 2;
                const u32x2 lo = *(const u32x2*)vb, hi = *(const u32x2*)(vb + 16);
                const bf16x8 af = __builtin_bit_cast(bf16x8, (u32x4){lo.x, lo.y, hi.x, hi.y});
                acc = MFMA_BF16(af, pf[ks], acc);
            }
        }
        float ss = 0.f;
#pragma unroll
        for (int i = 0; i < 16; ++i) ss += acc[i] * acc[i];
        ss += shx(ss, 32, lane);
        float* RED = (float*)(lds + H_RED);
        if (hh == 0) RED[vt * 64 + t] = ss;
        __syncthreads();
        const float tot = RED[t] + RED[64 + t] + RED[128 + t] + RED[192 + t];
        const float rs = 1.0f / sqrtf(tot * (1.0f / 128.0f) + EPS);
        bf16_t* yp = Y + (R0 + t) * D_MODEL + 512 + hd * 128 + 32 * vt + 4 * hh;
        u32x2 wout[4];
#pragma unroll
        for (int g = 0; g < 4; ++g) {
            const float r0 = acc[4 * g] * rs * nn[g].x * silu_f(bflo(gv[g].x)), r1 = acc[4 * g + 1] * rs * nn[g].y * silu_f(bfhi(gv[g].x));
            const float r2 = acc[4 * g + 2] * rs * nn[g].z * silu_f(bflo(gv[g].y)), r3 = acc[4 * g + 3] * rs * nn[g].w * silu_f(bfhi(gv[g].y));
            wout[g].x = pk2(r0, r1); wout[g].y = pk2(r2, r3);
        }
        H3_LOAD_GATE(un)
#pragma unroll
        for (int g = 0; g < 4; ++g) *(u32x2*)(yp + 8 * g) = wout[g];
    }
#undef H3_LOAD_RAW
#undef H3_LOAD_ST
#undef H3_LOAD_GATE
}

#define CTX() \
    const __attribute__((address_space(4))) Params* kp_ = (const __attribute__((address_space(4))) Params*)__builtin_amdgcn_kernarg_segment_ptr(); asm volatile("" : "+s"(kp_)); const __attribute__((address_space(4))) Params& p = *kp_; \
    int tid_ = threadIdx.x; asm volatile("" : "+v"(tid_)); const int tid = tid_, lane = tid & 63, wave = __builtin_amdgcn_readfirstlane(tid >> 6); \
    const int G = gridDim.x, bid = blockIdx.x; const int gw = wave * G + bid, NGW = G * 8; unsigned char* ws = p.ws; \
    (void)lane; (void)gw; (void)NGW; (void)ws; (void)tid;
#define WLP(l) ((const bf16_t*)(ws + WS_WEIGHTS + (size_t)(l) * WL_SIZE))
#define MLP(l) ((const float*)(ws + WS_MOD) + (size_t)(l) * 2 * NMOD)

template <class Epi> DI void run_gemm(PG8_LAS unsigned char* glds, const bf16_t* A, const bf16_t* Bt, int N, int K, const Epi E) {
    int G_ = gridDim.x, b_ = blockIdx.x; asm volatile("" : "+s"(G_), "+s"(b_));
    pg8::Gemm g{A, Bt, M_TOK, N, K}; pg8::StaticOrder S; S.init(M_TOK, N, G_, b_);
    GEMMCALL<Epi, pg8::StaticOrder, G_ALIGN, G_SP2>(glds, g, S, E);
}

#ifdef PROBE_MASK
#define STAMP() do { if (threadIdx.x == 0) { ((volatile LAS unsigned long long*)(glds + 131072 + 256))[ts_n] = __builtin_amdgcn_s_memrealtime(); } ++ts_n; } while (0)
#else
#define STAMP() do { } while (0)
#endif
__global__ void __launch_bounds__(512) fwd_kernel(Params p_unused) {
    extern __shared__ __attribute__((aligned(16))) unsigned char lds[];
    cg::grid_group grid = cg::this_grid();
    PG8_LAS unsigned char* glds = (PG8_LAS unsigned char*)lds;
    int ts_n = 0; (void)ts_n; STAMP();
    { CTX(); if (tid < 2) ((volatile LAS unsigned*)(glds + LDS_MISC))[tid] = 0u;
      if (tid == 0) (void)xb_add((unsigned*)(ws + WS_BAR) + XB_XCNT(xb_xcc_id()), 1u);
      { float* RS = (float*)(ws + WS_RS); for (int i = bid * 512 + tid; i < (DEPTH + 1) * 3 * M_TOK; i += G * 512) RS[i] = 0.f; } }
#ifndef SKIP_PREP
    { CTX(); phase_prep(p, lds, gw, NGW, wave, lane); }
#endif
#define GRID_BAR() do { CTX(); XcdBarrier xb_; xb_.bar = (unsigned*)(ws + WS_BAR); xb_.x = xb_xcc_id(); xb_.st = (volatile LAS unsigned*)(glds + LDS_MISC); xcd_barrier(xb_); STAMP(); } while (0)
    { CTX(); if (ws == nullptr) grid.sync(); }
    GRID_BAR();
    { CTX(); phase_prep2(p, ws, gw, NGW, lane); }
    GRID_BAR();
#define RSP(l, k) ((float*)(ws + WS_RS) + (size_t)((l) * 3 + (k)) * M_TOK)
#define SHWP(l) ((const float*)(ws + WS_SHW) + (size_t)(l) * 2 * SHW_N)

#pragma unroll 1
    for (int l = 0; l < DEPTH; ++l) {
        { CTX(); run_gemm(glds, (const bf16_t*)(ws + WS_HB), WLP(l) + WL_GU1 / 2, 2 * D_FF, D_MODEL, pg8::EpiSwiGLU{D_FF, l * 3 + 0, l * 2 * SHW_N}); }
        GRID_BAR();
        { CTX(); run_gemm(glds, (const bf16_t*)(ws + WS_ACT), WLP(l) + WL_DN1 / 2, D_MODEL, D_FF, pg8::EpiRes{(l == 0) ? 1 : 0, l * 2 * NMOD + 2 * D_MODEL, l * 2 * NMOD + 4 * D_MODEL, l * 3 + 1, 0.5f, 0}); }
        GRID_BAR();
        { CTX(); run_gemm(glds, (const bf16_t*)(ws + WS_HB), WLP(l) + WL_IN / 2, PW, D_MODEL, pg8::EpiBf16{PW, l * 3 + 1, l * 2 * SHW_N + 2 * D_FF}); }
        GRID_BAR();
#ifndef SKIP_H1
        { CTX(); if (tid == 0) ((volatile LAS unsigned*)(glds + LDS_MISC))[4] = 0u;
          hgrn_h1_phase(lds, (const bf16_t*)(ws + WS_ACT), (const float*)(ws + WS_LB) + l * 512, (bf16_t*)(ws + WS_ST), (float*)(ws + WS_DEC), bid, G, tid, wave, lane); }
#endif
        STAMP();
#ifndef SKIP_QK
        { CTX(); for (int m = gw; m < M_TOK; m += 4 * NGW) { if (m + 3 * NGW < M_TOK) { const int mm[4] = {m, m + NGW, m + 2 * NGW, m + 3 * NGW}; qkprep_tokens<4>((bf16_t*)(ws + WS_ACT), p.qng + l * 64, p.kng + l * 64, mm, lane); }
            else for (int m1 = m; m1 < M_TOK; m1 += NGW) { const int mm[1] = {m1}; qkprep_tokens<1>((bf16_t*)(ws + WS_ACT), p.qng + l * 64, p.kng + l * 64, mm, lane); } } }
#endif
        STAMP();
#ifndef SKIP_SB
        { CTX();
          for (;;) { unsigned jj = 0; if (lane == 0) jj = __hip_atomic_fetch_add((LAS unsigned*)(glds + LDS_MISC) + 4, 1u, __ATOMIC_RELAXED, __HIP_MEMORY_SCOPE_WORKGROUP);
            const int vb = (G % 8 == 0) ? (bid % 8) * (G / 8) + bid / 8 : bid;
            const int u = vb + G * __builtin_amdgcn_readfirstlane((int)jj); if (u >= 8 * (SEQ / 32)) break;
            const int bh = u / (SEQ / 32), qt = (SEQ / 32 - 1) - u % (SEQ / 32); sb_unit((const bf16_t*)(ws + WS_ACT), (bf16_t*)p.out, glds + wave * ATT_LDS_PER_WAVE, bh >> 2, bh & 3, qt, lane); } }
#endif
        GRID_BAR();
#ifndef SKIP_SCAN
        { CTX(); for (int g = bid * 512 + tid; g < 8 * 16384; g += G * 512) hgrn_scan((bf16_t*)(ws + WS_ST), (const float*)(ws + WS_DEC), g); }
#endif
        STAMP();
#ifndef SKIP_DIL
        { CTX();
            float gq = fabsf(p.qng[l * 64 + lane]), gk = fabsf(p.kng[l * 64 + lane]);
#pragma unroll
            for (int o = 1; o < 64; o <<= 1) { gq = fmaxf(gq, shx(gq, o, lane)); gk = fmaxf(gk, shx(gk, o, lane)); }
            const float m2 = 8.0f * gq * gk * LOG2E;
            const int vb = (G % 8 == 0) ? (bid % 8) * (G / 8) + bid / 8 : bid;
            for (int u = wave * G + vb; u < 3 * 8 * 256; u += NGW) {
                const int pat = u / 2048, rem = u % 2048, bh = rem / 256, pr = rem % 256;
                const int ppr = 256 >> (2 * pat);
                dil_unit((const bf16_t*)(ws + WS_ACT), (bf16_t*)(ws + WS_PNUM), (float*)(ws + WS_PDEN), glds + wave * ATT_LDS_PER_WAVE, bh >> 2, bh & 3, pat, pr / ppr, pr % ppr, m2, lane);
            }
        }
#endif
        GRID_BAR();
#ifndef SKIP_H3
        { CTX(); hgrn_h3_phase(lds, (const bf16_t*)(ws + WS_ACT), (const float*)(ws + WS_LB) + l * 512, (const bf16_t*)(ws + WS_ST), p.hng + l * 128, (bf16_t*)p.out, bid, G, tid, wave, lane); }
#endif
        STAMP();
        { CTX(); for (int m = gw; m < M_TOK; m += 4 * NGW) { if (m + 3 * NGW < M_TOK) { const int mm[4] = {m, m + NGW, m + 2 * NGW, m + 3 * NGW}; dil_merge_rows<4>((const bf16_t*)(ws + WS_PNUM), (const float*)(ws + WS_PDEN), (bf16_t*)p.out, mm, lane); }
            else for (int m1 = m; m1 < M_TOK; m1 += NGW) { const int mm[1] = {m1}; dil_merge_rows<1>((const bf16_t*)(ws + WS_PNUM), (const float*)(ws + WS_PDEN), (bf16_t*)p.out, mm, lane); } } }
        GRID_BAR();
        { CTX(); run_gemm(glds, (const bf16_t*)p.out, WLP(l) + WL_OUT / 2, D_MODEL, D_MODEL, pg8::EpiRes{0, l * 2 * NMOD + 5 * D_MODEL, l * 2 * NMOD + 7 * D_MODEL, l * 3 + 2, 1.0f, 0}); }
        GRID_BAR();
        { CTX(); run_gemm(glds, (const bf16_t*)(ws + WS_HB), WLP(l) + WL_GU2 / 2, 2 * D_FF, D_MODEL, pg8::EpiSwiGLU{D_FF, l * 3 + 2, l * 2 * SHW_N + 2 * D_FF + PW}); }
        GRID_BAR();
        { CTX(); run_gemm(glds, (const bf16_t*)(ws + WS_ACT), WLP(l) + WL_DN2 / 2, D_MODEL, D_FF, pg8::EpiRes{0, l * 2 * NMOD + 8 * D_MODEL, ((l + 1 < DEPTH) ? l + 1 : l) * 2 * NMOD + 1 * D_MODEL, (l + 1) * 3 + 0, 0.5f, (l + 1 == DEPTH) ? 1 : 0}); }
        GRID_BAR();
    }
#ifdef PROBE_MASK
    if (blockIdx.x == 0 && threadIdx.x == 0) {
        volatile LAS unsigned long long* ts = (volatile LAS unsigned long long*)(glds + 131072 + 256);
        unsigned long long sum = 0;
        for (int i = 0; i + 1 < ts_n; ++i) if ((PROBE_MASK >> i) & 1ull) sum += ts[i + 1] - ts[i];
        const unsigned long long target = __builtin_amdgcn_s_memrealtime() + 4ull * sum;
        while (__builtin_amdgcn_s_memrealtime() < target) __builtin_amdgcn_s_sleep(8);
    }
#endif
}

extern "C" void kernel_launch(void* const* d_in, const int* in_sizes, int n_in, void* d_out, int out_size, void* d_ws, size_t ws_size, hipStream_t stream) {
    static int grid = 0;
    if (grid == 0) {
        if (n_in != 16 || ws_size < WS_END) { fprintf(stderr, "kernel_launch: unexpected n_in %d / ws %zu\n", n_in, ws_size); grid = -1; return; }
        int dev = 0, cus = 0, per_cu = 0;
        hipGetDevice(&dev);
        hipDeviceGetAttribute(&cus, hipDeviceAttributeMultiprocessorCount, dev);
        if (hipFuncSetAttribute((const void*)fwd_kernel, hipFuncAttributeMaxDynamicSharedMemorySize, LDS_BYTES) != hipSuccess) { fprintf(stderr, "kernel_launch: hipFuncSetAttribute failed\n"); grid = -1; return; }
        if (hipOccupancyMaxActiveBlocksPerMultiprocessor(&per_cu, (const void*)fwd_kernel, 512, LDS_BYTES) != hipSuccess || per_cu < 1) { fprintf(stderr, "kernel_launch: occupancy query gave %d\n", per_cu); per_cu = 1; }
        (void)hipGetLastError();
        grid = cus * per_cu;
    }
    if (grid < 0) return;
    Params p{};
    p.x = (const float*)d_in[0]; p.c = (const float*)d_in[1]; p.w_mod = (const float*)d_in[2]; p.b_mod = (const float*)d_in[3];
    p.f1g = (const float*)d_in[4]; p.f1u = (const float*)d_in[5]; p.f1d = (const float*)d_in[6]; p.w_in = (const float*)d_in[7]; p.w_out = (const float*)d_in[8];
    p.qng = (const float*)d_in[9]; p.kng = (const float*)d_in[10]; p.hng = (const float*)d_in[11]; p.lbl = (const float*)d_in[12];
    p.f2g = (const float*)d_in[13]; p.f2u = (const float*)d_in[14]; p.f2d = (const float*)d_in[15];
    p.out = (float*)d_out; p.ws = (unsigned char*)d_ws;
    if (hipMemsetAsync((unsigned char*)d_ws + WS_BAR, 0, (XCD_BAR_WORDS + 512) * sizeof(unsigned), stream) != hipSuccess) { fprintf(stderr, "kernel_launch: barrier memset failed\n"); return; }
    void* args[] = {&p};
    hipError_t e = hipLaunchCooperativeKernel((const void*)fwd_kernel, dim3(grid), dim3(512), args, LDS_BYTES, stream);
    if (e != hipSuccess) fprintf(stderr, "cooperative launch failed: %s (grid %d)\n", hipGetErrorString(e), grid);
}
```
